# Optimizing an MI355X kernel written in HIP

```python
import math
import jax, jax.numpy as jnp
from jax import lax
import numpy as np

D_MODEL = 1024
BATCH = 8
SEQ = 4096
DEPTH = 4

GRID_W = 64
CTX_LEN = 256
N_MOD = 6
EPS = 1e-6
D_MIX = D_MODEL
HY_CH = D_MIX // 4
S5_CH = D_MIX // 4
ATT_W = D_MIX // 2
HY_CONV = 3
HY_FILTER_DIM = 64
HY_BANDS = 16
HY_EMB = 1 + 2 * HY_BANDS
HY_DECAY_MIN = -math.log(1e-2) / 1.5
HY_DECAY_MAX = -math.log(1e-2) / 0.3
S5_GROUP = 16
S5_GROUPS = S5_CH // S5_GROUP
S5_STATE = 64
S5_DT_MIN = 1e-3
S5_DT_MAX = 1e-1
ATT_HEAD_DIM = 64
ATT_HEADS = ATT_W // (2 * ATT_HEAD_DIM)
ATT_V_DIM = 2 * ATT_HEAD_DIM
ROPE_HALF = ATT_HEAD_DIM // 2
ROPE_PAIRS_AXIS = ROPE_HALF // 2
ROPE_BASE = 10000.0
Q_BLOCK = 128
MOE_GROUPS = 4
MOE_EPG = 8
N_EXPERTS = MOE_GROUPS * MOE_EPG
MOE_TOP_K = 2
EXPERT_HIDDEN = D_MODEL // 2
MOE_BLOCK = 256
IN_COLS = 3 * HY_CH + S5_CH + 3 * ATT_W
IN_SPLITS = (3 * HY_CH, 3 * HY_CH + S5_CH, 3 * HY_CH + S5_CH + ATT_W, 3 * HY_CH + S5_CH + 2 * ATT_W)

kernel_name = 'hybrid_hyena_s5_diffattn_hmoe_dit'


def rms_norm(x, g):
    xf = x.astype(jnp.float32)
    y = xf * lax.rsqrt(jnp.mean(xf * xf, axis=-1, keepdims=True) + EPS)
    return (y * g.astype(jnp.float32)).astype(x.dtype)


def modulate(h, shift, scale):
    return h * (1.0 + scale) + shift


def short_conv(u, w, b):
    up = jnp.pad(u, ((0, 0), (1, 1), (0, 0)))
    return up[:, :-2] * w[0] + up[:, 1:-1] * w[1] + up[:, 2:] * w[2] + b


def hyena_filter(L, w1, b1, w2, b2, w3, freq):
    f32 = jnp.float32
    t = jnp.arange(L, dtype=f32) / L
    ang = (2.0 * math.pi) * t[:, None] * jnp.arange(1, HY_BANDS + 1, dtype=f32)
    feat = jnp.concatenate([t[:, None], jnp.cos(ang), jnp.sin(ang)], axis=-1)
    fr = freq.astype(f32)
    h = jnp.sin(fr * (feat @ w1.astype(f32) + b1.astype(f32)))
    h = jnp.sin(fr * (h @ w2.astype(f32) + b2.astype(f32)))
    h = (h @ w3.astype(f32)).reshape(L, 2, HY_CH)
    window = jnp.exp(-t[:, None] * jnp.linspace(HY_DECAY_MIN, HY_DECAY_MAX, HY_CH, dtype=f32))
    h = h * window[:, None, :]
    filt = jnp.concatenate([h[:, 0], jnp.zeros((1, HY_CH), f32), h[:0:-1, 1]], axis=0)
    return filt / (jnp.sum(jnp.abs(filt), axis=0, keepdims=True) + EPS)


def hyena_mixer(p, conv_w, conv_b, filt_params, skip, norm_g):
    L = p.shape[1]
    u = short_conv(p, conv_w, conv_b).astype(jnp.float32)
    x0, x1, v = jnp.split(u, 3, axis=-1)
    z = x1 * v
    filt = hyena_filter(L, *filt_params)
    zf = jnp.fft.rfft(z, n=2 * L, axis=1)
    ff = jnp.fft.rfft(filt, n=2 * L, axis=0)
    y = jnp.fft.irfft(zf * ff[None], n=2 * L, axis=1)[:, :L]
    return rms_norm(x0 * (y + skip.astype(jnp.float32) * z), norm_g)


def _scan_combine(left, right):
    a_l, b_l = left
    a_r, b_r = right
    return a_l * a_r, a_r * b_l + b_r


def linear_scan(a_bar, bu, reverse):
    a = jnp.broadcast_to(a_bar, (1, bu.shape[1]) + a_bar.shape)
    _, h = lax.associative_scan(_scan_combine, (a, bu), reverse=reverse, axis=1)
    return h


def s5_mixer(u_ctx, u_lat, a_re, a_im, log_dt, b_re, b_im, c_re, c_im, d_skip, glu_w, norm_g, need_ctx):
    f32 = jnp.float32
    B, Lc, _ = u_ctx.shape
    L = u_lat.shape[1]
    uc = u_ctx.astype(f32).reshape(B, Lc, S5_GROUPS, S5_GROUP)
    ul = u_lat.astype(f32).reshape(B, L, S5_GROUPS, S5_GROUP)
    dsk = d_skip.astype(f32).reshape(S5_GROUPS, S5_GROUP)
    y_lat = dsk * ul
    ctx_terms = [dsk * uc] if need_ctx else []
    for direction in range(2):
        rev = direction == 1
        A = lax.complex(a_re[direction].astype(f32), a_im[direction].astype(f32))
        dtA = jnp.exp(log_dt[direction].astype(f32))[:, None] * A
        a_bar = jnp.exp(dtA)
        b_bar = ((a_bar - 1.0) / A)[:, :, None] * lax.complex(b_re[direction].astype(f32), b_im[direction].astype(f32))
        c_r = c_re[direction].astype(f32)
        c_i = c_im[direction].astype(f32)

        def drive(u):
            return lax.complex(jnp.einsum('blgh,gph->blgp', u, b_bar.real), jnp.einsum('blgh,gph->blgp', u, b_bar.imag))

        def readout(h):
            return jnp.einsum('blgp,ghp->blgh', h.real, c_r) - jnp.einsum('blgp,ghp->blgh', h.imag, c_i)

        h_ctx = linear_scan(a_bar, drive(uc), rev)
        h0 = h_ctx[:, 0] if rev else h_ctx[:, -1]
        steps = (L - jnp.arange(L)) if rev else (jnp.arange(L) + 1)
        carry = jnp.exp(steps.astype(f32)[:, None, None] * dtA)
        h_lat = linear_scan(a_bar, drive(ul), rev) + carry[None] * h0[:, None]
        y_lat = y_lat + readout(h_lat)
        if need_ctx:
            ctx_terms.append(readout(h_ctx))

    def glu(y, n):
        g = jax.nn.gelu(y.reshape(B, n, S5_CH))
        return rms_norm(g * jax.nn.sigmoid(g @ glu_w.astype(f32)), norm_g)

    out_ctx = glu(sum(ctx_terms), Lc) if need_ctx else None
    return glu(y_lat, L), out_ctx


def axial_rope(L):
    rows = L // GRID_W
    row = jnp.repeat(jnp.arange(rows, dtype=jnp.float32), GRID_W)
    col = jnp.tile(jnp.arange(GRID_W, dtype=jnp.float32), rows)
    inv = ROPE_BASE ** (-jnp.arange(ROPE_PAIRS_AXIS, dtype=jnp.float32) / ROPE_PAIRS_AXIS)
    ang = jnp.concatenate([row[:, None] * inv, col[:, None] * inv], axis=-1)
    return jnp.cos(ang), jnp.sin(ang)


def apply_rope(t, cos, sin):
    t1, t2 = t[..., :ROPE_HALF], t[..., ROPE_HALF:]
    return jnp.concatenate([t1 * cos - t2 * sin, t1 * sin + t2 * cos], axis=-1)


def diff_attention(ql, kl, vl, qc, kc, vc, cos, sin, lam, lam_init, subln_g, need_ctx):
    f32 = jnp.float32
    B, L, _ = ql.shape
    Lc = qc.shape[1]
    scale = ATT_HEAD_DIM ** -0.5

    def heads_qk(t, n):
        return t.reshape(B, n, ATT_HEADS, 2, ATT_HEAD_DIM).transpose(0, 2, 3, 1, 4)

    def heads_v(t, n):
        return t.reshape(B, n, ATT_HEADS, ATT_V_DIM).transpose(0, 2, 1, 3)

    def diff_map(logits):
        p = jax.nn.softmax(logits.astype(f32) * scale, axis=-1)
        return p[:, :, 0] - lam * p[:, :, 1]

    def finish(o, n):
        o = rms_norm(o, subln_g) * (1.0 - lam_init)
        return o.transpose(0, 2, 1, 3).reshape(B, n, ATT_HEADS * ATT_V_DIM)

    q_lat = heads_qk(ql, L)
    q_lat_rot = apply_rope(q_lat, cos, sin)
    k_lat_rot = apply_rope(heads_qk(kl, L), cos, sin)
    k_ctx = heads_qk(kc, Lc)
    v_ctx = heads_v(vc, Lc)
    v_all = jnp.concatenate([v_ctx, heads_v(vl, L)], axis=2)

    def latent_block(i):
        s = i * Q_BLOCK
        qb = lax.dynamic_slice_in_dim(q_lat, s, Q_BLOCK, axis=3)
        qrb = lax.dynamic_slice_in_dim(q_lat_rot, s, Q_BLOCK, axis=3)
        logits = jnp.concatenate([
            jnp.einsum('bhmqd,bhmkd->bhmqk', qb, k_ctx, preferred_element_type=f32),
            jnp.einsum('bhmqd,bhmkd->bhmqk', qrb, k_lat_rot, preferred_element_type=f32)], axis=-1)
        return jnp.einsum('bhqk,bhkv->bhqv', diff_map(logits), v_all)

    o = lax.map(latent_block, jnp.arange(L // Q_BLOCK))
    o = o.transpose(1, 2, 0, 3, 4).reshape(B, ATT_HEADS, L, ATT_V_DIM)
    out_ctx = None
    if need_ctx:
        a_c = diff_map(jnp.einsum('bhmqd,bhmkd->bhmqk', heads_qk(qc, Lc), k_ctx, preferred_element_type=f32))
        out_ctx = finish(jnp.einsum('bhqk,bhkv->bhqv', a_c, v_ctx), Lc)
    return finish(o, L), out_ctx


def hier_moe(h, w_g, b_g, w_e, b_e, w1, w3, w2):
    f32 = jnp.float32
    T, D = h.shape
    hf = h.astype(f32)
    g_logits = hf @ w_g.astype(f32) + b_g.astype(f32)
    g_idx = jnp.argmax(g_logits, axis=-1)
    p_group = jnp.take_along_axis(jax.nn.softmax(g_logits, axis=-1), g_idx[:, None], axis=1)
    e_logits = (hf @ w_e.astype(f32) + b_e.astype(f32)).reshape(T, MOE_GROUPS, MOE_EPG)
    e_logits = jnp.take_along_axis(e_logits, g_idx[:, None, None], axis=1)[:, 0]
    top_p, top_i = lax.top_k(jax.nn.softmax(e_logits, axis=-1), MOE_TOP_K)
    gate = (p_group * top_p / jnp.sum(top_p, axis=-1, keepdims=True)).reshape(-1)
    expert = (g_idx[:, None] * MOE_EPG + top_i).reshape(-1).astype(jnp.int32)
    tok = jnp.repeat(jnp.arange(T, dtype=jnp.int32), MOE_TOP_K)
    n_assign = T * MOE_TOP_K
    n_blocks = -(-n_assign // MOE_BLOCK) + N_EXPERTS
    n_pad = n_blocks * MOE_BLOCK
    order = jnp.argsort(expert)
    se = expert[order]
    counts = jnp.bincount(expert, length=N_EXPERTS)
    start = jnp.cumsum(counts) - counts
    padded = (counts + MOE_BLOCK - 1) // MOE_BLOCK * MOE_BLOCK
    pad_end = jnp.cumsum(padded)
    pad_start = pad_end - padded
    dest = pad_start[se] + jnp.arange(n_assign, dtype=jnp.int32) - start[se]
    slot_tok = jnp.full((n_pad,), T, jnp.int32).at[dest].set(tok[order])
    slot_gate = jnp.zeros((n_pad,), f32).at[dest].set(gate[order])
    block_e = jnp.minimum(jnp.searchsorted(pad_end, jnp.arange(n_blocks) * MOE_BLOCK, side='right'), N_EXPERTS - 1)
    h_pad = jnp.concatenate([h, jnp.zeros((1, D), h.dtype)], axis=0)
    xb = h_pad[slot_tok].reshape(n_blocks, MOE_BLOCK, D)

    def run_block(args):
        xi, e = args
        return (jax.nn.silu(xi @ w1[e]) * (xi @ w3[e])) @ w2[e]

    yb = lax.map(run_block, (xb, block_e)).reshape(n_pad, D)
    y = jax.ops.segment_sum(yb * slot_gate[:, None].astype(yb.dtype), slot_tok, num_segments=T + 1)
    return y[:T]


def setup_inputs(seed: int = 0) -> dict:
    key = jax.random.key(seed)
    keys = iter(jax.random.split(key, 64))
    f32 = jnp.float32

    def normal(shape, scale):
        return scale * jax.random.normal(next(keys), shape, f32)

    def gain(shape):
        return 1.0 + normal(shape, 0.01)

    G, P, H = S5_GROUPS, S5_STATE, S5_GROUP
    E, F = N_EXPERTS, EXPERT_HIDDEN
    return {
        'x': normal((BATCH, SEQ, D_MODEL), 1.0),
        'c': normal((BATCH, D_MODEL), 1.0),
        'ctx': normal((BATCH, CTX_LEN, D_MODEL), 1.0),
        'c_ctx': normal((D_MODEL,), 1.0),
        'w_mod': normal((DEPTH, D_MODEL, N_MOD * D_MODEL), 0.5 * D_MODEL ** -0.5),
        'b_mod': normal((DEPTH, N_MOD * D_MODEL), 0.02),
        'norm1_g': gain((DEPTH, D_MODEL)),
        'norm2_g': gain((DEPTH, D_MODEL)),
        'final_g': gain((D_MODEL,)),
        'w_in': normal((DEPTH, D_MODEL, IN_COLS), D_MODEL ** -0.5),
        'w_out': normal((DEPTH, D_MIX, D_MODEL), D_MIX ** -0.5),
        'hy_conv_w': normal((DEPTH, HY_CONV, 3 * HY_CH), HY_CONV ** -0.5),
        'hy_conv_b': normal((DEPTH, 3 * HY_CH), 0.01),
        'hy_ffn_w1': normal((DEPTH, HY_EMB, HY_FILTER_DIM), HY_EMB ** -0.5),
        'hy_ffn_b1': normal((DEPTH, HY_FILTER_DIM), 0.1),
        'hy_ffn_w2': normal((DEPTH, HY_FILTER_DIM, HY_FILTER_DIM), HY_FILTER_DIM ** -0.5),
        'hy_ffn_b2': normal((DEPTH, HY_FILTER_DIM), 0.1),
        'hy_ffn_w3': normal((DEPTH, HY_FILTER_DIM, 2 * HY_CH), HY_FILTER_DIM ** -0.5),
        'hy_freq': gain((DEPTH, HY_FILTER_DIM)),
        'hy_skip': normal((DEPTH, HY_CH), 0.5),
        'hy_norm_g': gain((DEPTH, HY_CH)),
        's5_a_re': -0.5 + normal((DEPTH, 2, G, P), 0.01),
        's5_a_im': math.pi * jnp.arange(P, dtype=f32) + normal((DEPTH, 2, G, P), 0.01),
        's5_log_dt': jax.random.uniform(next(keys), (DEPTH, 2, G), f32, math.log(S5_DT_MIN), math.log(S5_DT_MAX)),
        's5_b_re': normal((DEPTH, 2, G, P, H), (2 * H) ** -0.5),
        's5_b_im': normal((DEPTH, 2, G, P, H), (2 * H) ** -0.5),
        's5_c_re': normal((DEPTH, 2, G, H, P), (2 * P) ** -0.5),
        's5_c_im': normal((DEPTH, 2, G, H, P), (2 * P) ** -0.5),
        's5_d': normal((DEPTH, S5_CH), 0.5),
        's5_glu_w': normal((DEPTH, S5_CH, S5_CH), S5_CH ** -0.5),
        's5_norm_g': gain((DEPTH, S5_CH)),
        'att_lq1': normal((DEPTH, ATT_HEAD_DIM), 0.1),
        'att_lk1': normal((DEPTH, ATT_HEAD_DIM), 0.1),
        'att_lq2': normal((DEPTH, ATT_HEAD_DIM), 0.1),
        'att_lk2': normal((DEPTH, ATT_HEAD_DIM), 0.1),
        'att_subln_g': gain((DEPTH, ATT_V_DIM)),
        'moe_wg': normal((DEPTH, D_MODEL, MOE_GROUPS), D_MODEL ** -0.5),
        'moe_bg': normal((DEPTH, MOE_GROUPS), 0.01),
        'moe_we': normal((DEPTH, D_MODEL, E), D_MODEL ** -0.5),
        'moe_be': normal((DEPTH, E), 0.01),
        'moe_w1': normal((DEPTH, E, D_MODEL, F), D_MODEL ** -0.5),
        'moe_w3': normal((DEPTH, E, D_MODEL, F), D_MODEL ** -0.5),
        'moe_w2': normal((DEPTH, E, F, D_MODEL), F ** -0.5),
    }


def reference(x, c, ctx, c_ctx, w_mod, b_mod, norm1_g, norm2_g, final_g, w_in, w_out,
              hy_conv_w, hy_conv_b, hy_ffn_w1, hy_ffn_b1, hy_ffn_w2, hy_ffn_b2, hy_ffn_w3, hy_freq,
              hy_skip, hy_norm_g, s5_a_re, s5_a_im, s5_log_dt, s5_b_re, s5_b_im, s5_c_re, s5_c_im,
              s5_d, s5_glu_w, s5_norm_g, att_lq1, att_lk1, att_lq2, att_lk2, att_subln_g,
              moe_wg, moe_bg, moe_we, moe_be, moe_w1, moe_w3, moe_w2):
    f32 = jnp.float32
    B, L, D = x.shape
    Lc = ctx.shape[1]
    cos, sin = axial_rope(L)
    silu_c = jax.nn.silu(c)
    silu_cc = jax.nn.silu(c_ctx)
    for l in range(DEPTH):
        need_ctx = l < DEPTH - 1
        lam_init = 0.8 - 0.6 * math.exp(-0.3 * l)
        sh1, sc1, g1, sh2, sc2, g2 = jnp.split((silu_c @ w_mod[l] + b_mod[l])[:, None, :], N_MOD, axis=-1)
        csh1, csc1, cg1, csh2, csc2, cg2 = jnp.split(silu_cc @ w_mod[l] + b_mod[l], N_MOD, axis=-1)

        p_lat = modulate(rms_norm(x, norm1_g[l]), sh1, sc1) @ w_in[l]
        p_ctx = modulate(rms_norm(ctx, norm1_g[l]), csh1, csc1) @ w_in[l]
        hy_l, s5_l, q_l, k_l, v_l = jnp.split(p_lat, IN_SPLITS, axis=-1)
        hy_c, s5_c, q_c, k_c, v_c = jnp.split(p_ctx, IN_SPLITS, axis=-1)

        filt_params = (hy_ffn_w1[l], hy_ffn_b1[l], hy_ffn_w2[l], hy_ffn_b2[l], hy_ffn_w3[l], hy_freq[l])
        hy_lat = hyena_mixer(hy_l, hy_conv_w[l], hy_conv_b[l], filt_params, hy_skip[l], hy_norm_g[l])

        s5_lat, s5_ctx = s5_mixer(s5_c, s5_l, s5_a_re[l], s5_a_im[l], s5_log_dt[l], s5_b_re[l], s5_b_im[l],
                                  s5_c_re[l], s5_c_im[l], s5_d[l], s5_glu_w[l], s5_norm_g[l], need_ctx)

        lam = (jnp.exp(jnp.sum(att_lq1[l].astype(f32) * att_lk1[l].astype(f32)))
               - jnp.exp(jnp.sum(att_lq2[l].astype(f32) * att_lk2[l].astype(f32))) + lam_init)
        att_lat, att_ctx = diff_attention(q_l, k_l, v_l, q_c, k_c, v_c, cos, sin, lam, lam_init,
                                          att_subln_g[l], need_ctx)

        mix_lat = jnp.concatenate([hy_lat, s5_lat, att_lat], axis=-1).astype(x.dtype)
        x = x + g1 * (mix_lat @ w_out[l])
        if need_ctx:
            hy_ctx = hyena_mixer(hy_c, hy_conv_w[l], hy_conv_b[l], filt_params, hy_skip[l], hy_norm_g[l])
            mix_ctx = jnp.concatenate([hy_ctx, s5_ctx, att_ctx], axis=-1).astype(ctx.dtype)
            ctx = ctx + cg1 * (mix_ctx @ w_out[l])

        moe_params = (moe_wg[l], moe_bg[l], moe_we[l], moe_be[l], moe_w1[l], moe_w3[l], moe_w2[l])
        h_lat = modulate(rms_norm(x, norm2_g[l]), sh2, sc2).reshape(B * L, D)
        if need_ctx:
            h_ctx = modulate(rms_norm(ctx, norm2_g[l]), csh2, csc2).reshape(B * Lc, D)
            y = hier_moe(jnp.concatenate([h_lat, h_ctx], axis=0), *moe_params)
            x = x + g2 * y[:B * L].reshape(B, L, D)
            ctx = ctx + cg2 * y[B * L:].reshape(B, Lc, D)
        else:
            x = x + g2 * hier_moe(h_lat, *moe_params).reshape(B, L, D)
    return rms_norm(x, final_g)
```

```cpp
#include <hip/hip_runtime.h>
#include <cstdio>
#include <cstdint>
#include <cmath>
__device__ __forceinline__ int lane_id_asm() { int l; asm volatile("v_mbcnt_lo_u32_b32 %0, -1, 0\n\tv_mbcnt_hi_u32_b32 %0, -1, %0" : "=v"(l)); return l; }
namespace pg8 {
#define PG8_LAS __attribute__((address_space(3)))
typedef unsigned short bf16_t;
typedef short bf16x8 __attribute__((ext_vector_type(8)));
typedef float f32x4 __attribute__((ext_vector_type(4)));
typedef unsigned u32x4 __attribute__((ext_vector_type(4)));
constexpr int BM = 256, BK = 64, HALF = 128, HTB = HALF * BK * 2  , STAGE_BYTES = 8 * HTB, NXCD = 8, WGM = 8;

__host__ __device__ __forceinline__ int lds_byte(int r, int c) { const int st = (r >> 4) * 2 + (c >> 5), rr = r & 15, cc = c & 31, ob = rr * 64 + cc * 2; return st * 1024 + (ob ^ (((ob >> 9) & 1) << 5)); }
__host__ __device__ __forceinline__ void stage_rc(int b, int& R, int& C) { const int st = b / 1024, sb = b % 1024, swz = sb ^ (((sb >> 9) & 1) << 5); R = (st >> 1) * 16 + swz / 64; C = (st & 1) * 32 + (swz % 64) / 2; }
__host__ __device__ __forceinline__ int perm32(int rho) { const int n = rho >> 4, i = rho & 15; return 8 * (i >> 2) + 4 * n + (i & 3); }

struct Unit { int pm, pn; };
struct Gemm { const bf16_t* A; const bf16_t* Bt; int M, N, K; };

struct StaticOrder {
    int nM, nN, nwg, G, c;
    __host__ __device__ void init(int M, int N, int G_, int c_) { nM = M / BM; nN = N / BM; nwg = nM * nN; G = G_; c = c_; }
    __host__ __device__ bool next(int i, Unit& u) const {
        const long L = (long)i * G + c; if (L >= nwg) return false;
        int wgid = (int)L; { const int q = nwg / NXCD, r = nwg % NXCD, xcd = wgid % NXCD, off = wgid / NXCD; wgid = (xcd < r ? xcd * (q + 1) : r * (q + 1) + (xcd - r) * q) + off; }
        const int nig = WGM * nN, gid = wgid / nig, fm = gid * WGM, gsz = (nM - fm) < WGM ? (nM - fm) : WGM;
        u.pm = fm + ((wgid % nig) % gsz); u.pn = (wgid % nig) / gsz; return true;
    }
    __device__ __forceinline__ void a_ready(const Unit&) const {}
    __device__ __forceinline__ void done(const Unit&) const {}
};

__device__ __forceinline__ unsigned cvt_pk_bf16(float lo, float hi) { unsigned r; asm volatile("v_cvt_pk_bf16_f32 %0, %1, %2" : "=v"(r) : "v"(lo), "v"(hi)); return r; }
typedef float f32x2 __attribute__((ext_vector_type(2)));
template <class Epi, class Sched, bool ALIGN_EPI = false, bool SP2 = false, bool GATHER = false>
__device__ __forceinline__ void gemm_phase(PG8_LAS unsigned char* lds, const Gemm g, const Sched& S, const Epi& E, int tid_, const int* rowidx = nullptr) {
    asm volatile("" : "+v"(tid_));
    const int tid = tid_, wid = __builtin_amdgcn_readfirstlane(tid >> 6), lane = tid & 63, wr = wid >> 2, wc = wid & 3, fr = lane & 15, fq = lane >> 4;
    const int K = g.K, nt = K / BK;
    unsigned voffA[2], voffB[2]; int RA[2], CA[2]; unsigned oC[2][2], oN[2][2];
#pragma unroll
    for (int i = 0; i < 2; ++i) { int R, C; stage_rc(tid * 16 + i * 8192, R, C); const int Rb = Epi::PERM ? ((R & ~31) + perm32(R & 31)) : R;
        voffA[i] = (unsigned)(R * K + C) * 2u; voffB[i] = (unsigned)(Rb * K + C) * 2u; RA[i] = R; CA[i] = C; }
    const size_t kstep = (size_t)(BK * 2);
    const size_t hstep = (size_t)HALF * K * 2;
    const size_t tstep = 2 * hstep;
    const size_t tstepA = GATHER ? (size_t)0 : tstep;
    const unsigned ldsw = (unsigned)wid * 1024u;
    const int aoff = lds_byte(wr * 64 + fr, fq * 8), boff = lds_byte(wc * 32 + fr, fq * 8);
#define PG8_SA(b, h) (((b) * 2 + (h)) * HTB)
#define PG8_SB(b, h) ((4 + (b) * 2 + (h)) * HTB)
#define PG8_STAGEA(bufoff, gbase, h, NX) do { _Pragma("unroll") for (int _i = 0; _i < 2; ++_i) { \
        const unsigned _o = GATHER ? ((NX) ? oN[h][_i] : oC[h][_i]) : (unsigned)((h) * hstep) + voffA[_i]; \
        __builtin_amdgcn_global_load_lds((const unsigned*)((const char*)(gbase) + _o), (PG8_LAS unsigned*)(lds + (bufoff) + ldsw + _i * 8192), 16, 0, 0); } } while (0)
#define PG8_GIDX(dst, pm_) do { _Pragma("unroll") for (int _h = 0; _h < 2; ++_h) _Pragma("unroll") for (int _i = 0; _i < 2; ++_i) \
        dst[_h][_i] = ((unsigned)rowidx[(pm_) * BM + _h * HALF + RA[_i]] * (unsigned)K + (unsigned)CA[_i]) * 2u; } while (0)
#define PG8_STAGE(bufoff, gbase, voff) do { _Pragma("unroll") for (int _i = 0; _i < 2; ++_i) \
        __builtin_amdgcn_global_load_lds((const unsigned*)((const char*)(gbase) + (voff)[_i]), (PG8_LAS unsigned*)(lds + (bufoff) + ldsw + _i * 8192), 16, 0, 0); } while (0)
#define PG8_LDA(dst, b, h) do { _Pragma("unroll") for (int m = 0; m < 4; ++m) _Pragma("unroll") for (int k = 0; k < 2; ++k) dst[m][k] = *(const PG8_LAS bf16x8*)(lds + PG8_SA(b, h) + aoff + m * 2048 + k * 1024); } while (0)
#define PG8_LDB(dst, b, h) do { _Pragma("unroll") for (int n = 0; n < 2; ++n) _Pragma("unroll") for (int k = 0; k < 2; ++k) dst[n][k] = *(const PG8_LAS bf16x8*)(lds + PG8_SB(b, h) + boff + n * 2048 + k * 1024); } while (0)
#define PG8_MMA(ai, bj, At, Bt) do { __builtin_amdgcn_s_setprio(1); _Pragma("unroll") for (int m = 0; m < 4; ++m) _Pragma("unroll") for (int n = 0; n < 2; ++n) _Pragma("unroll") for (int k = 0; k < 2; ++k) \
        acc[ai][bj][m][n] = __builtin_amdgcn_mfma_f32_16x16x32_bf16(Bt[n][k], At[m][k], acc[ai][bj][m][n], 0, 0, 0); __builtin_amdgcn_s_setprio(0); } while (0)
#define PG8_WAIT_V(n) asm volatile("s_waitcnt vmcnt(" #n ")" ::: "memory")
#define PG8_WAIT_L(n) asm volatile("s_waitcnt lgkmcnt(" #n ")" ::: "memory")
#define PG8_BAR __builtin_amdgcn_s_barrier()
#define PG8_SCHED __builtin_amdgcn_sched_barrier(0)
    Unit cur, nxt; int ui = 0;
    if (!S.next(0, cur)) return;
    f32x4 acc[2][2][4][2];
#pragma unroll
    for (int a = 0; a < 2; ++a)
#pragma unroll
        for (int b = 0; b < 2; ++b)
#pragma unroll
            for (int m = 0; m < 4; ++m)
#pragma unroll
                for (int n = 0; n < 2; ++n) acc[a][b][m][n] = (f32x4){0.f, 0.f, 0.f, 0.f};
    bf16x8 At[4][2], B0[2][2], B1[2][2];
    const char* cA = (const char*)g.A + (size_t)cur.pm * tstepA; const char* cB = (const char*)g.Bt + (size_t)cur.pn * tstep;
    if constexpr (GATHER) { PG8_GIDX(oC, cur.pm); asm volatile("s_waitcnt vmcnt(0)" ::: "memory"); }
    S.a_ready(cur);
    if constexpr (SP2) {
        PG8_STAGE(PG8_SB(0, 0), cB, voffB); PG8_STAGE(PG8_SB(0, 1), cB + hstep, voffB); PG8_STAGEA(PG8_SA(0, 0), cA, 0, false); PG8_STAGEA(PG8_SA(0, 1), cA, 1, false);
        if (wr == 1) PG8_BAR;
        PG8_WAIT_V(2); PG8_BAR;
        PG8_STAGE(PG8_SB(1, 0), cB + kstep, voffB); PG8_STAGEA(PG8_SA(1, 0), cA + kstep, 0, false); PG8_STAGE(PG8_SB(1, 1), cB + hstep + kstep, voffB);
        PG8_WAIT_V(6); PG8_BAR;
    } else {
        PG8_STAGE(PG8_SB(0, 0), cB, voffB); PG8_STAGEA(PG8_SA(0, 0), cA, 0, false); PG8_STAGE(PG8_SB(0, 1), cB + hstep, voffB); PG8_STAGEA(PG8_SA(0, 1), cA, 1, false);
        if (wr == 1) PG8_BAR;
        PG8_WAIT_V(4); PG8_BAR;
        PG8_STAGE(PG8_SB(1, 0), cB + kstep, voffB); PG8_STAGEA(PG8_SA(1, 0), cA + kstep, 0, false); PG8_STAGE(PG8_SB(1, 1), cB + hstep + kstep, voffB);
        PG8_WAIT_V(6); PG8_BAR;
    }
    for (;;) {
        const bool has_next = S.next(ui + 1, nxt);
        const char* nA = has_next ? (const char*)g.A + (size_t)nxt.pm * tstepA : cA; const char* nB = has_next ? (const char*)g.Bt + (size_t)nxt.pn * tstep : cB;
        if constexpr (GATHER) { if (has_next) { PG8_GIDX(oN, nxt.pm); asm volatile("s_waitcnt vmcnt(0)" ::: "memory"); } else { _Pragma("unroll") for (int _h = 0; _h < 2; ++_h) _Pragma("unroll") for (int _i = 0; _i < 2; ++_i) oN[_h][_i] = oC[_h][_i]; } }
        for (int t = 0; t < nt; t += 2) {
            const bool last = (t == nt - 2);
            const char* a1 = cA + (size_t)(t + 1) * kstep;
            const char* a2 = last ? nA : cA + (size_t)(t + 2) * kstep; const char* b2 = last ? nB : cB + (size_t)(t + 2) * kstep;
            const char* a3 = a2 + kstep; const char* b3 = b2 + kstep;
            if (last && has_next) S.a_ready(nxt);
            if constexpr (SP2) {
            PG8_LDB(B0, 0, 0); PG8_LDB(B1, 0, 1); PG8_SCHED; PG8_LDA(At, 0, 0); PG8_STAGEA(PG8_SA(1, 1), a1, 1, false);
            PG8_WAIT_V(8); PG8_WAIT_L(0); PG8_BAR; PG8_MMA(0, 0, At, B0); PG8_MMA(0, 1, At, B1); PG8_BAR; PG8_SCHED;
            PG8_LDA(At, 0, 1); PG8_STAGE(PG8_SB(0, 0), b2, voffB); PG8_STAGE(PG8_SB(0, 1), b2 + hstep, voffB); PG8_STAGEA(PG8_SA(0, 0), a2, 0, last);
            PG8_WAIT_V(8); PG8_WAIT_L(0); PG8_BAR; PG8_MMA(1, 0, At, B0); PG8_MMA(1, 1, At, B1); PG8_BAR; PG8_SCHED;
            PG8_LDB(B0, 1, 0); PG8_LDB(B1, 1, 1); PG8_SCHED; PG8_LDA(At, 1, 0); PG8_STAGEA(PG8_SA(0, 1), a2, 1, last);
            PG8_WAIT_V(8); PG8_WAIT_L(0); PG8_BAR; PG8_MMA(0, 0, At, B0); PG8_MMA(0, 1, At, B1); PG8_BAR; PG8_SCHED;
            PG8_LDA(At, 1, 1); PG8_STAGE(PG8_SB(1, 0), b3, voffB); PG8_STAGE(PG8_SB(1, 1), b3 + hstep, voffB); PG8_STAGEA(PG8_SA(1, 0), a3, 0, last);
            PG8_WAIT_V(8); PG8_WAIT_L(0); PG8_BAR; PG8_MMA(1, 0, At, B0); PG8_MMA(1, 1, At, B1); PG8_BAR; PG8_SCHED;
            } else {
            PG8_LDB(B0, 0, 0); PG8_SCHED; PG8_LDA(At, 0, 0); PG8_STAGEA(PG8_SA(1, 1), a1, 1, false);
            PG8_WAIT_L(8); PG8_BAR; PG8_WAIT_L(0); PG8_MMA(0, 0, At, B0); PG8_BAR; PG8_SCHED;
            PG8_LDB(B1, 0, 1); PG8_STAGE(PG8_SB(0, 0), b2, voffB);
            PG8_BAR; PG8_WAIT_L(0); PG8_MMA(0, 1, At, B1); PG8_BAR;
            PG8_LDA(At, 0, 1); PG8_STAGEA(PG8_SA(0, 0), a2, 0, last);
            PG8_BAR; PG8_WAIT_L(0); PG8_MMA(1, 0, At, B0); PG8_BAR; PG8_SCHED;
            PG8_STAGE(PG8_SB(0, 1), b2 + hstep, voffB);
            PG8_WAIT_V(6); PG8_BAR; PG8_MMA(1, 1, At, B1); PG8_BAR;
            PG8_LDB(B0, 1, 0); PG8_SCHED; PG8_LDA(At, 1, 0); PG8_STAGEA(PG8_SA(0, 1), a2, 1, last);
            PG8_WAIT_L(8); PG8_BAR; PG8_WAIT_L(0); PG8_MMA(0, 0, At, B0); PG8_BAR; PG8_SCHED;
            PG8_LDB(B1, 1, 1); PG8_STAGE(PG8_SB(1, 0), b3, voffB);
            PG8_BAR; PG8_WAIT_L(0); PG8_MMA(0, 1, At, B1); PG8_BAR;
            PG8_LDA(At, 1, 1); PG8_STAGEA(PG8_SA(1, 0), a3, 0, last);
            PG8_BAR; PG8_WAIT_L(0); PG8_MMA(1, 0, At, B0); PG8_BAR; PG8_SCHED;
            PG8_STAGE(PG8_SB(1, 1), b3 + hstep, voffB);
            PG8_WAIT_V(6); PG8_BAR; PG8_MMA(1, 1, At, B1); PG8_BAR;
            }
        }
        if constexpr (ALIGN_EPI) { if (wr == 0) PG8_BAR; }
        if constexpr (!Epi::AFTER_DRAIN) { const int l2_ = lane_id_asm(); E(acc, cur, wr, wc, l2_ & 15, l2_ >> 4); S.done(cur); }
        if (!has_next) break;
#pragma unroll
        for (int a = 0; a < 2; ++a)
#pragma unroll
            for (int b = 0; b < 2; ++b)
#pragma unroll
                for (int m = 0; m < 4; ++m)
#pragma unroll
                    for (int n = 0; n < 2; ++n) acc[a][b][m][n] = (f32x4){0.f, 0.f, 0.f, 0.f};
        cur = nxt; cA = nA; cB = nB; ++ui;
        if constexpr (GATHER) { _Pragma("unroll") for (int _h = 0; _h < 2; ++_h) _Pragma("unroll") for (int _i = 0; _i < 2; ++_i) oC[_h][_i] = oN[_h][_i]; }
        if constexpr (ALIGN_EPI) { if (wr == 1) PG8_BAR; }
    }
    PG8_WAIT_V(0);
    if constexpr (!ALIGN_EPI) { if (wr == 0) PG8_BAR; }
    PG8_BAR;
    if constexpr (Epi::AFTER_DRAIN) { const int l2_ = lane_id_asm(); E.fused(acc, cur, wr, wc, l2_ & 15, l2_ >> 4, lds, wid, l2_); S.done(cur); }
#undef PG8_SA
#undef PG8_SB
#undef PG8_STAGE
#undef PG8_STAGEA
#undef PG8_GIDX
#undef PG8_LDA
#undef PG8_LDB
#undef PG8_MMA
#undef PG8_WAIT_V
#undef PG8_WAIT_L
#undef PG8_BAR
#undef PG8_SCHED
}
}

constexpr int DM = 1024, NB = 8, SEQ = 4096, CTXL = 256, DEPTH = 4;
constexpr int ML = NB * SEQ;
constexpr int MC = NB * CTXL;
constexpr int MT = ML + MC;
constexpr int INC = 2560;
constexpr int C_S5 = 768, C_Q = 1024, C_K = 1536, C_V = 2048;
constexpr int NMOD = 6 * DM;
constexpr int NEXP = 32, EHID = 512;
constexpr int NSLOT = (MT * 2 / 256 + NEXP) * 256;
constexpr float EPSF = 1e-6f;
constexpr int S5T = 32;
constexpr int S5ROWS = MT / S5T;
constexpr int S5RP = 1280;
constexpr int NWAVES = 8, NTHR = 512;
constexpr int NPL = 11;
constexpr int PH_LAYER0 = 2, PH_FINAL = PH_LAYER0 + DEPTH * NPL, PH_TOTAL = PH_FINAL + 1;

constexpr size_t MiB = 1u << 20;
constexpr size_t WS_CTL = 0, CTL_ZERO_BYTES = 1 * MiB;
constexpr size_t WS_MODV = 2 * MiB;
constexpr size_t WS_MISC = 3 * MiB;
constexpr size_t WS_ROPE = 4 * MiB;
constexpr size_t WS_H2T = 5 * MiB;
constexpr size_t WS_H2C = 9 * MiB;
constexpr size_t WS_FC = 10 * MiB;
constexpr size_t WS_GLUT = 13 * MiB;
constexpr size_t WS_WINT = 16 * MiB;
constexpr size_t WS_WOUTT = 36 * MiB;
constexpr size_t WS_S5MB = 44 * MiB;
constexpr size_t WS_S5CS = 92 * MiB;
constexpr size_t WS_FSPEC = 108 * MiB;
constexpr size_t WS_X = 172 * MiB;
constexpr size_t WS_H = 308 * MiB;
constexpr size_t WS_MOEW13 = 377 * MiB;
constexpr size_t WS_MOEW2 = 441 * MiB;
constexpr size_t WS_U5 = 473 * MiB;
constexpr size_t WS_YI = 493 * MiB;
constexpr size_t WS_ST = 533 * MiB;
constexpr size_t WS_HIN = 553 * MiB;
constexpr size_t WS_GY = 563 * MiB;
constexpr size_t WS_HYW = 583 * MiB;
constexpr size_t WS_HYWC = 615 * MiB;
constexpr size_t WS_TOK = 617 * MiB;
constexpr size_t WS_R = 620 * MiB;
constexpr size_t WS_P = WS_R;
constexpr size_t WS_QR = WS_R + 170 * MiB;
constexpr size_t WS_MIX = WS_R + 202 * MiB;
constexpr size_t WS_HID = WS_R;
constexpr size_t WS_YB = WS_R + 76 * MiB;
constexpr size_t WS_END = WS_R + 270 * MiB;
constexpr size_t TK_E = 0, TK_POS = TK_E + (size_t)MT * 2 * 4, TK_GATE = TK_POS + (size_t)MT * 2 * 4, TK_SLOT = TK_GATE + (size_t)MT * 2 * 4;
constexpr size_t TK_STOK = TK_SLOT + (size_t)MT * 2 * 4, TK_SGATE = TK_STOK + (size_t)NSLOT * 4, TK_TILEE = TK_SGATE + (size_t)NSLOT * 4, TK_END = TK_TILEE + 4096;
static_assert(TK_END <= 3 * MiB, "routing tables");
constexpr int CW_TMO = 0;
constexpr int CW_BAR = 4096;
constexpr int CW_CNT = 16384;
constexpr int CW_NTILES = 16384 + 1024;

constexpr int LDS_BYTES = 163840;
constexpr int MISC_OFF = 162816;

#define GAS __attribute__((address_space(1)))
#define LAS __attribute__((address_space(3)))
typedef unsigned short bf16;
typedef unsigned v4u __attribute__((ext_vector_type(4)));
typedef unsigned v2u __attribute__((ext_vector_type(2)));
typedef float f32x4 __attribute__((ext_vector_type(4)));
typedef float f32x2 __attribute__((ext_vector_type(2)));
typedef float f32x16 __attribute__((ext_vector_type(16)));
typedef short bf16x8 __attribute__((ext_vector_type(8)));
typedef short s16x4 __attribute__((ext_vector_type(4)));
typedef GAS unsigned gu32;
#define RLX_AGENT __ATOMIC_RELAXED, __HIP_MEMORY_SCOPE_AGENT
#define LDS_WAIT() asm volatile("s_waitcnt lgkmcnt(0)" ::: "memory")
#define VM_WAIT() asm volatile("s_waitcnt vmcnt(0)" ::: "memory")
__device__ __forceinline__ unsigned f2bf(float f) { unsigned u = __builtin_bit_cast(unsigned, f); return (u + 0x7fffu + ((u >> 16) & 1u)) >> 16; }
__device__ __forceinline__ unsigned pk2(float lo, float hi) { return pg8::cvt_pk_bf16(lo, hi); }
__device__ __forceinline__ float bf2f(unsigned short h) { return __builtin_bit_cast(float, (unsigned)h << 16); }
__device__ __forceinline__ float bflo(unsigned w) { return __builtin_bit_cast(float, w << 16); }
__device__ __forceinline__ float bfhi(unsigned w) { return __builtin_bit_cast(float, w & 0xffff0000u); }
__device__ __forceinline__ float fexp(float x) { return __builtin_amdgcn_exp2f(x * 1.4426950408889634f); }
__device__ __forceinline__ float fsigmoid(float x) { return __builtin_amdgcn_rcpf(1.f + fexp(-x)); }
__device__ __forceinline__ float fsilu(float x) { return x * fsigmoid(x); }
__device__ __forceinline__ float fgelu_tanh(float x) { const float u = 0.7978845608028654f * (x + 0.044715f * x * x * x); return x * fsigmoid(2.f * u); }
template <int M> __device__ __forceinline__ float xor_add(float v) {
    if constexpr (M < 32) return v + __builtin_bit_cast(float, __builtin_amdgcn_ds_swizzle(__builtin_bit_cast(int, v), (M << 10) | 0x1f));
    else { auto rr = __builtin_amdgcn_permlane32_swap(__float_as_uint(v), __float_as_uint(v), false, false); const unsigned a = rr[0], b = rr[1]; return __uint_as_float(a) + __uint_as_float(b); }
}
__device__ __forceinline__ float wave_sum(float v) { v = xor_add<1>(v); v = xor_add<2>(v); v = xor_add<4>(v); v = xor_add<8>(v); v = xor_add<16>(v); v = xor_add<32>(v); return v; }
#define XB_TMO      128
#define XB_XCNT(j)  (256  + 64 * (j))
#define XB_XSUB(j)  (1280 + 64 * (j))
#define XB_XGEN(j)  (2304 + 64 * (j))
#define XB_TOP      3328
#define XB_TOPGEN   3392
#define XCD_BAR_WORDS 3456
#define XB_SPIN_CAP (1u << 18)

__device__ __forceinline__ unsigned xb_ld(unsigned* p)              { return __hip_atomic_load(p, __ATOMIC_RELAXED, __HIP_MEMORY_SCOPE_AGENT); }
__device__ __forceinline__ unsigned xb_add(unsigned* p, unsigned v) { return __hip_atomic_fetch_add(p, v, __ATOMIC_RELAXED, __HIP_MEMORY_SCOPE_AGENT); }
__device__ __forceinline__ unsigned xb_xcc_id() { return (unsigned)__builtin_amdgcn_s_getreg((3 << 11) | 20) & 0xFu; }
#define XB_SPIN(cond, bar) do { unsigned _sp = 0; while (cond) { __builtin_amdgcn_s_sleep(1); \
    if ((++_sp & 255u) == 0u) { if (xb_ld(&(bar)[XB_TMO])) break; if (_sp > XB_SPIN_CAP) { atomicAdd(&(bar)[XB_TMO], 1u); break; } } } } while (0)

struct XcdBarrier {
    unsigned* bar; unsigned x;
    volatile LAS unsigned* st;
};

__device__ __forceinline__ XcdBarrier xcd_barrier_post(unsigned* bar, volatile LAS unsigned* st, int tid) {
    XcdBarrier b; b.bar = bar; b.x = xb_xcc_id(); b.st = st;
    if (tid == 0) (void)xb_add(&bar[XB_XCNT(b.x)], 1u);
    return b;
}
__device__ __forceinline__ void xcd_barrier_complete(unsigned* bar, unsigned x, unsigned& nloc, unsigned& nx) {
    const unsigned G = gridDim.x * gridDim.y * gridDim.z;
    unsigned sum, cnt, mine, sp = 0u;
    for (;;) {
        sum = 0u; cnt = 0u; mine = 0u;
#pragma unroll
        for (unsigned j = 0; j < 16; ++j) { const unsigned c = xb_ld(&bar[XB_XCNT(j)]); sum += c; cnt += (c > 0u) ? 1u : 0u; mine = (j == x) ? c : mine; }
        if (sum == G) break;
        __builtin_amdgcn_s_sleep(1);
        if ((++sp & 255u) == 0u) { if (xb_ld(&bar[XB_TMO])) break; if (sp > XB_SPIN_CAP) { atomicAdd(&bar[XB_TMO], 1u); break; } }
    }
    nloc = mine > 0u ? mine : 1u; nx = cnt > 0u ? cnt : 1u;
}

__device__ __forceinline__ void xcd_barrier(const XcdBarrier& b, int tid) {
    asm volatile("s_waitcnt vmcnt(0)" ::: "memory");
    __syncthreads();
    if (tid == 0) {
        unsigned* bar = b.bar;
        __builtin_amdgcn_s_waitcnt(0);
        unsigned nloc = b.st[0], nx = b.st[1];
        if (nloc == 0u) { xcd_barrier_complete(bar, b.x, nloc, nx); b.st[0] = nloc; b.st[1] = nx; }
        const unsigned old = xb_add(&bar[XB_XSUB(b.x)], 1u);
        const unsigned gen = old / nloc;
        if (old + 1u == (gen + 1u) * nloc) {
            __builtin_amdgcn_fence(__ATOMIC_RELEASE, "agent");
            asm volatile("s_waitcnt vmcnt(0)" ::: "memory");
            const unsigned og = xb_add(&bar[XB_TOP], 1u);
            const unsigned tg = og / nx;
            if (og + 1u == (tg + 1u) * nx) xb_add(&bar[XB_TOPGEN], 1u);
            else XB_SPIN(xb_ld(&bar[XB_TOPGEN]) == tg, bar);
            __builtin_amdgcn_fence(__ATOMIC_ACQUIRE, "agent");
            xb_add(&bar[XB_XGEN(b.x)], 1u);
            asm volatile("s_waitcnt vmcnt(0)" ::: "memory");
        } else {
            XB_SPIN(xb_ld(&bar[XB_XGEN(b.x)]) == gen, bar);
            __builtin_amdgcn_fence(__ATOMIC_ACQUIRE, "agent");
            asm volatile("s_waitcnt vmcnt(0)" ::: "memory");
        }
    }
    __syncthreads();
}

struct Args { const float* in[43]; float* out; unsigned char* ws; int ph_lo, ph_hi; };
enum InIdx { I_X = 0, I_C, I_CTX, I_CCTX, I_WMOD, I_BMOD, I_N1G, I_N2G, I_FING, I_WIN, I_WOUT, I_HYCW, I_HYCB, I_HYW1, I_HYB1, I_HYW2, I_HYB2, I_HYW3, I_HYFREQ, I_HYSKIP, I_HYNG,
             I_S5ARE, I_S5AIM, I_S5LDT, I_S5BRE, I_S5BIM, I_S5CRE, I_S5CIM, I_S5D, I_S5GLU, I_S5NG, I_LQ1, I_LK1, I_LQ2, I_LK2, I_SUBLN, I_MWG, I_MBG, I_MWE, I_MBE, I_MW1, I_MW3, I_MW2 };
struct Frame {
    LAS unsigned char* lds;
    float* out; unsigned char* ws; gu32* ctl;
    int tid, lane, wave, vcu, G, bx;
};
#define WSP(T, off) ((T*)(F.ws + (off)))
__device__ __forceinline__ const float* inptr(int idx) { const unsigned long ka = (unsigned long)__builtin_amdgcn_kernarg_segment_ptr(); const float* p;
    asm volatile("s_load_dwordx2 %0, %1, %2\n\ts_waitcnt lgkmcnt(0)" : "=s"(p) : "s"(ka), "n"(idx * 8)); return p; }

template <class RowMap>
__device__ __forceinline__ void transpose_item(const float* W, int K, int N, bf16* WT, LAS float* scr, int item, int lane, const RowMap& rowmap) {
    const int nblk = N / 32, kb = item / nblk, nb = item % nblk, k0 = 64 * kb, n0 = 32 * nb;
#pragma unroll 8
    for (int i = 0; i < 32; ++i) { const int kk = 2 * i + (lane >> 5); scr[kk * 33 + (lane & 31)] = W[(size_t)(k0 + kk) * N + n0 + (lane & 31)]; }
    LDS_WAIT(); asm volatile("" ::: "memory");
    const int c = lane & 7;
#pragma unroll
    for (int j = 0; j < 4; ++j) { const int n = (lane >> 3) + 8 * j; const LAS float* s = scr + (8 * c) * 33 + n;
        v4u o; o.x = pk2(s[0 * 33], s[1 * 33]); o.y = pk2(s[2 * 33], s[3 * 33]); o.z = pk2(s[4 * 33], s[5 * 33]); o.w = pk2(s[6 * 33], s[7 * 33]);
        *(GAS v4u*)(WT + (size_t)rowmap(n0 + n) * K + k0 + 8 * c) = o; }
    LDS_WAIT(); asm volatile("" ::: "memory");
}
struct RowId { __device__ __forceinline__ int operator()(int n) const { return n; } };
struct RowWin {
    __device__ __forceinline__ int operator()(int n) const { if (n < C_Q || n >= C_V) return n; const int d = n & 63, j = d & 31, s = d >> 5; return (n - d) + 2 * j + s; } };
struct RowW13 { int off; __device__ __forceinline__ int operator()(int j) const { return (j >> 7) * 256 + off + (j & 127); } };

__device__ __forceinline__ void p0_modv(Frame& F) {
    const float* const in_BMOD = inptr(I_BMOD);
    const float* const in_C = inptr(I_C);
    const float* const in_CCTX = inptr(I_CCTX);
    const float* const in_WMOD = inptr(I_WMOD);
    LAS float* sc = (LAS float*)F.lds;
    LAS float* red = (LAS float*)(F.lds + 36864);
    for (int i = F.tid; i < 9 * 1024; i += NTHR) { const int bi = i >> 10, k = i & 1023; const float v = bi < 8 ? in_C[bi * 1024 + k] : in_CCTX[k]; sc[i] = fsilu(v); }
    __syncthreads();
    for (int unit = F.vcu; unit < DEPTH * 48; unit += F.G) {
        const int l = unit / 48, cb = unit % 48, c4 = F.tid & 31, kk = F.tid >> 5;
        f32x4 acc[9];
#pragma unroll
        for (int b = 0; b < 9; ++b) acc[b] = (f32x4){0.f, 0.f, 0.f, 0.f};
        const float* wb = in_WMOD + (size_t)l * DM * NMOD + cb * 128 + c4 * 4;
#pragma unroll 4
        for (int i = 0; i < 64; ++i) { const int k = kk + 16 * i; const f32x4 w = *(const f32x4*)(wb + (size_t)k * NMOD);
#pragma unroll
            for (int b = 0; b < 9; ++b) acc[b] += sc[b * 1024 + k] * w; }
#pragma unroll
        for (int b = 0; b < 9; ++b) *(LAS f32x4*)(red + (kk * 9 + b) * 128 + c4 * 4) = acc[b];
        __syncthreads();
        for (int o = F.tid; o < 9 * 128; o += NTHR) { const int b = o >> 7, cc = o & 127; float s = in_BMOD[l * NMOD + cb * 128 + cc];
#pragma unroll
            for (int q = 0; q < 16; ++q) s += red[(q * 9 + b) * 128 + cc];
            WSP(float, WS_MODV)[(size_t)(l * 9 + b) * NMOD + cb * 128 + cc] = s; }
        __syncthreads();
    }
    __syncthreads();
}
__device__ __forceinline__ void p0_weights(Frame& F) {
    const float* const in_S5GLU = inptr(I_S5GLU);
    const float* const in_WIN = inptr(I_WIN);
    const float* const in_WOUT = inptr(I_WOUT);
    LAS float* scr = (LAS float*)(F.lds + F.wave * 8448);
    const int gw = F.vcu * NWAVES + F.wave, NGW = F.G * NWAVES;
    constexpr int I_IN = (DM / 64) * (INC / 32), I_OUT = (DM / 64) * (DM / 32), I_GLU = (256 / 64) * (256 / 32);
    constexpr int NIT = DEPTH * (I_IN + I_OUT + I_GLU);
    for (int it = gw; it < NIT; it += NGW) {
        int r = it; const int l = r / (I_IN + I_OUT + I_GLU); r -= l * (I_IN + I_OUT + I_GLU);
        if (r < I_IN) { transpose_item(in_WIN + (size_t)l * DM * INC, DM, INC, WSP(bf16, WS_WINT) + (size_t)l * INC * DM, scr, r, F.lane, RowWin{}); continue; } r -= I_IN;
        if (r < I_OUT) { transpose_item(in_WOUT + (size_t)l * DM * DM, DM, DM, WSP(bf16, WS_WOUTT) + (size_t)l * DM * DM, scr, r, F.lane, RowId{}); continue; } r -= I_OUT;
        transpose_item(in_S5GLU + (size_t)l * 65536, 256, 256, WSP(bf16, WS_GLUT) + (size_t)l * 65536, scr, r, F.lane, RowId{});
    }
}
__device__ __forceinline__ void moe_weights(Frame& F, int l) {
    const float* const in_MW1 = inptr(I_MW1);
    const float* const in_MW2 = inptr(I_MW2);
    const float* const in_MW3 = inptr(I_MW3);
    LAS float* scr = (LAS float*)(F.lds + F.wave * 8448);
    const int gw = F.vcu * NWAVES + F.wave, NGW = F.G * NWAVES;
    constexpr int I_1 = (DM / 64) * (EHID / 32), I_2 = (EHID / 64) * (DM / 32);
    for (int it = gw; it < NEXP * (2 * I_1 + I_2); it += NGW) {
        const int e = it / (2 * I_1 + I_2); int r = it - e * (2 * I_1 + I_2);
        const size_t eo = (size_t)(l * NEXP + e) * DM * EHID;
        if (r < I_1) { transpose_item(in_MW1 + eo, DM, EHID, WSP(bf16, WS_MOEW13) + (size_t)e * 1024 * 1024, scr, r, F.lane, RowW13{0}); continue; } r -= I_1;
        if (r < I_1) { transpose_item(in_MW3 + eo, DM, EHID, WSP(bf16, WS_MOEW13) + (size_t)e * 1024 * 1024, scr, r, F.lane, RowW13{128}); continue; } r -= I_1;
        transpose_item(in_MW2 + eo, EHID, DM, WSP(bf16, WS_MOEW2) + (size_t)e * 1024 * 512, scr, r, F.lane, RowId{});
    }
}
__device__ __forceinline__ void p0_h2(Frame& F) {
    const float* const in_HYB1 = inptr(I_HYB1);
    const float* const in_HYB2 = inptr(I_HYB2);
    const float* const in_HYFREQ = inptr(I_HYFREQ);
    const float* const in_HYW1 = inptr(I_HYW1);
    const float* const in_HYW2 = inptr(I_HYW2);
    LAS float* feat = (LAS float*)F.lds;
    LAS float* h1 = feat + 8 * 33;
    constexpr int UPL = (SEQ + CTXL) / 8;
    for (int unit = F.vcu; unit < DEPTH * UPL; unit += F.G) {
        const int l = unit / UPL, ub = unit % UPL; const bool isc = ub >= SEQ / 8; const int pos0 = isc ? (ub - SEQ / 8) * 8 : ub * 8; const float invL = isc ? 1.f / CTXL : 1.f / SEQ;
        if (F.tid < 8 * 33) { const int p = F.tid / 33, j = F.tid % 33; const float t = (float)(pos0 + p) * invL; float v;
            if (j == 0) v = t; else { const int m = j <= 16 ? j : j - 16; const float ang = 6.283185307179586f * t * (float)m; v = j <= 16 ? cosf(ang) : sinf(ang); }
            feat[F.tid] = v; }
        __syncthreads();
        const int p = F.tid >> 6, k = F.tid & 63;
        { float s = in_HYB1[l * 64 + k]; const float* w1 = in_HYW1 + (size_t)l * 33 * 64 + k;
#pragma unroll
          for (int j = 0; j < 33; ++j) s += feat[p * 33 + j] * w1[j * 64];
          h1[p * 64 + k] = sinf(in_HYFREQ[l * 64 + k] * s); }
        __syncthreads();
        { float s = in_HYB2[l * 64 + k]; const float* w2 = in_HYW2 + (size_t)l * 64 * 64 + k;
#pragma unroll 8
          for (int j = 0; j < 64; ++j) s += h1[p * 64 + j] * w2[j * 64];
          const float v = sinf(in_HYFREQ[l * 64 + k] * s);
          if (isc) WSP(float, WS_H2C)[((size_t)l * CTXL + pos0 + p) * 64 + k] = v; else WSP(float, WS_H2T)[((size_t)l * SEQ + pos0 + p) * 64 + k] = v; }
        __syncthreads();
    }
}
__device__ __forceinline__ void p0_misc(Frame& F) {
    const float* const in_LK1 = inptr(I_LK1);
    const float* const in_LK2 = inptr(I_LK2);
    const float* const in_LQ1 = inptr(I_LQ1);
    const float* const in_LQ2 = inptr(I_LQ2);
    for (int i = F.vcu * NTHR + F.tid; i < SEQ * 32; i += F.G * NTHR) { const int t = i >> 5, j = i & 31; const float inv = powf(10000.f, -(float)(j & 15) / 16.f);
        const float ang = (float)(j < 16 ? (t >> 6) : (t & 63)) * inv; WSP(f32x2, WS_ROPE)[i] = (f32x2){cosf(ang), sinf(ang)}; }
    if (F.bx == 0) {
        if (F.tid < DEPTH) { const int l = F.tid; float s1 = 0.f, s2 = 0.f;
            for (int d = 0; d < 64; ++d) { s1 += in_LQ1[l * 64 + d] * in_LK1[l * 64 + d]; s2 += in_LQ2[l * 64 + d] * in_LK2[l * 64 + d]; }
            const float li = 0.8f - 0.6f * expf(-0.3f * (float)l);
            WSP(float, WS_MISC)[l] = expf(s1) - expf(s2) + li; WSP(float, WS_MISC)[4 + l] = 1.f - li; }
        for (int i = F.tid; i < DM / 2; i += NTHR) WSP(unsigned, WS_H)[(size_t)MT * (DM / 2) + i] = 0u;
    }
}
__device__ __forceinline__ void p0_s5(Frame& F) {
    const float* const in_S5AIM = inptr(I_S5AIM);
    const float* const in_S5ARE = inptr(I_S5ARE);
    const float* const in_S5BIM = inptr(I_S5BIM);
    const float* const in_S5BRE = inptr(I_S5BRE);
    const float* const in_S5CIM = inptr(I_S5CIM);
    const float* const in_S5CRE = inptr(I_S5CRE);
    const float* const in_S5D = inptr(I_S5D);
    const float* const in_S5LDT = inptr(I_S5LDT);
    LAS f32x2* ap = (LAS f32x2*)F.lds;
    LAS f32x2* bb = ap + 2 * 33 * 64;
    LAS f32x2* cc = bb + 2 * 64 * 16;
    LAS float* kt = (LAS float*)(cc + 2 * 16 * 64);
    for (int unit = F.vcu; unit < DEPTH * 16; unit += F.G) {
        const int l = unit >> 4, g = unit & 15;
        for (int i = F.tid; i < 2 * 33 * 64; i += NTHR) { const int d = i / (33 * 64), tau = (i / 64) % 33, p = i & 63; const int pi = ((l * 2 + d) * 16 + g) * 64 + p;
            const float dt = expf(in_S5LDT[(l * 2 + d) * 16 + g]); const float xr = (float)tau * dt * in_S5ARE[pi], xi = (float)tau * dt * in_S5AIM[pi];
            const float m = expf(xr); ap[i] = (f32x2){m * cosf(xi), m * sinf(xi)}; }
        for (int i = F.tid; i < 2 * 64 * 16; i += NTHR) { const int d = i >> 10, p = (i >> 4) & 63, h = i & 15; const int pi = ((l * 2 + d) * 16 + g) * 64 + p;
            const float dt = expf(in_S5LDT[(l * 2 + d) * 16 + g]); const float ar = in_S5ARE[pi], ai = in_S5AIM[pi];
            const float m = expf(dt * ar); const float er = m * cosf(dt * ai) - 1.f, ei = m * sinf(dt * ai);
            const float den = 1.f / (ar * ar + ai * ai); const float cr = (er * ar + ei * ai) * den, ci = (ei * ar - er * ai) * den;
            const float br = in_S5BRE[(size_t)pi * 16 + h], bi = in_S5BIM[(size_t)pi * 16 + h];
            bb[i] = (f32x2){cr * br - ci * bi, cr * bi + ci * br}; }
        for (int i = F.tid; i < 2 * 16 * 64; i += NTHR) { const int d = i >> 10, h = (i >> 6) & 15, p = i & 63; const size_t ci = ((size_t)((l * 2 + d) * 16 + g) * 16 + h) * 64 + p;
            cc[i] = (f32x2){in_S5CRE[ci], in_S5CIM[ci]}; }
        __syncthreads();
        for (int i = F.tid; i < 2 * 32 * 256; i += NTHR) { const int d = i >> 13, tau = (i >> 8) & 31, h = (i >> 4) & 15, h2 = i & 15; float s = 0.f;
            for (int p = 0; p < 64; ++p) { const f32x2 c = cc[(d * 16 + h) * 64 + p], a = ap[(d * 33 + tau) * 64 + p], b = bb[(d * 64 + p) * 16 + h2];
                const float tr = c.x * a.x - c.y * a.y, ti = c.x * a.y + c.y * a.x; s += tr * b.x - ti * b.y; }
            kt[i] = s; }
        __syncthreads();
        bf16* MB = WSP(bf16, WS_S5MB) + (size_t)(l * 16 + g) * 768 * 512;
        bf16* CS = WSP(bf16, WS_S5CS) + (size_t)(l * 16 + g) * 512 * 256;
        for (int i = F.tid; i < 512 * 64; i += NTHR) { const int n = i >> 6, k8 = (i & 63) * 8, t = n >> 4, h = n & 15, s = k8 >> 4, h0 = k8 & 15; float v[8];
#pragma unroll
            for (int j = 0; j < 8; ++j) { float x = 0.f; if (t >= s) x += kt[((0 * 32 + (t - s)) * 16 + h) * 16 + h0 + j]; if (s >= t) x += kt[((1 * 32 + (s - t)) * 16 + h) * 16 + h0 + j];
                if (t == s && h == h0 + j) x += in_S5D[l * 256 + g * 16 + h]; v[j] = x; }
            *(GAS v4u*)(MB + (size_t)n * 512 + k8) = (v4u){pk2(v[0], v[1]), pk2(v[2], v[3]), pk2(v[4], v[5]), pk2(v[6], v[7])}; }
        for (int i = F.tid; i < 256 * 64; i += NTHR) { const int n = i >> 6, k8 = (i & 63) * 8, d = n >> 7, im = (n >> 6) & 1, p = n & 63, s = k8 >> 4, h0 = k8 & 15; float v[8];
            const f32x2 a = ap[(d * 33 + (d == 0 ? 31 - s : s)) * 64 + p];
#pragma unroll
            for (int j = 0; j < 8; ++j) { const f32x2 b = bb[(d * 64 + p) * 16 + h0 + j]; v[j] = im ? (a.x * b.y + a.y * b.x) : (a.x * b.x - a.y * b.y); }
            *(GAS v4u*)(MB + (size_t)(512 + n) * 512 + k8) = (v4u){pk2(v[0], v[1]), pk2(v[2], v[3]), pk2(v[4], v[5]), pk2(v[6], v[7])}; }
        for (int i = F.tid; i < 512 * 32; i += NTHR) { const int n = i >> 5, k8 = (i & 31) * 8, t = n >> 4, h = n & 15, d = k8 >> 7, im = (k8 >> 6) & 1, p0 = k8 & 63; float v[8];
#pragma unroll
            for (int j = 0; j < 8; ++j) { const f32x2 c = cc[(d * 16 + h) * 64 + p0 + j], a = ap[(d * 33 + (d == 0 ? t + 1 : 32 - t)) * 64 + p0 + j];
                v[j] = im ? -(c.x * a.y + c.y * a.x) : (c.x * a.x - c.y * a.y); }
            *(GAS v4u*)(CS + (size_t)n * 256 + k8) = (v4u){pk2(v[0], v[1]), pk2(v[2], v[3]), pk2(v[4], v[5]), pk2(v[6], v[7])}; }
        __syncthreads();
    }
}

__device__ __forceinline__ f32x2 cmul(f32x2 a, f32x2 b) { return (f32x2){a.x * b.x - a.y * b.y, a.x * b.y + a.y * b.x}; }
__device__ __forceinline__ f32x2 twid(int p, float invB) { const float x = (float)p * invB; return (f32x2){__builtin_amdgcn_cosf(x), -__builtin_amdgcn_sinf(x)}; }
template <bool INV> __device__ __forceinline__ void bfly(f32x2& a, f32x2& b, f32x2 w) {
    if (!INV) { const f32x2 s = a + b, d = a - b; a = s; b = cmul(d, w); }
    else { const f32x2 t = cmul(b, (f32x2){w.x, -w.y}); const f32x2 s = a + t, d = a - t; a = s; b = d; }
}
template <bool INV> __device__ __forceinline__ void fft_r8(LAS f32x2* buf, int B, int tid) {
    const int S = B >> 3; const float iB = 1.f / (float)B;
#pragma unroll 1
    for (int gi = tid; gi < 1024; gi += NTHR) {
        const int blk = gi / S, j = gi - blk * S, base = blk * B + j;
        f32x2 x[8];
#pragma unroll
        for (int k = 0; k < 8; ++k) x[k] = buf[base + k * S];
        if (!INV) {
#pragma unroll
            for (int k = 0; k < 4; ++k) bfly<false>(x[k], x[k + 4], twid(j + k * S, iB));
#pragma unroll
            for (int hh = 0; hh < 8; hh += 4)
#pragma unroll
                for (int k = 0; k < 2; ++k) bfly<false>(x[hh + k], x[hh + k + 2], twid(j + k * S, 2.f * iB));
            const f32x2 w = twid(j, 4.f * iB);
#pragma unroll
            for (int q = 0; q < 8; q += 2) bfly<false>(x[q], x[q + 1], w);
        } else {
            const f32x2 w = twid(j, 4.f * iB);
#pragma unroll
            for (int q = 0; q < 8; q += 2) bfly<true>(x[q], x[q + 1], w);
#pragma unroll
            for (int hh = 0; hh < 8; hh += 4)
#pragma unroll
                for (int k = 0; k < 2; ++k) bfly<true>(x[hh + k], x[hh + k + 2], twid(j + k * S, 2.f * iB));
#pragma unroll
            for (int k = 0; k < 4; ++k) bfly<true>(x[k], x[k + 4], twid(j + k * S, iB));
        }
#pragma unroll
        for (int k = 0; k < 8; ++k) buf[base + k * S] = x[k];
    }
    __syncthreads();
}
__device__ __forceinline__ void fft_r2(LAS f32x2* buf, int tid) {
    for (int i = tid; i < 4096; i += NTHR) { const f32x2 a = buf[2 * i], b = buf[2 * i + 1]; buf[2 * i] = a + b; buf[2 * i + 1] = a - b; }
    __syncthreads();
}
__device__ __forceinline__ void fft_fwd(LAS f32x2* buf, int tid) { fft_r8<false>(buf, 8192, tid); fft_r8<false>(buf, 1024, tid); fft_r8<false>(buf, 128, tid); fft_r8<false>(buf, 16, tid); fft_r2(buf, tid); }
__device__ __forceinline__ void fft_inv(LAS f32x2* buf, int tid) { fft_r2(buf, tid); fft_r8<true>(buf, 16, tid); fft_r8<true>(buf, 128, tid); fft_r8<true>(buf, 1024, tid); fft_r8<true>(buf, 8192, tid); }

constexpr float HY_DMIN = 3.0701134573253946f, HY_DMAX = 15.350567286626973f;
__device__ __forceinline__ float block_sum(float v, LAS float* red, int tid) {
    v = wave_sum(v); __syncthreads(); if ((tid & 63) == 0) red[tid >> 6] = v; __syncthreads();
    float s = 0.f;
#pragma unroll
    for (int w = 0; w < NWAVES; ++w) s += red[w];
    return s;
}
__device__ __forceinline__ void p0_filters(Frame& F) {
    const float* const in_HYSKIP = inptr(I_HYSKIP);
    const float* const in_HYW3 = inptr(I_HYW3);
    LAS f32x2* buf = (LAS f32x2*)F.lds; LAS float* w3s = (LAS float*)(F.lds + 65536); LAS float* red = w3s + 128;
    for (int unit = F.vcu; unit < DEPTH * 256; unit += F.G) {
        const int l = unit >> 8, c = unit & 255;
        if (F.tid < 128) w3s[F.tid] = in_HYW3[(size_t)l * 64 * 512 + (F.tid & 63) * 512 + (F.tid >> 6) * 256 + c];
        __syncthreads();
        const float decay = HY_DMIN + (HY_DMAX - HY_DMIN) * (float)c / 255.f;
        float asum = 0.f; float vals[16];
#pragma unroll 1
        for (int i = 0; i < 16; ++i) { const int n = F.tid + NTHR * i; float v = 0.f;
            if (n != SEQ) { const int pos = n < SEQ ? n : 2 * SEQ - n; const LAS float* w = w3s + (n < SEQ ? 0 : 64); const f32x4* hp = (const f32x4*)(WSP(float, WS_H2T) + ((size_t)l * SEQ + pos) * 64);
                float s = 0.f;
#pragma unroll
                for (int q = 0; q < 16; ++q) { const f32x4 h = hp[q]; s += h.x * w[4 * q] + h.y * w[4 * q + 1] + h.z * w[4 * q + 2] + h.w * w[4 * q + 3]; }
                v = s * expf(-((float)pos / (float)SEQ) * decay); }
            buf[n] = (f32x2){v, 0.f}; asum += fabsf(v); }
        (void)vals;
        const float tot = block_sum(asum, red, F.tid); const float nrm = 1.f / (tot + EPSF);
        for (int i = 0; i < 16; ++i) { const int n = F.tid + NTHR * i; f32x2 v = buf[n]; v.x = v.x * nrm + (n == 0 ? in_HYSKIP[l * 256 + c] : 0.f); buf[n] = v; }
        __syncthreads();
        fft_fwd(buf, F.tid);
        f32x2* dst = WSP(f32x2, WS_FSPEC) + (size_t)unit * 8192;
        for (int i = F.tid; i < 8192; i += NTHR) dst[i] = buf[i] * (1.f / 8192.f);
        __syncthreads();
    }
    LAS float* red2 = (LAS float*)(F.lds + 1024);
    LAS float* w3c = (LAS float*)F.lds;
    for (int unit = F.vcu; unit < DEPTH * 256; unit += F.G) {
        const int l = unit >> 8, c = unit & 255, n = F.tid;
        if (F.tid < 128) w3c[F.tid] = in_HYW3[(size_t)l * 64 * 512 + (F.tid & 63) * 512 + (F.tid >> 6) * 256 + c];
        __syncthreads();
        const float decay = HY_DMIN + (HY_DMAX - HY_DMIN) * (float)c / 255.f; float v = 0.f;
        if (n != CTXL) { const int pos = n < CTXL ? n : 2 * CTXL - n; const LAS float* w = w3c + (n < CTXL ? 0 : 64); const float* hp = WSP(float, WS_H2C) + ((size_t)l * CTXL + pos) * 64; float s = 0.f;
            for (int q = 0; q < 64; ++q) s += hp[q] * w[q];
            v = s * expf(-((float)pos / (float)CTXL) * decay); }
        const float tot = block_sum(fabsf(v), red2, F.tid);
        WSP(float, WS_FC)[(size_t)unit * 512 + n] = v / (tot + EPSF) + (n == 0 ? in_HYSKIP[l * 256 + c] : 0.f);
        __syncthreads();
    }
}
__device__ __forceinline__ float sconv(const bf16* P, int r0, int len, int t, int col, float w0, float w1, float w2, float bias) {
    const bf16* p = P + (size_t)(r0 + t) * INC + col;
    const float a = t > 0 ? bf2f(p[-INC]) : 0.f, b = bf2f(p[0]), c = t + 1 < len ? bf2f(p[INC]) : 0.f;
    return a * w0 + b * w1 + c * w2 + bias;
}
__device__ __forceinline__ void hyena_unit(Frame& F, int l, int unit) {
    const float* const in_HYCB = inptr(I_HYCB);
    const float* const in_HYCW = inptr(I_HYCW);
    LAS f32x2* buf = (LAS f32x2*)F.lds;
    const int c = unit >> 2, bp = unit & 3; const bf16* P = WSP(bf16, WS_P);
    const float* cw = in_HYCW + (size_t)l * 3 * 768; const float* cb = in_HYCB + (size_t)l * 768;
    const float a0 = cw[256 + c], a1 = cw[768 + 256 + c], a2 = cw[1536 + 256 + c], ab = cb[256 + c];
    const float v0 = cw[512 + c], v1 = cw[768 + 512 + c], v2 = cw[1536 + 512 + c], vb = cb[512 + c];
    for (int i = 0; i < 8; ++i) { const int t = F.tid + NTHR * i; float z[2];
#pragma unroll
        for (int q = 0; q < 2; ++q) { const int r0 = (2 * bp + q) * SEQ; z[q] = sconv(P, r0, SEQ, t, 256 + c, a0, a1, a2, ab) * sconv(P, r0, SEQ, t, 512 + c, v0, v1, v2, vb); }
        buf[t] = (f32x2){z[0], z[1]}; buf[SEQ + t] = (f32x2){0.f, 0.f}; }
    __syncthreads();
    fft_fwd(buf, F.tid);
    const f32x2* fs = WSP(f32x2, WS_FSPEC) + (size_t)(l * 256 + c) * 8192;
    for (int i = F.tid; i < 8192; i += NTHR) buf[i] = cmul(buf[i], fs[i]);
    __syncthreads();
    fft_inv(buf, F.tid);
    float* o0 = WSP(float, WS_HYW) + ((size_t)(2 * bp) * 256 + c) * SEQ; float* o1 = o0 + (size_t)256 * SEQ;
    for (int t = F.tid; t < SEQ; t += NTHR) { const f32x2 v = buf[t]; o0[t] = v.x; o1[t] = v.y; }
    __syncthreads();
}
__device__ __forceinline__ void hyena_ctx_unit(Frame& F, int l, int c) {
    const float* const in_HYCB = inptr(I_HYCB);
    const float* const in_HYCW = inptr(I_HYCW);
    LAS float* z = (LAS float*)F.lds; LAS float* fc = z + NB * CTXL; const bf16* P = WSP(bf16, WS_P);
    const float* cw = in_HYCW + (size_t)l * 3 * 768; const float* cb = in_HYCB + (size_t)l * 768;
    const float a0 = cw[256 + c], a1 = cw[768 + 256 + c], a2 = cw[1536 + 256 + c], ab = cb[256 + c];
    const float v0 = cw[512 + c], v1 = cw[768 + 512 + c], v2 = cw[1536 + 512 + c], vb = cb[512 + c];
    fc[F.tid] = WSP(float, WS_FC)[(size_t)(l * 256 + c) * 512 + F.tid];
    for (int i = F.tid; i < NB * CTXL; i += NTHR) { const int b = i >> 8, t = i & 255; const int r0 = ML + b * CTXL;
        z[i] = sconv(P, r0, CTXL, t, 256 + c, a0, a1, a2, ab) * sconv(P, r0, CTXL, t, 512 + c, v0, v1, v2, vb); }
    __syncthreads();
    for (int i = F.tid; i < NB * CTXL; i += NTHR) { const int b = i >> 8, t = i & 255; float s = 0.f;
        for (int k = 0; k < CTXL; ++k) s += fc[(t - k) & 511] * z[b * CTXL + k];
        WSP(float, WS_HYWC)[((size_t)b * 256 + c) * CTXL + t] = s; }
    __syncthreads();
}
__device__ __forceinline__ void hyena_fin_unit(Frame& F, int l, int unit) {
    const float* const in_HYCB = inptr(I_HYCB);
    const float* const in_HYCW = inptr(I_HYCW);
    const float* const in_HYNG = inptr(I_HYNG);
    LAS float* wt = (LAS float*)F.lds;
    const int r0 = unit * 64; const bool isc = r0 >= ML; const int b = isc ? (r0 - ML) / CTXL : r0 / SEQ; const int len = isc ? CTXL : SEQ;
    const int seq0 = isc ? ML + b * CTXL : b * SEQ, t0 = r0 - seq0;
    const float* src = isc ? WSP(float, WS_HYWC) + (size_t)b * 256 * CTXL : WSP(float, WS_HYW) + (size_t)b * 256 * SEQ;
    for (int i = F.tid; i < 256 * 16; i += NTHR) { const int c = i >> 4, q = i & 15; const f32x4 v = *(const f32x4*)(src + (size_t)c * len + t0 + 4 * q);
        wt[c * 65 + 4 * q] = v.x; wt[c * 65 + 4 * q + 1] = v.y; wt[c * 65 + 4 * q + 2] = v.z; wt[c * 65 + 4 * q + 3] = v.w; }
    __syncthreads();
    const bf16* P = WSP(bf16, WS_P); const float* cw = in_HYCW + (size_t)l * 3 * 768; const float* cb = in_HYCB + (size_t)l * 768;
    for (int tt = 0; tt < 8; ++tt) { const int tl = F.wave * 8 + tt, t = t0 + tl; float v[4]; float ss = 0.f;
#pragma unroll
        for (int j = 0; j < 4; ++j) { const int c = F.lane + 64 * j; const float x0 = sconv(P, seq0, len, t, c, cw[c], cw[768 + c], cw[1536 + c], cb[c]); v[j] = x0 * wt[c * 65 + tl]; ss += v[j] * v[j]; }
        const float rs = rsqrtf(wave_sum(ss) * (1.f / 256.f) + EPSF);
#pragma unroll
        for (int j = 0; j < 4; ++j) { const int c = F.lane + 64 * j; WSP(bf16, WS_MIX)[(size_t)(r0 + tl) * DM + c] = (bf16)f2bf(v[j] * rs * in_HYNG[l * 256 + c]); }
    }
    __syncthreads();
}

__device__ __forceinline__ void n1_phase(Frame& F, int l) {
    const float* const in_CTX = inptr(I_CTX);
    const float* const in_FING = inptr(I_FING);
    const float* const in_N1G = inptr(I_N1G);
    const float* const in_X = inptr(I_X);
    const int gw = F.vcu * NWAVES + F.wave, NGW = F.G * NWAVES;
    const int nrows = l == DEPTH ? ML : MT;
    for (int r = gw; r < nrows; r += NGW) {
        const int bi = r < ML ? r >> 12 : 8;
        f32x4 v[4];
        if (l == 0) { const float* src = r < ML ? in_X + (size_t)r * DM : in_CTX + (size_t)(r - ML) * DM;
#pragma unroll
            for (int j = 0; j < 4; ++j) v[j] = *(const f32x4*)(src + 4 * F.lane + 256 * j);
        } else {
            const float* src = WSP(float, WS_X) + (size_t)r * DM; const int* ts = (const int*)(F.ws + WS_TOK + TK_SLOT) + 2 * r; const int sa = ts[0], sb = ts[1];
            const bf16* ya = WSP(bf16, WS_YB) + (size_t)sa * DM; const bf16* yb = WSP(bf16, WS_YB) + (size_t)sb * DM;
            const float* g2 = WSP(float, WS_MODV) + (size_t)((l - 1) * 9 + bi) * NMOD + 5 * DM;
#pragma unroll
            for (int j = 0; j < 4; ++j) { const int c = 4 * F.lane + 256 * j; const f32x4 x = *(const f32x4*)(src + c), g = *(const f32x4*)(g2 + c);
                const v2u a = *(const v2u*)(ya + c), b = *(const v2u*)(yb + c);
                v[j] = x + g * (f32x4){bflo(a.x) + bflo(b.x), bfhi(a.x) + bfhi(b.x), bflo(a.y) + bflo(b.y), bfhi(a.y) + bfhi(b.y)}; }
        }
        float ss = 0.f;
#pragma unroll
        for (int j = 0; j < 4; ++j) ss += v[j].x * v[j].x + v[j].y * v[j].y + v[j].z * v[j].z + v[j].w * v[j].w;
        const float rs = rsqrtf(wave_sum(ss) * (1.f / DM) + EPSF);
        if (l == DEPTH) {
#pragma unroll
            for (int j = 0; j < 4; ++j) { const int c = 4 * F.lane + 256 * j; *(f32x4*)(F.out + (size_t)r * DM + c) = v[j] * rs * *(const f32x4*)(in_FING + c); }
        } else {
            const float* mv = WSP(float, WS_MODV) + (size_t)(l * 9 + bi) * NMOD; const float* ng = in_N1G + l * DM;
#pragma unroll
            for (int j = 0; j < 4; ++j) { const int c = 4 * F.lane + 256 * j; *(f32x4*)(WSP(float, WS_X) + (size_t)r * DM + c) = v[j];
                const f32x4 h = v[j] * rs * *(const f32x4*)(ng + c) * (1.f + *(const f32x4*)(mv + DM + c)) + *(const f32x4*)(mv + c);
                *(v2u*)(WSP(bf16, WS_H) + (size_t)r * DM + c) = (v2u){pk2(h.x, h.y), pk2(h.z, h.w)}; }
        }
    }
}
__device__ __forceinline__ void n2r_phase(Frame& F, int l) {
    const float* const in_MBE = inptr(I_MBE);
    const float* const in_MBG = inptr(I_MBG);
    const float* const in_MWE = inptr(I_MWE);
    const float* const in_MWG = inptr(I_MWG);
    const float* const in_N2G = inptr(I_N2G);
    LAS float* wl = (LAS float*)F.lds;
    for (int i = F.tid; i < 1024 * 36; i += NTHR) { const int k = i / 36, n = i - k * 36; wl[i] = n < 32 ? in_MWE[((size_t)l * DM + k) * 32 + n] : in_MWG[((size_t)l * DM + k) * 4 + (n - 32)]; }
    __syncthreads();
    const int gw = F.vcu * NWAVES + F.wave, NGW = F.G * NWAVES, rr = F.lane & 15, q = F.lane >> 4;
    const float* ng = in_N2G + l * DM;
    gu32* cnt = F.ctl + CW_CNT + l * 64;
    for (int grp = gw; grp < MT / 16; grp += NGW) {
        const int r = grp * 16 + rr; const int bi = r < ML ? r >> 12 : 8;
        const float* xr = WSP(float, WS_X) + (size_t)r * DM + 256 * q; const float* mv = WSP(float, WS_MODV) + (size_t)(l * 9 + bi) * NMOD;
        float ss = 0.f;
#pragma unroll 8
        for (int s = 0; s < 64; ++s) { const f32x4 x = *(const f32x4*)(xr + 4 * s); ss += x.x * x.x + x.y * x.y + x.z * x.z + x.w * x.w; }
        ss = xor_add<16>(ss); ss = xor_add<32>(ss);
        const float rs = rsqrtf(ss * (1.f / DM) + EPSF);
        f32x4 d0 = {0.f, 0.f, 0.f, 0.f}, d1 = d0, d2 = d0;
        bf16* hrow = WSP(bf16, WS_H) + (size_t)r * DM + 256 * q;
#pragma unroll 2
        for (int s = 0; s < 64; ++s) { const int c = 256 * q + 4 * s; const f32x4 x = *(const f32x4*)(xr + 4 * s);
            const f32x4 h = x * rs * *(const f32x4*)(ng + c) * (1.f + *(const f32x4*)(mv + 4 * DM + c)) + *(const f32x4*)(mv + 3 * DM + c);
            *(v2u*)(hrow + 4 * s) = (v2u){pk2(h.x, h.y), pk2(h.z, h.w)};
#pragma unroll
            for (int e = 0; e < 4; ++e) { const LAS float* wk = wl + (c + e) * 36 + rr; const float hv = h[e];
                const float w0 = wk[0], w1 = wk[16], w2 = rr < 4 ? wk[32] : 0.f;
                d0 = __builtin_amdgcn_mfma_f32_16x16x4f32(w0, hv, d0, 0, 0, 0); d1 = __builtin_amdgcn_mfma_f32_16x16x4f32(w1, hv, d1, 0, 0, 0); d2 = __builtin_amdgcn_mfma_f32_16x16x4f32(w2, hv, d2, 0, 0, 0); } }
        int G = 0; float pg = 0.f;
        { const float b0 = in_MBG[l * 4], b1 = in_MBG[l * 4 + 1], b2 = in_MBG[l * 4 + 2], b3 = in_MBG[l * 4 + 3];
          const float g0 = d2.x + b0, g1 = d2.y + b1, g2 = d2.z + b2, g3 = d2.w + b3; float m = g0; G = 0;
          if (g1 > m) { m = g1; G = 1; } if (g2 > m) { m = g2; G = 2; } if (g3 > m) { m = g3; G = 3; }
          pg = 1.f / (fexp(g0 - m) + fexp(g1 - m) + fexp(g2 - m) + fexp(g3 - m)); }
        G = __builtin_amdgcn_ds_bpermute(rr << 2, G);
        const f32x4 t = (G >> 1) ? d1 : d0;
        float ev[8];
#pragma unroll
        for (int j = 0; j < 8; ++j) { const int src = rr + 16 * (2 * (G & 1) + (j >> 2)); const float x = (j & 3) == 0 ? t.x : (j & 3) == 1 ? t.y : (j & 3) == 2 ? t.z : t.w; ev[j] = __builtin_bit_cast(float, __builtin_amdgcn_ds_bpermute(src << 2, __builtin_bit_cast(int, x))); }
        if (q == 0) {
#pragma unroll
            for (int j = 0; j < 8; ++j) ev[j] += in_MBE[l * 32 + G * 8 + j];
            int ia = 0; float ma = ev[0];
#pragma unroll
            for (int j = 1; j < 8; ++j) if (ev[j] > ma) { ma = ev[j]; ia = j; }
            int ib = -1; float mb = -3.0e38f;
#pragma unroll
            for (int j = 0; j < 8; ++j) if (j != ia && ev[j] > mb) { mb = ev[j]; ib = j; }
            const float eb = fexp(mb - ma); const float ga = pg / (1.f + eb), gb = pg * eb / (1.f + eb);
            const int ea = G * 8 + ia, eb_ = G * 8 + ib;
            const int pa = (int)__hip_atomic_fetch_add(cnt + ea, 1u, RLX_AGENT), pb = (int)__hip_atomic_fetch_add(cnt + eb_, 1u, RLX_AGENT);
            int* te = (int*)(F.ws + WS_TOK + TK_E) + 2 * r; int* tp = (int*)(F.ws + WS_TOK + TK_POS) + 2 * r; float* tg = (float*)(F.ws + WS_TOK + TK_GATE) + 2 * r;
            te[0] = ea; te[1] = eb_; tp[0] = pa; tp[1] = pb; tg[0] = ga; tg[1] = gb;
        }
    }
    __syncthreads();
}
__device__ __forceinline__ void assign_phase(Frame& F, int l) {
    LAS int* ps = (LAS int*)F.lds;
    if (F.tid == 0) { int acc = 0; for (int e = 0; e < NEXP; ++e) { const int c = (int)__hip_atomic_load(F.ctl + CW_CNT + l * 64 + e, RLX_AGENT); ps[e] = acc; ps[32 + e] = c; acc += (c + 255) / 256 * 256; } ps[64] = acc; }
    __syncthreads();
    int* stok = (int*)(F.ws + WS_TOK + TK_STOK); float* sgate = (float*)(F.ws + WS_TOK + TK_SGATE); int* tslot = (int*)(F.ws + WS_TOK + TK_SLOT);
    const int* te = (const int*)(F.ws + WS_TOK + TK_E); const int* tp = (const int*)(F.ws + WS_TOK + TK_POS); const float* tg = (const float*)(F.ws + WS_TOK + TK_GATE);
    for (int i = F.vcu * NTHR + F.tid; i < MT * 2; i += F.G * NTHR) { const int dest = ps[te[i]] + tp[i]; stok[dest] = i >> 1; sgate[dest] = tg[i]; tslot[i] = dest; }
    for (int i = F.vcu * NTHR + F.tid; i < NEXP * 256; i += F.G * NTHR) { const int e = i >> 8, j = i & 255, c = ps[32 + e], rem = c & 255;
        if (rem != 0 && j >= rem) { const int dest = ps[e] + (c & ~255) + j; stok[dest] = MT; sgate[dest] = 0.f; } }
    if (F.bx == 0) { int* tile_e = (int*)(F.ws + WS_TOK + TK_TILEE); const int nt = ps[64] / 256;
        for (int t = F.tid; t < nt; t += NTHR) { int e = 0; for (int k = 1; k < NEXP; ++k) if (t * 256 >= ps[k]) e = k; tile_e[t] = e; }
        if (F.tid == 0) __hip_atomic_store(F.ctl + CW_NTILES + l, (unsigned)nt, RLX_AGENT); }
    __syncthreads();
}
__device__ __forceinline__ void s5_scan_phase(Frame& F, int l) {
    const float* const in_S5AIM = inptr(I_S5AIM);
    const float* const in_S5ARE = inptr(I_S5ARE);
    const float* const in_S5LDT = inptr(I_S5LDT);
    const int item = F.vcu * NTHR + F.tid; if (item >= NB * 16 * 2 * 64) return;
    const int p = item & 63, d = (item >> 6) & 1, g = (item >> 7) & 15, b = item >> 11;
    const int pi = ((l * 2 + d) * 16 + g) * 64 + p; const float dt = expf(in_S5LDT[(l * 2 + d) * 16 + g]);
    const float m = expf(32.f * dt * in_S5ARE[pi]), ang = 32.f * dt * in_S5AIM[pi]; const float ar = m * cosf(ang), ai = m * sinf(ang);
    const float* ST = WSP(float, WS_ST) + (size_t)g * S5RP * 256 + d * 128 + p; bf16* HIN = WSP(bf16, WS_HIN) + (size_t)g * S5RP * 256 + d * 128 + p;
    float hr = 0.f, hi = 0.f;
    for (int step = 0; step < 136; ++step) {
        int row;
        if (d == 0) row = step < 8 ? 1024 + b * 8 + step : b * 128 + (step - 8);
        else row = step < 8 ? 1024 + b * 8 + (7 - step) : b * 128 + (135 - step);
        HIN[(size_t)row * 256] = (bf16)f2bf(hr); HIN[(size_t)row * 256 + 64] = (bf16)f2bf(hi);
        const float sr = ST[(size_t)row * 256], si = ST[(size_t)row * 256 + 64];
        const float nr = ar * hr - ai * hi + sr, ni = ar * hi + ai * hr + si; hr = nr; hi = ni;
    }
}

struct ListOrder {
    int n, per, ncol, rowmul, colmul, G, c;
    __device__ __forceinline__ bool next(int i, pg8::Unit& u) const { const int L = i * G + c; if (L >= n) return false; const int a = L / per, r = L - a * per; u.pm = rowmul * a + r / ncol; u.pn = colmul * a + r % ncol; return true; }
    __device__ __forceinline__ void a_ready(const pg8::Unit&) const {}
    __device__ __forceinline__ void done(const pg8::Unit&) const {}
};
struct MoeOrder {
    const int* tile_e; int ntiles, G, c;
    __device__ __forceinline__ bool next(int i, pg8::Unit& u) const { const int L = i * G + c; if (L >= ntiles * 4) return false; const int t = L >> 2; u.pm = t; u.pn = tile_e[t] * 4 + (L & 3); return true; }
    __device__ __forceinline__ void a_ready(const pg8::Unit&) const {}
    __device__ __forceinline__ void done(const pg8::Unit&) const {}
};
using pg8::Unit; using pg8::HALF; using pg8::BM;
#define EPI_ROWS_BEGIN  _Pragma("unroll") for (int ai = 0; ai < 2; ++ai) _Pragma("unroll") for (int m = 0; m < 4; ++m) { const int row = u.pm * BM + ai * HALF + wr * 64 + m * 16 + fr;
#define EPI_ROWS_END asm volatile("" ::: "memory"); }
__device__ __forceinline__ v4u pack8(const f32x4 a, const f32x4 b) { return (v4u){pk2(a.x, a.y), pk2(a.z, a.w), pk2(b.x, b.y), pk2(b.z, b.w)}; }
struct EpiG1 {
    static constexpr bool PERM = true, AFTER_DRAIN = false;
    bf16* P; bf16* QR; bf16* U5; const f32x2* rope;
    __device__ __forceinline__ void operator()(const f32x4 (&acc)[2][2][4][2], const Unit& u, int wr, int wc, int fr, int fq) const {
        const int pn = u.pn; const bool lat = u.pm < ML / BM;
        EPI_ROWS_BEGIN
#pragma unroll
            for (int bj = 0; bj < 2; ++bj) { const int cl = bj * HALF + wc * 32 + 8 * fq, col = pn * BM + cl; const f32x4 v0 = acc[ai][bj][m][0], v1 = acc[ai][bj][m][1];
                if (pn == 3) { const int g = cl >> 4, h0 = cl & 15; *(GAS v4u*)(U5 + ((size_t)g * S5RP + (row >> 5)) * 512 + (row & 31) * 16 + h0) = pack8(v0, v1); }
                else if (pn >= 4 && pn < 8) {
                    const bool isq = pn < 6;
                    if (isq || !lat) *(GAS v4u*)(P + (size_t)row * INC + col) = pack8(v0, v1);
                    if (lat) { const int j0 = (cl & 63) >> 1; const f32x4* rp = (const f32x4*)(rope + (size_t)(row & (SEQ - 1)) * 32 + j0); const f32x4 c0 = rp[0], c1 = rp[1];
                        const f32x4 r0 = {v0.x * c0.x - v0.y * c0.y, v0.x * c0.y + v0.y * c0.x, v0.z * c0.z - v0.w * c0.w, v0.z * c0.w + v0.w * c0.z};
                        const f32x4 r1 = {v1.x * c1.x - v1.y * c1.y, v1.x * c1.y + v1.y * c1.x, v1.z * c1.z - v1.w * c1.w, v1.z * c1.w + v1.w * c1.z};
                        if (isq) *(GAS v4u*)(QR + (size_t)row * 512 + (col - C_Q)) = pack8(r0, r1); else *(GAS v4u*)(P + (size_t)row * INC + col) = pack8(r0, r1); }
                } else *(GAS v4u*)(P + (size_t)row * INC + col) = pack8(v0, v1);
            }
        EPI_ROWS_END
    }
};
struct EpiG2 {
    static constexpr bool PERM = false, AFTER_DRAIN = false;
    float* X; const float* modv_l;
    __device__ __forceinline__ void operator()(const f32x4 (&acc)[2][2][4][2], const Unit& u, int wr, int wc, int fr, int fq) const {
        const int bi = u.pm < ML / BM ? u.pm >> 4 : 8; const float* g1 = modv_l + (size_t)bi * NMOD + 2 * DM; const int col0 = u.pn * BM + wc * 32 + 4 * fq;
        f32x4 gv[2][2];
#pragma unroll
        for (int bj = 0; bj < 2; ++bj)
#pragma unroll
            for (int n = 0; n < 2; ++n) gv[bj][n] = *(const f32x4*)(g1 + col0 + bj * HALF + n * 16);
        EPI_ROWS_BEGIN
            float* xr = X + (size_t)row * DM + col0;
#pragma unroll
            for (int bj = 0; bj < 2; ++bj)
#pragma unroll
                for (int n = 0; n < 2; ++n) { f32x4* p = (f32x4*)(xr + bj * HALF + n * 16); *p = *p + gv[bj][n] * acc[ai][bj][m][n]; }
        EPI_ROWS_END
    }
};
struct EpiUp {
    static constexpr bool PERM = true, AFTER_DRAIN = false;
    bf16* HID;
    __device__ __forceinline__ void operator()(const f32x4 (&acc)[2][2][4][2], const Unit& u, int wr, int wc, int fr, int fq) const {
        const int col = (u.pn & 3) * 128 + wc * 32 + 8 * fq;
        EPI_ROWS_BEGIN
            f32x4 o[2];
#pragma unroll
            for (int n = 0; n < 2; ++n) { const f32x4 a = acc[ai][0][m][n], b = acc[ai][1][m][n]; o[n] = (f32x4){fsilu(a.x) * b.x, fsilu(a.y) * b.y, fsilu(a.z) * b.z, fsilu(a.w) * b.w}; }
            *(GAS v4u*)(HID + (size_t)row * EHID + col) = pack8(o[0], o[1]);
        EPI_ROWS_END
    }
};
struct EpiDown {
    static constexpr bool PERM = true, AFTER_DRAIN = false;
    bf16* YB; const float* sgate;
    __device__ __forceinline__ void operator()(const f32x4 (&acc)[2][2][4][2], const Unit& u, int wr, int wc, int fr, int fq) const {
        EPI_ROWS_BEGIN
            const float gt = sgate[row];
#pragma unroll
            for (int bj = 0; bj < 2; ++bj) *(GAS v4u*)(YB + (size_t)row * DM + (u.pn & 3) * BM + bj * HALF + wc * 32 + 8 * fq) = pack8(acc[ai][bj][m][0] * gt, acc[ai][bj][m][1] * gt);
        EPI_ROWS_END
    }
};
struct EpiS5i {
    static constexpr bool PERM = true, AFTER_DRAIN = false;
    float* YI; float* ST;
    __device__ __forceinline__ void operator()(const f32x4 (&acc)[2][2][4][2], const Unit& u, int wr, int wc, int fr, int fq) const {
        const int g = u.pm / 5, i5 = u.pm - 5 * g, j = u.pn - 3 * g;
        EPI_ROWS_BEGIN
            const int cr = row - g * S5RP; (void)i5;
#pragma unroll
            for (int bj = 0; bj < 2; ++bj) { const int cl = bj * HALF + wc * 32 + 8 * fq; float* dst;
                if (j < 2) { const int n = j * BM + cl; dst = YI + ((size_t)cr * 32 + (n >> 4)) * 256 + g * 16 + (n & 15); } else dst = ST + ((size_t)g * S5RP + cr) * 256 + cl;
                *(f32x4*)dst = acc[ai][bj][m][0]; *(f32x4*)(dst + 4) = acc[ai][bj][m][1]; }
        EPI_ROWS_END
    }
};
struct EpiS5c {
    static constexpr bool PERM = true, AFTER_DRAIN = false;
    const float* YI; bf16* GY;
    __device__ __forceinline__ void operator()(const f32x4 (&acc)[2][2][4][2], const Unit& u, int wr, int wc, int fr, int fq) const {
        const int g = u.pm / 5, j = u.pn - 2 * g;
        EPI_ROWS_BEGIN
            const int cr = row - g * S5RP;
#pragma unroll
            for (int bj = 0; bj < 2; ++bj) { const int n = j * BM + bj * HALF + wc * 32 + 8 * fq; const size_t o = ((size_t)cr * 32 + (n >> 4)) * 256 + g * 16 + (n & 15);
                const f32x4 y0 = acc[ai][bj][m][0] + *(const f32x4*)(YI + o), y1 = acc[ai][bj][m][1] + *(const f32x4*)(YI + o + 4);
                *(GAS v4u*)(GY + o) = pack8((f32x4){fgelu_tanh(y0.x), fgelu_tanh(y0.y), fgelu_tanh(y0.z), fgelu_tanh(y0.w)}, (f32x4){fgelu_tanh(y1.x), fgelu_tanh(y1.y), fgelu_tanh(y1.z), fgelu_tanh(y1.w)}); }
        EPI_ROWS_END
    }
};
struct EpiGlu {
    static constexpr bool PERM = true, AFTER_DRAIN = true;
    const bf16* GY; bf16* MIX; const float* ng;
    __device__ __forceinline__ void fused(f32x4 (&acc)[2][2][4][2], const Unit& u, int wr, int wc, int fr, int fq, PG8_LAS unsigned char* lds, int wid, int lane) const {
        PG8_LAS float* part = (PG8_LAS float*)lds;
        EPI_ROWS_BEGIN
            float ss = 0.f;
#pragma unroll
            for (int bj = 0; bj < 2; ++bj) { const int col = bj * HALF + wc * 32 + 8 * fq; const v4u gw = *(const GAS v4u*)(GY + (size_t)row * 256 + col);
                const f32x4 g0 = {bflo(gw.x), bfhi(gw.x), bflo(gw.y), bfhi(gw.y)}, g1 = {bflo(gw.z), bfhi(gw.z), bflo(gw.w), bfhi(gw.w)};
                f32x4& a0 = acc[ai][bj][m][0]; f32x4& a1 = acc[ai][bj][m][1];
                a0 = (f32x4){g0.x * fsigmoid(a0.x), g0.y * fsigmoid(a0.y), g0.z * fsigmoid(a0.z), g0.w * fsigmoid(a0.w)};
                a1 = (f32x4){g1.x * fsigmoid(a1.x), g1.y * fsigmoid(a1.y), g1.z * fsigmoid(a1.z), g1.w * fsigmoid(a1.w)};
                ss += a0.x * a0.x + a0.y * a0.y + a0.z * a0.z + a0.w * a0.w + a1.x * a1.x + a1.y * a1.y + a1.z * a1.z + a1.w * a1.w; }
            ss = xor_add<16>(ss); ss = xor_add<32>(ss);
            if (fq == 0) part[(ai * HALF + wr * 64 + m * 16 + fr) * 4 + wc] = ss;
        EPI_ROWS_END
        asm volatile("s_waitcnt lgkmcnt(0)" ::: "memory"); __builtin_amdgcn_s_barrier(); asm volatile("" ::: "memory");
        EPI_ROWS_BEGIN
            const int lr = ai * HALF + wr * 64 + m * 16 + fr; const f32x4 pp = *(PG8_LAS f32x4*)(part + lr * 4); const float rs = rsqrtf((pp.x + pp.y + pp.z + pp.w) * (1.f / 256.f) + EPSF);
#pragma unroll
            for (int bj = 0; bj < 2; ++bj) { const int col = bj * HALF + wc * 32 + 8 * fq; const f32x4 n0 = *(const f32x4*)(ng + col), n1 = *(const f32x4*)(ng + col + 4);
                *(GAS v4u*)(MIX + (size_t)row * DM + 256 + col) = pack8(acc[ai][bj][m][0] * rs * n0, acc[ai][bj][m][1] * rs * n1); }
        EPI_ROWS_END
        asm volatile("s_waitcnt lgkmcnt(0)" ::: "memory"); __builtin_amdgcn_s_barrier(); asm volatile("" ::: "memory");
    }
};

namespace att {
constexpr int KVBLK = 64, QBLK = 32;
constexpr int SHM_V = KVBLK * 128 * 2, SHM_K = KVBLK * 128 * 2;
constexpr float SCALE = 0.125f, THR = 8.f;
#define KSWZ(row, colB) ((row) * 256 + ((colB) ^ (((row) & 7) << 4)))
#define SBAR() __builtin_amdgcn_sched_barrier(0)
__device__ __forceinline__ int crow(int r, int hi) { return (r & 3) + 8 * (r >> 2) + 4 * hi; }
__device__ __forceinline__ unsigned cvtpk(float lo, float hi) { unsigned r; asm volatile("v_cvt_pk_bf16_f32 %0, %1, %2" : "=v"(r) : "v"(lo), "v"(hi)); return r; }
__device__ __forceinline__ void partialSM(f32x16& p0, f32x16& p1, float& m_reg, float& mn, float& alpha) {
  constexpr float C = SCALE * 1.4426950408889634f;
  float pmax = p0[0];
#pragma unroll
  for (int r = 1; r < 16; ++r) pmax = fmaxf(pmax, p0[r]);
#pragma unroll
  for (int r = 0; r < 16; ++r) pmax = fmaxf(pmax, p1[r]);
  { auto rr = __builtin_amdgcn_permlane32_swap(__float_as_uint(pmax), __float_as_uint(pmax), false, false);
    pmax = fmaxf(__uint_as_float(rr[0]), __uint_as_float(rr[1])); }
  if (__builtin_expect(__all(pmax - m_reg <= THR / SCALE), 1)) { mn = m_reg; alpha = 1.f; }
  else { mn = fmaxf(m_reg, pmax); alpha = __builtin_amdgcn_exp2f((m_reg - mn) * C); m_reg = mn; }
  float mnC = -mn * C;
#pragma unroll
  for (int r = 0; r < 16; ++r) p0[r] = fmaf(p0[r], C, mnC);
#pragma unroll
  for (int r = 0; r < 16; ++r) p1[r] = fmaf(p1[r], C, mnC);
#pragma unroll
  for (int r = 0; r < 16; ++r) p0[r] = __builtin_amdgcn_exp2f(p0[r]);
}
__device__ __forceinline__ void finishSM(f32x16& p0, f32x16& p1, float alpha, float& l_reg, bf16x8& pa0, bf16x8& pa1, bf16x8& pa2, bf16x8& pa3) {
#pragma unroll
  for (int r = 0; r < 16; ++r) p1[r] = __builtin_amdgcn_exp2f(p1[r]);
  float ps = 0;
#pragma unroll
  for (int r = 0; r < 16; ++r) ps += p0[r];
#pragma unroll
  for (int r = 0; r < 16; ++r) ps += p1[r];
  { auto rr = __builtin_amdgcn_permlane32_swap(__float_as_uint(ps), __float_as_uint(ps), false, false);
    ps = __uint_as_float(rr[0]) + __uint_as_float(rr[1]); }
  l_reg = l_reg * alpha + ps;
#define PK4(P, BASE, OUT) do { unsigned a0 = cvtpk(P[BASE + 0], P[BASE + 1]), a1 = cvtpk(P[BASE + 2], P[BASE + 3]);   \
    unsigned b0 = cvtpk(P[BASE + 4], P[BASE + 5]), b1 = cvtpk(P[BASE + 6], P[BASE + 7]);                              \
    auto r0 = __builtin_amdgcn_permlane32_swap(a0, b0, false, false); auto r1 = __builtin_amdgcn_permlane32_swap(a1, b1, false, false); \
    v4u w = {r0[0], r1[0], r0[1], r1[1]}; OUT = __builtin_bit_cast(bf16x8, w); } while (0)
  PK4(p0, 0, pa0); PK4(p0, 8, pa1); PK4(p1, 0, pa2); PK4(p1, 8, pa3);
#undef PK4
}
__device__ __forceinline__ void qkt(f32x16& p0, f32x16& p1, const LAS char* Ks, const bf16x8* qr, int r32, int hi, int sub) {
  p0 = f32x16{}; p1 = f32x16{};
#pragma unroll
  for (int d0 = 0; d0 < 4; ++d0) { const int cb = sub * 128 + (d0 * 16 + hi * 8) * 2;
    const bf16x8 b0 = *(const LAS bf16x8*)(Ks + KSWZ(r32, cb));
    const bf16x8 b1 = *(const LAS bf16x8*)(Ks + KSWZ(32 + r32, cb));
    p0 = __builtin_amdgcn_mfma_f32_32x32x16_bf16(b0, qr[d0], p0, 0, 0, 0);
    p1 = __builtin_amdgcn_mfma_f32_32x32x16_bf16(b1, qr[d0], p1, 0, 0, 0); }
}
__device__ __forceinline__ int v_st(int k, int c) { const int kk = (k & ~0xC) | ((k & 4) << 1) | ((k & 8) >> 1); return ((kk >> 3) * 4 + (c >> 5)) * 512 + ((kk & 7) * 32 + (c & 31)) * 2; }
__device__ __forceinline__ int v_rd_base(int lane) { return ((lane & 3) << 3) | (((lane >> 2) & 3) << 6) | (((lane >> 4) & 1) << 5) | (((lane >> 5) & 1) << 8); }
constexpr int v_rd_off(int d0, int ks, int half) { return d0 * 512 + ks * 4096 + half * 2048; }
template <int OFF> __device__ __forceinline__ s16x4 tr_read(int vb) { s16x4 r; asm volatile("ds_read_b64_tr_b16 %0, %1 offset:%2" : "=&v"(r) : "v"(vb), "i"(OFF) : "memory"); return r; }
template <int D0> __device__ __forceinline__ void pv_one(f32x16& od, int vb, bf16x8 pa0, bf16x8 pa1, bf16x8 pa2, bf16x8 pa3) {
  const s16x4 l0 = tr_read<v_rd_off(D0, 0, 0)>(vb), h0 = tr_read<v_rd_off(D0, 0, 1)>(vb), l1 = tr_read<v_rd_off(D0, 1, 0)>(vb), h1 = tr_read<v_rd_off(D0, 1, 1)>(vb);
  const s16x4 l2 = tr_read<v_rd_off(D0, 2, 0)>(vb), h2 = tr_read<v_rd_off(D0, 2, 1)>(vb), l3 = tr_read<v_rd_off(D0, 3, 0)>(vb), h3 = tr_read<v_rd_off(D0, 3, 1)>(vb);
  asm volatile("s_waitcnt lgkmcnt(0)" ::: "memory"); SBAR();
#define PK(L, H) (bf16x8){L[0], L[1], L[2], L[3], H[0], H[1], H[2], H[3]}
  od = __builtin_amdgcn_mfma_f32_32x32x16_bf16(pa0, PK(l0, h0), od, 0, 0, 0);
  od = __builtin_amdgcn_mfma_f32_32x32x16_bf16(pa1, PK(l1, h1), od, 0, 0, 0);
  od = __builtin_amdgcn_mfma_f32_32x32x16_bf16(pa2, PK(l2, h2), od, 0, 0, 0);
  od = __builtin_amdgcn_mfma_f32_32x32x16_bf16(pa3, PK(l3, h3), od, 0, 0, 0);
#undef PK
}
__device__ __forceinline__ void pv_d0(f32x16* o, int vb, bf16x8 pa0, bf16x8 pa1, bf16x8 pa2, bf16x8 pa3) {
  pv_one<0>(o[0], vb, pa0, pa1, pa2, pa3); pv_one<1>(o[1], vb, pa0, pa1, pa2, pa3); pv_one<2>(o[2], vb, pa0, pa1, pa2, pa3); pv_one<3>(o[3], vb, pa0, pa1, pa2, pa3);
}
__device__ __forceinline__ void attn_unit(LAS char* lds, const bf16* P, const bf16* QR, bf16* MIX, const float* subln, float lam, float oml, int unit, int tid_) {
  asm volatile("" : "+v"(tid_));
  const int tid = tid_, wid = tid >> 6, lane = tid & 63, r32 = lane & 31, hi = lane >> 5, sub = wid >> 2, wq = wid & 3;
  const bool isl = unit < 1024; int b, h, q0;
  if (isl) { const int bh = unit >> 5; b = bh >> 2; h = bh & 3; q0 = b * SEQ + (unit & 31) * 128; } else { const int u2 = unit - 1024, bh = u2 >> 1; b = bh >> 2; h = bh & 3; q0 = ML + b * CTXL + (u2 & 1) * 128; }
  const int NT = isl ? 68 : 4; const int crow0 = ML + b * CTXL, lrow0 = b * SEQ;
  LAS char* V_lds = lds; LAS char* K_lds = lds + 2 * SHM_V;
  LAS float* ws = (LAS float*)(lds + 2 * SHM_V + 2 * SHM_K) + wid * 64; LAS float* li_l = ws; LAS float* al_l = ws + 32;
  float m_reg = -1e30f, l_reg = 0; f32x16 o[4] = {}; bf16x8 qr[4];
  const int qrow = q0 + wq * QBLK + r32;
  { const bf16* Qw = P + (size_t)qrow * INC + C_Q + h * 128 + sub * 64 + hi * 8;
#pragma unroll
    for (int d0 = 0; d0 < 4; ++d0) qr[d0] = *(const bf16x8*)(Qw + d0 * 16); }
  const int sr = tid >> 4, sc = (tid & 15) * 8, vst0 = v_st(sr, sc), vst1 = v_st(32 + sr, sc);
  const int vb0 = (int)(unsigned long)V_lds + v_rd_base(lane);
  const bf16* Kc = P + C_K + h * 128 + sc; const bf16* Vc = P + C_V + h * 128 + sc;
  struct { bf16x8 vs0, vs1, ks0, ks1; } sr_[2];
#define TROW(j) (((j) < 4 ? crow0 + (j) * 64 : lrow0 + ((j) - 4) * 64) + sr)
#define SLOAD(i, j) do { const size_t _r = (size_t)TROW(j) * INC; sr_[i].vs0 = *(const bf16x8*)(Vc + _r); sr_[i].vs1 = *(const bf16x8*)(Vc + _r + (size_t)32 * INC); \
    sr_[i].ks0 = *(const bf16x8*)(Kc + _r); sr_[i].ks1 = *(const bf16x8*)(Kc + _r + (size_t)32 * INC); } while (0)
#define SWRITE(bb, i) do { *(LAS bf16x8*)(V_lds + (bb) * SHM_V + vst0) = sr_[i].vs0; *(LAS bf16x8*)(V_lds + (bb) * SHM_V + vst1) = sr_[i].vs1; const int kc = sc * 2; \
    *(LAS bf16x8*)(K_lds + (bb) * SHM_K + KSWZ(sr, kc)) = sr_[i].ks0; *(LAS bf16x8*)(K_lds + (bb) * SHM_K + KSWZ(32 + sr, kc)) = sr_[i].ks1; } while (0)
#define SWAIT() asm volatile("s_waitcnt vmcnt(4)" ::: "memory")
#define RESC(a) do { if (__any((a) < 1.f)) { if (hi == 0) al_l[r32] = (a); asm volatile("s_waitcnt lgkmcnt(0)" ::: "memory"); \
    _Pragma("unroll") for (int d = 0; d < 4; ++d) _Pragma("unroll") for (int r = 0; r < 16; ++r) o[d][r] *= al_l[crow(r, hi)]; } } while (0)
  f32x16 pA0, pA1, pB0, pB1; float mnA, mnB, alA, alB; bf16x8 pa0, pa1, pa2, pa3;
  SLOAD(0, 0); asm volatile("s_waitcnt vmcnt(0)" ::: "memory"); SWRITE(0, 0); __syncthreads();
  qkt(pA0, pA1, K_lds, qr, r32, hi, sub); partialSM(pA0, pA1, m_reg, mnA, alA);
  SLOAD(1, 1); if (2 < NT) SLOAD(0, 2);
  SWAIT(); SWRITE(1, 1); __syncthreads();
  for (int j = 1; j + 1 < NT; j += 2) {
    SBAR(); qkt(pB0, pB1, K_lds + SHM_K, qr, r32, hi, sub);
    finishSM(pA0, pA1, alA, l_reg, pa0, pa1, pa2, pa3); SBAR();
    SLOAD(1, j + 2); SBAR();
    pv_d0(o, vb0, pa0, pa1, pa2, pa3); partialSM(pB0, pB1, m_reg, mnB, alB);
    __syncthreads(); SWAIT(); SWRITE(0, 0);
    RESC(alB); __syncthreads();
    if (isl && j == 3) { const bf16* Qw = QR + (size_t)qrow * 512 + h * 128 + sub * 64 + hi * 8;
#pragma unroll
      for (int d0 = 0; d0 < 4; ++d0) qr[d0] = *(const bf16x8*)(Qw + d0 * 16); }
    SBAR(); qkt(pA0, pA1, K_lds, qr, r32, hi, sub);
    finishSM(pB0, pB1, alB, l_reg, pa0, pa1, pa2, pa3); SBAR();
    if (j + 3 < NT) SLOAD(0, j + 3); SBAR();
    pv_d0(o, vb0 + SHM_V, pa0, pa1, pa2, pa3); partialSM(pA0, pA1, m_reg, mnA, alA);
    __syncthreads(); SWAIT(); SWRITE(1, 1);
    RESC(alA); __syncthreads();
  }
  SBAR(); qkt(pB0, pB1, K_lds + SHM_K, qr, r32, hi, sub);
  finishSM(pA0, pA1, alA, l_reg, pa0, pa1, pa2, pa3); SBAR();
  pv_d0(o, vb0, pa0, pa1, pa2, pa3); partialSM(pB0, pB1, m_reg, mnB, alB);
  __syncthreads(); RESC(alB);
  finishSM(pB0, pB1, alB, l_reg, pa0, pa1, pa2, pa3); SBAR();
  pv_d0(o, vb0 + SHM_V, pa0, pa1, pa2, pa3);
  if (hi == 0) li_l[r32] = l_reg; asm volatile("s_waitcnt lgkmcnt(0)" ::: "memory");
  float rli[16];
#pragma unroll
  for (int r = 0; r < 16; ++r) rli[r] = __builtin_amdgcn_rcpf(li_l[crow(r, hi)]);
  __syncthreads();
  LAS float* ex = (LAS float*)lds + wq * 4096 + lane;
  if (sub == 1) {
#pragma unroll
    for (int d = 0; d < 4; ++d)
#pragma unroll
      for (int r = 0; r < 16; ++r) ex[(d * 16 + r) * 64] = o[d][r] * rli[r] * lam;
  }
  __syncthreads();
  if (sub == 0) {
    float ss[16];
#pragma unroll
    for (int r = 0; r < 16; ++r) { float s = 0.f;
#pragma unroll
      for (int d = 0; d < 4; ++d) { const float v = o[d][r] * rli[r] - ex[(d * 16 + r) * 64]; o[d][r] = v; s += v * v; }
      ss[r] = s; }
#pragma unroll
    for (int r = 0; r < 16; ++r) { float s = ss[r]; s = xor_add<1>(s); s = xor_add<2>(s); s = xor_add<4>(s); s = xor_add<8>(s); s = xor_add<16>(s); ss[r] = rsqrtf(s * (1.f / 128.f) + EPSF) * oml; }
    bf16* Ow = MIX + (size_t)(q0 + wq * QBLK) * DM + 512 + h * 128 + r32;
#pragma unroll
    for (int d = 0; d < 4; ++d) { const float gsc = subln[d * 32 + r32];
#pragma unroll
      for (int r = 0; r < 16; ++r) Ow[(size_t)crow(r, hi) * DM + d * 32] = (bf16)f2bf(o[d][r] * ss[r] * gsc); }
  }
  __syncthreads();
#undef TROW
#undef SLOAD
#undef SWRITE
#undef SWAIT
#undef RESC
}
#undef KSWZ
}

__global__ void __launch_bounds__(NTHR, 2) mega_fwd(Args args) {
    extern __shared__ __attribute__((aligned(16))) unsigned char lds_raw[];
    Frame F;
    F.lds = (LAS unsigned char*)lds_raw; F.out = args.out; F.ws = args.ws; F.ctl = (gu32*)(args.ws + WS_CTL);
    const int wave0 = __builtin_amdgcn_readfirstlane((int)threadIdx.x >> 6);
    F.tid = threadIdx.x; F.lane = F.tid & 63; F.wave = wave0;
    F.G = gridDim.x; F.bx = blockIdx.x; F.vcu = F.bx;
    volatile LAS unsigned* MISC = (volatile LAS unsigned*)(F.lds + MISC_OFF);
    for (int u = F.tid; u < 256; u += NTHR) MISC[u] = 0u;
    __syncthreads();
    const int lo = args.ph_lo, hi = args.ph_hi;
    const bool multi = (hi - lo) > 1;
    XcdBarrier bar; bar.bar = (unsigned*)(F.ctl + CW_BAR); bar.x = 0; bar.st = nullptr;
    if (multi) bar = xcd_barrier_post((unsigned*)(F.ctl + CW_BAR), MISC + 8, F.tid);
#ifndef PH_MASK
#define PH_MASK 0xFFFFFFFFu
#endif
#define IN(k) (lo <= (k) && (k) < hi)
#define PHM(bit) ((PH_MASK >> (bit)) & 1u)
#define FRESH() do { const int t_ = (wave0 << 6) | lane_id_asm(); F.tid = t_; F.lane = t_ & 63; F.wave = wave0; \
    unsigned char* w_ = args.ws; asm volatile("" : "+s"(w_)); F.ws = w_; F.ctl = (gu32*)(w_ + WS_CTL); \
    int bx_ = blockIdx.x, g_ = gridDim.x; asm volatile("" : "+s"(bx_), "+s"(g_)); F.bx = bx_; F.G = g_; F.vcu = (g_ % 8 == 0) ? (bx_ % 8) * (g_ / 8) + bx_ / 8 : bx_; } while (0)
#define SEAM(k) do { if (IN(k) && IN((k) + 1)) { XcdBarrier b_ = bar; unsigned char* p_ = args.ws; asm volatile("" : "+s"(p_)); b_.bar = (unsigned*)(p_ + WS_CTL) + CW_BAR; xcd_barrier(b_, (wave0 << 6) | lane_id_asm()); } } while (0)
    PG8_LAS unsigned char* glds = (PG8_LAS unsigned char*)lds_raw;

    if (PHM(0) && IN(0)) { FRESH(); p0_modv(F); p0_weights(F); __syncthreads(); p0_h2(F); p0_s5(F); p0_misc(F); }
    SEAM(0);
    if (PHM(1) && IN(1)) { FRESH(); p0_filters(F); }
    SEAM(1);

#pragma unroll 1
    for (int l = 0; l < DEPTH; ++l) {
        const int pb = PH_LAYER0 + l * NPL;
        if (PHM(2) && IN(pb + 0)) { FRESH(); n1_phase(F, l); __syncthreads(); moe_weights(F, l); }
        SEAM(pb + 0);
        if (PHM(3) && IN(pb + 1)) { FRESH();
            pg8::Gemm g{WSP(bf16, WS_H), WSP(bf16, WS_WINT) + (size_t)l * INC * DM, MT, INC, DM}; pg8::StaticOrder S; S.init(MT, INC, F.G, F.bx);
            EpiG1 E{WSP(bf16, WS_P), WSP(bf16, WS_QR), WSP(bf16, WS_U5), WSP(f32x2, WS_ROPE)};
            pg8::gemm_phase<EpiG1, pg8::StaticOrder, true, true, false>(glds, g, S, E, F.tid);
        }
        SEAM(pb + 1);
        if (PHM(4) && IN(pb + 2)) { FRESH();
            const float lam = WSP(float, WS_MISC)[l], oml = WSP(float, WS_MISC)[4 + l];
#if !defined(SUBM) || (SUBM & 1)
            for (int u = F.vcu; u < 1088; u += F.G) att::attn_unit((LAS char*)lds_raw, WSP(bf16, WS_P), WSP(bf16, WS_QR), WSP(bf16, WS_MIX), inptr(I_SUBLN) + l * 128, lam, oml, u, F.tid);
#endif
            __syncthreads();
#if !defined(SUBM) || (SUBM & 2)
            for (int u = F.vcu; u < 1024; u += F.G) hyena_unit(F, l, u);
            for (int u = F.vcu; u < 256; u += F.G) hyena_ctx_unit(F, l, u);
#endif
            __syncthreads();
#if !defined(SUBM) || (SUBM & 4)
            { pg8::Gemm g{WSP(bf16, WS_U5), WSP(bf16, WS_S5MB) + (size_t)l * 16 * 768 * 512, 16 * S5RP, 16 * 768, 512}; ListOrder S{240, 15, 3, 5, 3, F.G, F.bx};
              EpiS5i E{WSP(float, WS_YI), WSP(float, WS_ST)};
              pg8::gemm_phase<EpiS5i, ListOrder, true, true, false>(glds, g, S, E, F.tid); }
#endif
        }
        SEAM(pb + 2);
        if (PHM(5) && IN(pb + 3)) { FRESH(); s5_scan_phase(F, l); }
        SEAM(pb + 3);
        if (PHM(6) && IN(pb + 4)) { FRESH();
            pg8::Gemm g{WSP(bf16, WS_HIN), WSP(bf16, WS_S5CS) + (size_t)l * 16 * 512 * 256, 16 * S5RP, 16 * 512, 256}; ListOrder S{160, 10, 2, 5, 2, F.G, F.bx};
            EpiS5c E{WSP(float, WS_YI), WSP(bf16, WS_GY)};
            pg8::gemm_phase<EpiS5c, ListOrder, true, true, false>(glds, g, S, E, F.tid);
        }
        SEAM(pb + 4);
        if (PHM(7) && IN(pb + 5)) { FRESH();
            { pg8::Gemm g{WSP(bf16, WS_GY), WSP(bf16, WS_GLUT) + (size_t)l * 65536, MT, 256, 256}; ListOrder S{MT / 256, 1, 1, 1, 0, F.G, F.bx};
              EpiGlu E{WSP(bf16, WS_GY), WSP(bf16, WS_MIX), inptr(I_S5NG) + l * 256};
              pg8::gemm_phase<EpiGlu, ListOrder, false, true, false>(glds, g, S, E, F.tid); }
            __syncthreads();
            for (int u = F.vcu; u < MT / 64; u += F.G) hyena_fin_unit(F, l, u);
        }
        SEAM(pb + 5);
        if (PHM(8) && IN(pb + 6)) { FRESH();
            pg8::Gemm g{WSP(bf16, WS_MIX), WSP(bf16, WS_WOUTT) + (size_t)l * DM * DM, MT, DM, DM}; pg8::StaticOrder S; S.init(MT, DM, F.G, F.bx);
            EpiG2 E{WSP(float, WS_X), WSP(float, WS_MODV) + (size_t)l * 9 * NMOD};
            pg8::gemm_phase<EpiG2, pg8::StaticOrder, true, true, false>(glds, g, S, E, F.tid);
        }
        SEAM(pb + 6);
        if (PHM(9) && IN(pb + 7)) { FRESH(); n2r_phase(F, l); }
        SEAM(pb + 7);
        if (PHM(10) && IN(pb + 8)) { FRESH(); assign_phase(F, l); }
        SEAM(pb + 8);
        if (PHM(11) && IN(pb + 9)) { FRESH();
            const int ntiles = (int)__hip_atomic_load(F.ctl + CW_NTILES + l, RLX_AGENT);
            pg8::Gemm g{WSP(bf16, WS_H), WSP(bf16, WS_MOEW13), NSLOT, NEXP * 1024, DM}; MoeOrder S{(const int*)(F.ws + WS_TOK + TK_TILEE), ntiles, F.G, F.bx};
            EpiUp E{WSP(bf16, WS_HID)};
            pg8::gemm_phase<EpiUp, MoeOrder, true, true, true>(glds, g, S, E, F.tid, (const int*)(F.ws + WS_TOK + TK_STOK));
        }
        SEAM(pb + 9);
        if (PHM(12) && IN(pb + 10)) { FRESH();
            const int ntiles = (int)__hip_atomic_load(F.ctl + CW_NTILES + l, RLX_AGENT);
            pg8::Gemm g{WSP(bf16, WS_HID), WSP(bf16, WS_MOEW2), NSLOT, NEXP * 1024, EHID}; MoeOrder S{(const int*)(F.ws + WS_TOK + TK_TILEE), ntiles, F.G, F.bx};
            EpiDown E{WSP(bf16, WS_YB), (const float*)(F.ws + WS_TOK + TK_SGATE)};
            pg8::gemm_phase<EpiDown, MoeOrder, true, true, false>(glds, g, S, E, F.tid);
        }
        SEAM(pb + 10);
    }
    if (PHM(13) && IN(PH_FINAL)) { FRESH(); n1_phase(F, DEPTH); }
#undef IN
#undef SEAM
}

#ifndef MK_SPLIT
#define MK_SPLIT 1
#endif
extern "C" void kernel_launch(void* const* d_in, const int* in_sizes, int n_in, void* d_out, int out_size, void* d_ws, size_t ws_size, hipStream_t stream) {
    static int grid = 0;
    if (grid == 0) {
        if (n_in != 43 || out_size != ML * DM || ws_size < WS_END) { fprintf(stderr, "kernel_launch: unexpected problem: n_in %d out %d ws %zu (need %zu)\n", n_in, out_size, ws_size, (size_t)WS_END); grid = -1; return; }
        int dev = 0, cus = 0, per_cu = 0;
        if (hipGetDevice(&dev) != hipSuccess || hipDeviceGetAttribute(&cus, hipDeviceAttributeMultiprocessorCount, dev) != hipSuccess) { grid = -1; return; }
        if (hipFuncSetAttribute((const void*)mega_fwd, hipFuncAttributeMaxDynamicSharedMemorySize, LDS_BYTES) != hipSuccess) { fprintf(stderr, "kernel_launch: hipFuncSetAttribute failed\n"); grid = -1; return; }
        if (hipOccupancyMaxActiveBlocksPerMultiprocessor(&per_cu, (const void*)mega_fwd, NTHR, LDS_BYTES) != hipSuccess || per_cu < 1) fprintf(stderr, "kernel_launch: occupancy query says %d\n", per_cu);
        (void)hipGetLastError();
        grid = cus;
    }
    if (grid < 0) return;
    if (hipMemsetAsync((char*)d_ws + WS_CTL, 0, CTL_ZERO_BYTES, stream) != hipSuccess) return;
    Args a{};
    for (int i = 0; i < 43; ++i) a.in[i] = (const float*)d_in[i];
    a.out = (float*)d_out; a.ws = (unsigned char*)d_ws;
#if MK_SPLIT
    for (int p = 0; p < PH_TOTAL; ++p) { a.ph_lo = p; a.ph_hi = p + 1; hipLaunchKernelGGL(mega_fwd, dim3(grid), dim3(NTHR), LDS_BYTES, stream, a); }
#else
    a.ph_lo = 0; a.ph_hi = PH_TOTAL; hipLaunchKernelGGL(mega_fwd, dim3(grid), dim3(NTHR), LDS_BYTES, stream, a);
#endif
    const hipError_t le = hipPeekAtLastError();
    if (le != hipSuccess) fprintf(stderr, "kernel_launch: launch failed: %s\n", hipGetErrorName(le));
}
```

```cpp
#include <hip/hip_runtime.h>
#include <cstdio>
#include <cstdint>
#include <cmath>
__device__ __forceinline__ int lane_id_asm() { int l; asm volatile("v_mbcnt_lo_u32_b32 %0, -1, 0\n\tv_mbcnt_hi_u32_b32 %0, -1, %0" : "=v"(l)); return l; }
namespace pg8 {
#define PG8_LAS __attribute__((address_space(3)))
typedef unsigned short bf16_t;
typedef short bf16x8 __attribute__((ext_vector_type(8)));
typedef float f32x4 __attribute__((ext_vector_type(4)));
typedef unsigned u32x4 __attribute__((ext_vector_type(4)));
constexpr int BM = 256, BK = 64, HALF = 128, HTB = HALF * BK * 2  , STAGE_BYTES = 8 * HTB, NXCD = 8, WGM = 8;

__host__ __device__ __forceinline__ int lds_byte(int r, int c) { const int st = (r >> 4) * 2 + (c >> 5), rr = r & 15, cc = c & 31, ob = rr * 64 + cc * 2; return st * 1024 + (ob ^ (((ob >> 9) & 1) << 5)); }
__host__ __device__ __forceinline__ void stage_rc(int b, int& R, int& C) { const int st = b / 1024, sb = b % 1024, swz = sb ^ (((sb >> 9) & 1) << 5); R = (st >> 1) * 16 + swz / 64; C = (st & 1) * 32 + (swz % 64) / 2; }
__host__ __device__ __forceinline__ int perm32(int rho) { const int n = rho >> 4, i = rho & 15; return 8 * (i >> 2) + 4 * n + (i & 3); }

struct Unit { int pm, pn; };
struct Gemm { const bf16_t* A; const bf16_t* Bt; int M, N, K; };

struct StaticOrder {
    int nM, nN, nwg, G, c;
    __host__ __device__ void init(int M, int N, int G_, int c_) { nM = M / BM; nN = N / BM; nwg = nM * nN; G = G_; c = c_; }
    __host__ __device__ bool next(int i, Unit& u) const {
        const long L = (long)i * G + c; if (L >= nwg) return false;
        int wgid = (int)L; { const int q = nwg / NXCD, r = nwg % NXCD, xcd = wgid % NXCD, off = wgid / NXCD; wgid = (xcd < r ? xcd * (q + 1) : r * (q + 1) + (xcd - r) * q) + off; }
        const int nig = WGM * nN, gid = wgid / nig, fm = gid * WGM, gsz = (nM - fm) < WGM ? (nM - fm) : WGM;
        u.pm = fm + ((wgid % nig) % gsz); u.pn = (wgid % nig) / gsz; return true;
    }
    __device__ __forceinline__ void a_ready(const Unit&) const {}
    __device__ __forceinline__ void done(const Unit&) const {}
};

__device__ __forceinline__ unsigned cvt_pk_bf16(float lo, float hi) { unsigned r; asm volatile("v_cvt_pk_bf16_f32 %0, %1, %2" : "=v"(r) : "v"(lo), "v"(hi)); return r; }
typedef float f32x2 __attribute__((ext_vector_type(2)));
template <class Epi, class Sched, bool ALIGN_EPI = false, bool SP2 = false, bool GATHER = false>
__device__ __forceinline__ void gemm_phase(PG8_LAS unsigned char* lds, const Gemm g, const Sched& S, const Epi& E, int tid_, const int* rowidx = nullptr) {
    asm volatile("" : "+v"(tid_));
    const int tid = tid_, wid = __builtin_amdgcn_readfirstlane(tid >> 6), lane = tid & 63, wr = wid >> 2, wc = wid & 3, fr = lane & 15, fq = lane >> 4;
    const int K = g.K, nt = K / BK;
    unsigned voffA[2], voffB[2]; int RA[2], CA[2]; unsigned oC[2][2], oN[2][2];
#pragma unroll
    for (int i = 0; i < 2; ++i) { int R, C; stage_rc(tid * 16 + i * 8192, R, C); const int Rb = Epi::PERM ? ((R & ~31) + perm32(R & 31)) : R;
        voffA[i] = (unsigned)(R * K + C) * 2u; voffB[i] = (unsigned)(Rb * K + C) * 2u; RA[i] = R; CA[i] = C; }
    const size_t kstep = (size_t)(BK * 2);
    const size_t hstep = (size_t)HALF * K * 2;
    const size_t tstep = 2 * hstep;
    const size_t tstepA = GATHER ? (size_t)0 : tstep;
    const unsigned ldsw = (unsigned)wid * 1024u;
    const int aoff = lds_byte(wr * 64 + fr, fq * 8), boff = lds_byte(wc * 32 + fr, fq * 8);
#define PG8_SA(b, h) (((b) * 2 + (h)) * HTB)
#define PG8_SB(b, h) ((4 + (b) * 2 + (h)) * HTB)
#define PG8_STAGEA(bufoff, gbase, h, NX) do { _Pragma("unroll") for (int _i = 0; _i < 2; ++_i) { \
        const unsigned _o = GATHER ? ((NX) ? oN[h][_i] : oC[h][_i]) : (unsigned)((h) * hstep) + voffA[_i]; \
        __builtin_amdgcn_global_load_lds((const unsigned*)((const char*)(gbase) + _o), (PG8_LAS unsigned*)(lds + (bufoff) + ldsw + _i * 8192), 16, 0, 0); } } while (0)
#define PG8_GIDX(dst, pm_) do { _Pragma("unroll") for (int _h = 0; _h < 2; ++_h) _Pragma("unroll") for (int _i = 0; _i < 2; ++_i) \
        dst[_h][_i] = ((unsigned)rowidx[(pm_) * BM + _h * HALF + RA[_i]] * (unsigned)K + (unsigned)CA[_i]) * 2u; } while (0)
#define PG8_STAGE(bufoff, gbase, voff) do { _Pragma("unroll") for (int _i = 0; _i < 2; ++_i) \
        __builtin_amdgcn_global_load_lds((const unsigned*)((const char*)(gbase) + (voff)[_i]), (PG8_LAS unsigned*)(lds + (bufoff) + ldsw + _i * 8192), 16, 0, 0); } while (0)
#define PG8_LDA(dst, b, h) do { _Pragma("unroll") for (int m = 0; m < 4; ++m) _Pragma("unroll") for (int k = 0; k < 2; ++k) dst[m][k] = *(const PG8_LAS bf16x8*)(lds + PG8_SA(b, h) + aoff + m * 2048 + k * 1024); } while (0)
#define PG8_LDB(dst, b, h) do { _Pragma("unroll") for (int n = 0; n < 2; ++n) _Pragma("unroll") for (int k = 0; k < 2; ++k) dst[n][k] = *(const PG8_LAS bf16x8*)(lds + PG8_SB(b, h) + boff + n * 2048 + k * 1024); } while (0)
#define PG8_MMA(ai, bj, At, Bt) do { __builtin_amdgcn_s_setprio(1); _Pragma("unroll") for (int m = 0; m < 4; ++m) _Pragma("unroll") for (int n = 0; n < 2; ++n) _Pragma("unroll") for (int k = 0; k < 2; ++k) \
        acc[ai][bj][m][n] = __builtin_amdgcn_mfma_f32_16x16x32_bf16(Bt[n][k], At[m][k], acc[ai][bj][m][n], 0, 0, 0); __builtin_amdgcn_s_setprio(0); } while (0)
#define PG8_WAIT_V(n) asm volatile("s_waitcnt vmcnt(" #n ")" ::: "memory")
#define PG8_WAIT_L(n) asm volatile("s_waitcnt lgkmcnt(" #n ")" ::: "memory")
#define PG8_BAR __builtin_amdgcn_s_barrier()
#define PG8_SCHED __builtin_amdgcn_sched_barrier(0)
    Unit cur, nxt; int ui = 0;
    if (!S.next(0, cur)) return;
    f32x4 acc[2][2][4][2];
#pragma unroll
    for (int a = 0; a < 2; ++a)
#pragma unroll
        for (int b = 0; b < 2; ++b)
#pragma unroll
            for (int m = 0; m < 4; ++m)
#pragma unroll
                for (int n = 0; n < 2; ++n) acc[a][b][m][n] = (f32x4){0.f, 0.f, 0.f, 0.f};
    bf16x8 At[4][2], B0[2][2], B1[2][2];
    const char* cA = (const char*)g.A + (size_t)cur.pm * tstepA; const char* cB = (const char*)g.Bt + (size_t)cur.pn * tstep;
    if constexpr (GATHER) { PG8_GIDX(oC, cur.pm); asm volatile("s_waitcnt vmcnt(0)" ::: "memory"); }
    S.a_ready(cur);
    if constexpr (SP2) {
        PG8_STAGE(PG8_SB(0, 0), cB, voffB); PG8_STAGE(PG8_SB(0, 1), cB + hstep, voffB); PG8_STAGEA(PG8_SA(0, 0), cA, 0, false); PG8_STAGEA(PG8_SA(0, 1), cA, 1, false);
        if (wr == 1) PG8_BAR;
        PG8_WAIT_V(2); PG8_BAR;
        PG8_STAGE(PG8_SB(1, 0), cB + kstep, voffB); PG8_STAGEA(PG8_SA(1, 0), cA + kstep, 0, false); PG8_STAGE(PG8_SB(1, 1), cB + hstep + kstep, voffB);
        PG8_WAIT_V(6); PG8_BAR;
    } else {
        PG8_STAGE(PG8_SB(0, 0), cB, voffB); PG8_STAGEA(PG8_SA(0, 0), cA, 0, false); PG8_STAGE(PG8_SB(0, 1), cB + hstep, voffB); PG8_STAGEA(PG8_SA(0, 1), cA, 1, false);
        if (wr == 1) PG8_BAR;
        PG8_WAIT_V(4); PG8_BAR;
        PG8_STAGE(PG8_SB(1, 0), cB + kstep, voffB); PG8_STAGEA(PG8_SA(1, 0), cA + kstep, 0, false); PG8_STAGE(PG8_SB(1, 1), cB + hstep + kstep, voffB);
        PG8_WAIT_V(6); PG8_BAR;
    }
    for (;;) {
        const bool has_next = S.next(ui + 1, nxt);
        const char* nA = has_next ? (const char*)g.A + (size_t)nxt.pm * tstepA : cA; const char* nB = has_next ? (const char*)g.Bt + (size_t)nxt.pn * tstep : cB;
        if constexpr (GATHER) { if (has_next) { PG8_GIDX(oN, nxt.pm); asm volatile("s_waitcnt vmcnt(0)" ::: "memory"); } else { _Pragma("unroll") for (int _h = 0; _h < 2; ++_h) _Pragma("unroll") for (int _i = 0; _i < 2; ++_i) oN[_h][_i] = oC[_h][_i]; } }
        for (int t = 0; t < nt; t += 2) {
            const bool last = (t == nt - 2);
            const char* a1 = cA + (size_t)(t + 1) * kstep;
            const char* a2 = last ? nA : cA + (size_t)(t + 2) * kstep; const char* b2 = last ? nB : cB + (size_t)(t + 2) * kstep;
            const char* a3 = a2 + kstep; const char* b3 = b2 + kstep;
            if (last && has_next) S.a_ready(nxt);
            if constexpr (SP2) {
            PG8_LDB(B0, 0, 0); PG8_LDB(B1, 0, 1); PG8_SCHED; PG8_LDA(At, 0, 0); PG8_STAGEA(PG8_SA(1, 1), a1, 1, false);
            PG8_WAIT_V(8); PG8_WAIT_L(0); PG8_BAR; PG8_MMA(0, 0, At, B0); PG8_MMA(0, 1, At, B1); PG8_BAR; PG8_SCHED;
            PG8_LDA(At, 0, 1); PG8_STAGE(PG8_SB(0, 0), b2, voffB); PG8_STAGE(PG8_SB(0, 1), b2 + hstep, voffB); PG8_STAGEA(PG8_SA(0, 0), a2, 0, last);
            PG8_WAIT_V(8); PG8_WAIT_L(0); PG8_BAR; PG8_MMA(1, 0, At, B0); PG8_MMA(1, 1, At, B1); PG8_BAR; PG8_SCHED;
            PG8_LDB(B0, 1, 0); PG8_LDB(B1, 1, 1); PG8_SCHED; PG8_LDA(At, 1, 0); PG8_STAGEA(PG8_SA(0, 1), a2, 1, last);
            PG8_WAIT_V(8); PG8_WAIT_L(0); PG8_BAR; PG8_MMA(0, 0, At, B0); PG8_MMA(0, 1, At, B1); PG8_BAR; PG8_SCHED;
            PG8_LDA(At, 1, 1); PG8_STAGE(PG8_SB(1, 0), b3, voffB); PG8_STAGE(PG8_SB(1, 1), b3 + hstep, voffB); PG8_STAGEA(PG8_SA(1, 0), a3, 0, last);
            PG8_WAIT_V(8); PG8_WAIT_L(0); PG8_BAR; PG8_MMA(1, 0, At, B0); PG8_MMA(1, 1, At, B1); PG8_BAR; PG8_SCHED;
            } else {
            PG8_LDB(B0, 0, 0); PG8_SCHED; PG8_LDA(At, 0, 0); PG8_STAGEA(PG8_SA(1, 1), a1, 1, false);
            PG8_WAIT_L(8); PG8_BAR; PG8_WAIT_L(0); PG8_MMA(0, 0, At, B0); PG8_BAR; PG8_SCHED;
            PG8_LDB(B1, 0, 1); PG8_STAGE(PG8_SB(0, 0), b2, voffB);
            PG8_BAR; PG8_WAIT_L(0); PG8_MMA(0, 1, At, B1); PG8_BAR;
            PG8_LDA(At, 0, 1); PG8_STAGEA(PG8_SA(0, 0), a2, 0, last);
            PG8_BAR; PG8_WAIT_L(0); PG8_MMA(1, 0, At, B0); PG8_BAR; PG8_SCHED;
            PG8_STAGE(PG8_SB(0, 1), b2 + hstep, voffB);
            PG8_WAIT_V(6); PG8_BAR; PG8_MMA(1, 1, At, B1); PG8_BAR;
            PG8_LDB(B0, 1, 0); PG8_SCHED; PG8_LDA(At, 1, 0); PG8_STAGEA(PG8_SA(0, 1), a2, 1, last);
            PG8_WAIT_L(8); PG8_BAR; PG8_WAIT_L(0); PG8_MMA(0, 0, At, B0); PG8_BAR; PG8_SCHED;
            PG8_LDB(B1, 1, 1); PG8_STAGE(PG8_SB(1, 0), b3, voffB);
            PG8_BAR; PG8_WAIT_L(0); PG8_MMA(0, 1, At, B1); PG8_BAR;
            PG8_LDA(At, 1, 1); PG8_STAGEA(PG8_SA(1, 0), a3, 0, last);
            PG8_BAR; PG8_WAIT_L(0); PG8_MMA(1, 0, At, B0); PG8_BAR; PG8_SCHED;
            PG8_STAGE(PG8_SB(1, 1), b3 + hstep, voffB);
            PG8_WAIT_V(6); PG8_BAR; PG8_MMA(1, 1, At, B1); PG8_BAR;
            }
        }
        if constexpr (ALIGN_EPI) { if (wr == 0) PG8_BAR; }
        if constexpr (!Epi::AFTER_DRAIN) { const int l2_ = lane_id_asm(); E(acc, cur, wr, wc, l2_ & 15, l2_ >> 4); S.done(cur); }
        if (!has_next) break;
#pragma unroll
        for (int a = 0; a < 2; ++a)
#pragma unroll
            for (int b = 0; b < 2; ++b)
#pragma unroll
                for (int m = 0; m < 4; ++m)
#pragma unroll
                    for (int n = 0; n < 2; ++n) acc[a][b][m][n] = (f32x4){0.f, 0.f, 0.f, 0.f};
        cur = nxt; cA = nA; cB = nB; ++ui;
        if constexpr (GATHER) { _Pragma("unroll") for (int _h = 0; _h < 2; ++_h) _Pragma("unroll") for (int _i = 0; _i < 2; ++_i) oC[_h][_i] = oN[_h][_i]; }
        if constexpr (ALIGN_EPI) { if (wr == 1) PG8_BAR; }
    }
    PG8_WAIT_V(0);
    if constexpr (!ALIGN_EPI) { if (wr == 0) PG8_BAR; }
    PG8_BAR;
    if constexpr (Epi::AFTER_DRAIN) { const int l2_ = lane_id_asm(); E.fused(acc, cur, wr, wc, l2_ & 15, l2_ >> 4, lds, wid, l2_); S.done(cur); }
#undef PG8_SA
#undef PG8_SB
#undef PG8_STAGE
#undef PG8_STAGEA
#undef PG8_GIDX
#undef PG8_LDA
#undef PG8_LDB
#undef PG8_MMA
#undef PG8_WAIT_V
#undef PG8_WAIT_L
#undef PG8_BAR
#undef PG8_SCHED
}
}

constexpr int DM = 1024, NB = 8, SEQ = 4096, CTXL = 256, DEPTH = 4;
constexpr int ML = NB * SEQ;
constexpr int MC = NB * CTXL;
constexpr int MT = ML + MC;
constexpr int INC = 2560;
constexpr int C_S5 = 768, C_Q = 1024, C_K = 1536, C_V = 2048;
constexpr int NMOD = 6 * DM;
constexpr int NEXP = 32, EHID = 512;
constexpr int NSLOT = (MT * 2 / 256 + NEXP) * 256;
constexpr float EPSF = 1e-6f;
constexpr int S5T = 32;
constexpr int S5ROWS = MT / S5T;
constexpr int S5RP = 1280;
constexpr int NWAVES = 8, NTHR = 512;
constexpr int NPL = 11;
constexpr int PH_LAYER0 = 2, PH_FINAL = PH_LAYER0 + DEPTH * NPL, PH_TOTAL = PH_FINAL + 1;

constexpr size_t MiB = 1u << 20;
constexpr size_t WS_CTL = 0, CTL_ZERO_BYTES = 1 * MiB;
constexpr size_t WS_MODV = 2 * MiB;
constexpr size_t WS_MISC = 3 * MiB;
constexpr size_t WS_ROPE = 4 * MiB;
constexpr size_t WS_H2T = 5 * MiB;
constexpr size_t WS_H2C = 9 * MiB;
constexpr size_t WS_FC = 10 * MiB;
constexpr size_t WS_GLUT = 13 * MiB;
constexpr size_t WS_WINT = 16 * MiB;
constexpr size_t WS_WOUTT = 36 * MiB;
constexpr size_t WS_S5MB = 44 * MiB;
constexpr size_t WS_S5CS = 92 * MiB;
constexpr size_t WS_FSPEC = 108 * MiB;
constexpr size_t WS_X = 172 * MiB;
constexpr size_t WS_H = 308 * MiB;
constexpr size_t WS_MOEW13 = 377 * MiB;
constexpr size_t WS_MOEW2 = 441 * MiB;
constexpr size_t WS_U5 = 473 * MiB;
constexpr size_t WS_YI = 493 * MiB;
constexpr size_t WS_ST = 533 * MiB;
constexpr size_t WS_HIN = 553 * MiB;
constexpr size_t WS_GY = 563 * MiB;
constexpr size_t WS_HYW = 583 * MiB;
constexpr size_t WS_HYWC = 615 * MiB;
constexpr size_t WS_TOK = 617 * MiB;
constexpr size_t WS_R = 620 * MiB;
constexpr size_t WS_P = WS_R;
constexpr size_t WS_QR = WS_R + 170 * MiB;
constexpr size_t WS_MIX = WS_R + 202 * MiB;
constexpr size_t WS_HID = WS_R;
constexpr size_t WS_YB = WS_R + 76 * MiB;
constexpr size_t WS_END = WS_R + 270 * MiB;
constexpr size_t TK_E = 0, TK_POS = TK_E + (size_t)MT * 2 * 4, TK_GATE = TK_POS + (size_t)MT * 2 * 4, TK_SLOT = TK_GATE + (size_t)MT * 2 * 4;
constexpr size_t TK_STOK = TK_SLOT + (size_t)MT * 2 * 4, TK_SGATE = TK_STOK + (size_t)NSLOT * 4, TK_TILEE = TK_SGATE + (size_t)NSLOT * 4, TK_END = TK_TILEE + 4096;
static_assert(TK_END <= 3 * MiB, "routing tables");
constexpr int CW_TMO = 0;
constexpr int CW_BAR = 4096;
constexpr int CW_CNT = 16384;
constexpr int CW_NTILES = 16384 + 1024;

constexpr int LDS_BYTES = 163840;
constexpr int MISC_OFF = 162816;

#define GAS __attribute__((address_space(1)))
#define LAS __attribute__((address_space(3)))
typedef unsigned short bf16;
typedef unsigned v4u __attribute__((ext_vector_type(4)));
typedef unsigned v2u __attribute__((ext_vector_type(2)));
typedef float f32x4 __attribute__((ext_vector_type(4)));
typedef float f32x2 __attribute__((ext_vector_type(2)));
typedef float f32x16 __attribute__((ext_vector_type(16)));
typedef short bf16x8 __attribute__((ext_vector_type(8)));
typedef short s16x4 __attribute__((ext_vector_type(4)));
typedef GAS unsigned gu32;
#define RLX_AGENT __ATOMIC_RELAXED, __HIP_MEMORY_SCOPE_AGENT
#define LDS_WAIT() asm volatile("s_waitcnt lgkmcnt(0)" ::: "memory")
#define VM_WAIT() asm volatile("s_waitcnt vmcnt(0)" ::: "memory")
__device__ __forceinline__ unsigned f2bf(float f) { unsigned u = __builtin_bit_cast(unsigned, f); return (u + 0x7fffu + ((u >> 16) & 1u)) >> 16; }
__device__ __forceinline__ unsigned pk2(float lo, float hi) { return pg8::cvt_pk_bf16(lo, hi); }
__device__ __forceinline__ float bf2f(unsigned short h) { return __builtin_bit_cast(float, (unsigned)h << 16); }
__device__ __forceinline__ float bflo(unsigned w) { return __builtin_bit_cast(float, w << 16); }
__device__ __forceinline__ float bfhi(unsigned w) { return __builtin_bit_cast(float, w & 0xffff0000u); }
__device__ __forceinline__ float fexp(float x) { return __builtin_amdgcn_exp2f(x * 1.4426950408889634f); }
__device__ __forceinline__ float fsigmoid(float x) { return __builtin_amdgcn_rcpf(1.f + fexp(-x)); }
__device__ __forceinline__ float fsilu(float x) { return x * fsigmoid(x); }
__device__ __forceinline__ float fgelu_tanh(float x) { const float u = 0.7978845608028654f * (x + 0.044715f * x * x * x); return x * fsigmoid(2.f * u); }
template <int M> __device__ __forceinline__ float xor_add(float v) {
    if constexpr (M < 32) return v + __builtin_bit_cast(float, __builtin_amdgcn_ds_swizzle(__builtin_bit_cast(int, v), (M << 10) | 0x1f));
    else { auto rr = __builtin_amdgcn_permlane32_swap(__float_as_uint(v), __float_as_uint(v), false, false); const unsigned a = rr[0], b = rr[1]; return __uint_as_float(a) + __uint_as_float(b); }
}
__device__ __forceinline__ float wave_sum(float v) { v = xor_add<1>(v); v = xor_add<2>(v); v = xor_add<4>(v); v = xor_add<8>(v); v = xor_add<16>(v); v = xor_add<32>(v); return v; }
#define XB_TMO      128
#define XB_XCNT(j)  (256  + 64 * (j))
#define XB_XSUB(j)  (1280 + 64 * (j))
#define XB_XGEN(j)  (2304 + 64 * (j))
#define XB_TOP      3328
#define XB_TOPGEN   3392
#define XCD_BAR_WORDS 3456
#define XB_SPIN_CAP (1u << 18)

__device__ __forceinline__ unsigned xb_ld(unsigned* p)              { return __hip_atomic_load(p, __ATOMIC_RELAXED, __HIP_MEMORY_SCOPE_AGENT); }
__device__ __forceinline__ unsigned xb_add(unsigned* p, unsigned v) { return __hip_atomic_fetch_add(p, v, __ATOMIC_RELAXED, __HIP_MEMORY_SCOPE_AGENT); }
__device__ __forceinline__ unsigned xb_xcc_id() { return (unsigned)__builtin_amdgcn_s_getreg((3 << 11) | 20) & 0xFu; }
#define XB_SPIN(cond, bar) do { unsigned _sp = 0; while (cond) { __builtin_amdgcn_s_sleep(1); \
    if ((++_sp & 255u) == 0u) { if (xb_ld(&(bar)[XB_TMO])) break; if (_sp > XB_SPIN_CAP) { atomicAdd(&(bar)[XB_TMO], 1u); break; } } } } while (0)

struct XcdBarrier {
    unsigned* bar; unsigned x;
    volatile LAS unsigned* st;
};

__device__ __forceinline__ XcdBarrier xcd_barrier_post(unsigned* bar, volatile LAS unsigned* st, int tid) {
    XcdBarrier b; b.bar = bar; b.x = xb_xcc_id(); b.st = st;
    if (tid == 0) (void)xb_add(&bar[XB_XCNT(b.x)], 1u);
    return b;
}
__device__ __forceinline__ void xcd_barrier_complete(unsigned* bar, unsigned x, unsigned& nloc, unsigned& nx) {
    const unsigned G = gridDim.x * gridDim.y * gridDim.z;
    unsigned sum, cnt, mine, sp = 0u;
    for (;;) {
        sum = 0u; cnt = 0u; mine = 0u;
#pragma unroll
        for (unsigned j = 0; j < 16; ++j) { const unsigned c = xb_ld(&bar[XB_XCNT(j)]); sum += c; cnt += (c > 0u) ? 1u : 0u; mine = (j == x) ? c : mine; }
        if (sum == G) break;
        __builtin_amdgcn_s_sleep(1);
        if ((++sp & 255u) == 0u) { if (xb_ld(&bar[XB_TMO])) break; if (sp > XB_SPIN_CAP) { atomicAdd(&bar[XB_TMO], 1u); break; } }
    }
    nloc = mine > 0u ? mine : 1u; nx = cnt > 0u ? cnt : 1u;
}

__device__ __forceinline__ void xcd_barrier(const XcdBarrier& b, int tid) {
    asm volatile("s_waitcnt vmcnt(0)" ::: "memory");
    __syncthreads();
    if (tid == 0) {
        unsigned* bar = b.bar;
        __builtin_amdgcn_s_waitcnt(0);
        unsigned nloc = b.st[0], nx = b.st[1];
        if (nloc == 0u) { xcd_barrier_complete(bar, b.x, nloc, nx); b.st[0] = nloc; b.st[1] = nx; }
        const unsigned old = xb_add(&bar[XB_XSUB(b.x)], 1u);
        const unsigned gen = old / nloc;
        if (old + 1u == (gen + 1u) * nloc) {
            __builtin_amdgcn_fence(__ATOMIC_RELEASE, "agent");
            asm volatile("s_waitcnt vmcnt(0)" ::: "memory");
            const unsigned og = xb_add(&bar[XB_TOP], 1u);
            const unsigned tg = og / nx;
            if (og + 1u == (tg + 1u) * nx) xb_add(&bar[XB_TOPGEN], 1u);
            else XB_SPIN(xb_ld(&bar[XB_TOPGEN]) == tg, bar);
            __builtin_amdgcn_fence(__ATOMIC_ACQUIRE, "agent");
            xb_add(&bar[XB_XGEN(b.x)], 1u);
            asm volatile("s_waitcnt vmcnt(0)" ::: "memory");
        } else {
            XB_SPIN(xb_ld(&bar[XB_XGEN(b.x)]) == gen, bar);
            __builtin_amdgcn_fence(__ATOMIC_ACQUIRE, "agent");
            asm volatile("s_waitcnt vmcnt(0)" ::: "memory");
        }
    }
    __syncthreads();
}

struct Args { const float* in[43]; float* out; unsigned char* ws; int ph_lo, ph_hi; };
enum InIdx { I_X = 0, I_C, I_CTX, I_CCTX, I_WMOD, I_BMOD, I_N1G, I_N2G, I_FING, I_WIN, I_WOUT, I_HYCW, I_HYCB, I_HYW1, I_HYB1, I_HYW2, I_HYB2, I_HYW3, I_HYFREQ, I_HYSKIP, I_HYNG,
             I_S5ARE, I_S5AIM, I_S5LDT, I_S5BRE, I_S5BIM, I_S5CRE, I_S5CIM, I_S5D, I_S5GLU, I_S5NG, I_LQ1, I_LK1, I_LQ2, I_LK2, I_SUBLN, I_MWG, I_MBG, I_MWE, I_MBE, I_MW1, I_MW3, I_MW2 };
struct Frame {
    LAS unsigned char* lds;
    float* out; unsigned char* ws; gu32* ctl;
    int tid, lane, wave, vcu, G, bx;
};
#define WSP(T, off) ((T*)(F.ws + (off)))
__device__ __forceinline__ const float* inptr(int idx) { const unsigned long ka = (unsigned long)__builtin_amdgcn_kernarg_segment_ptr(); const float* p;
    asm volatile("s_load_dwordx2 %0, %1, %2\n\ts_waitcnt lgkmcnt(0)" : "=s"(p) : "s"(ka), "n"(idx * 8)); return p; }

template <class RowMap>
__device__ __forceinline__ void transpose_item(const float* W, int K, int N, bf16* WT, LAS float* scr, int item, int lane, const RowMap& rowmap) {
    const int nblk = N / 32, kb = item / nblk, nb = item % nblk, k0 = 64 * kb, n0 = 32 * nb;
#pragma unroll 8
    for (int i = 0; i < 32; ++i) { const int kk = 2 * i + (lane >> 5); scr[kk * 33 + (lane & 31)] = W[(size_t)(k0 + kk) * N + n0 + (lane & 31)]; }
    LDS_WAIT(); asm volatile("" ::: "memory");
    const int c = lane & 7;
#pragma unroll
    for (int j = 0; j < 4; ++j) { const int n = (lane >> 3) + 8 * j; const LAS float* s = scr + (8 * c) * 33 + n;
        v4u o; o.x = pk2(s[0 * 33], s[1 * 33]); o.y = pk2(s[2 * 33], s[3 * 33]); o.z = pk2(s[4 * 33], s[5 * 33]); o.w = pk2(s[6 * 33], s[7 * 33]);
        *(GAS v4u*)(WT + (size_t)rowmap(n0 + n) * K + k0 + 8 * c) = o; }
    LDS_WAIT(); asm volatile("" ::: "memory");
}
struct RowId { __device__ __forceinline__ int operator()(int n) const { return n; } };
struct RowWin {
    __device__ __forceinline__ int operator()(int n) const { if (n < C_Q || n >= C_V) return n; const int d = n & 63, j = d & 31, s = d >> 5; return (n - d) + 2 * j + s; } };
struct RowW13 { int off; __device__ __forceinline__ int operator()(int j) const { return (j >> 7) * 256 + off + (j & 127); } };

__device__ __forceinline__ void p0_modv(Frame& F) {
    const float* const in_BMOD = inptr(I_BMOD);
    const float* const in_C = inptr(I_C);
    const float* const in_CCTX = inptr(I_CCTX);
    const float* const in_WMOD = inptr(I_WMOD);
    LAS float* sc = (LAS float*)F.lds;
    LAS float* red = (LAS float*)(F.lds + 36864);
    for (int i = F.tid; i < 9 * 1024; i += NTHR) { const int bi = i >> 10, k = i & 1023; const float v = bi < 8 ? in_C[bi * 1024 + k] : in_CCTX[k]; sc[i] = fsilu(v); }
    __syncthreads();
    for (int unit = F.vcu; unit < DEPTH * 48; unit += F.G) {
        const int l = unit / 48, cb = unit % 48, c4 = F.tid & 31, kk = F.tid >> 5;
        f32x4 acc[9];
#pragma unroll
        for (int b = 0; b < 9; ++b) acc[b] = (f32x4){0.f, 0.f, 0.f, 0.f};
        const float* wb = in_WMOD + (size_t)l * DM * NMOD + cb * 128 + c4 * 4;
#pragma unroll 4
        for (int i = 0; i < 64; ++i) { const int k = kk + 16 * i; const f32x4 w = *(const f32x4*)(wb + (size_t)k * NMOD);
#pragma unroll
            for (int b = 0; b < 9; ++b) acc[b] += sc[b * 1024 + k] * w; }
#pragma unroll
        for (int b = 0; b < 9; ++b) *(LAS f32x4*)(red + (kk * 9 + b) * 128 + c4 * 4) = acc[b];
        __syncthreads();
        for (int o = F.tid; o < 9 * 128; o += NTHR) { const int b = o >> 7, cc = o & 127; float s = in_BMOD[l * NMOD + cb * 128 + cc];
#pragma unroll
            for (int q = 0; q < 16; ++q) s += red[(q * 9 + b) * 128 + cc];
            WSP(float, WS_MODV)[(size_t)(l * 9 + b) * NMOD + cb * 128 + cc] = s; }
        __syncthreads();
    }
    __syncthreads();
}
__device__ __forceinline__ void p0_weights(Frame& F) {
    const float* const in_S5GLU = inptr(I_S5GLU);
    const float* const in_WIN = inptr(I_WIN);
    const float* const in_WOUT = inptr(I_WOUT);
    LAS float* scr = (LAS float*)(F.lds + F.wave * 8448);
    const int gw = F.vcu * NWAVES + F.wave, NGW = F.G * NWAVES;
    constexpr int I_IN = (DM / 64) * (INC / 32), I_OUT = (DM / 64) * (DM / 32), I_GLU = (256 / 64) * (256 / 32);
    constexpr int NIT = DEPTH * (I_IN + I_OUT + I_GLU);
    for (int it = gw; it < NIT; it += NGW) {
        int r = it; const int l = r / (I_IN + I_OUT + I_GLU); r -= l * (I_IN + I_OUT + I_GLU);
        if (r < I_IN) { transpose_item(in_WIN + (size_t)l * DM * INC, DM, INC, WSP(bf16, WS_WINT) + (size_t)l * INC * DM, scr, r, F.lane, RowWin{}); continue; } r -= I_IN;
        if (r < I_OUT) { transpose_item(in_WOUT + (size_t)l * DM * DM, DM, DM, WSP(bf16, WS_WOUTT) + (size_t)l * DM * DM, scr, r, F.lane, RowId{}); continue; } r -= I_OUT;
        transpose_item(in_S5GLU + (size_t)l * 65536, 256, 256, WSP(bf16, WS_GLUT) + (size_t)l * 65536, scr, r, F.lane, RowId{});
    }
}
__device__ __forceinline__ void moe_weights(Frame& F, int l) {
    const float* const in_MW1 = inptr(I_MW1);
    const float* const in_MW2 = inptr(I_MW2);
    const float* const in_MW3 = inptr(I_MW3);
    LAS float* scr = (LAS float*)(F.lds + F.wave * 8448);
    const int gw = F.vcu * NWAVES + F.wave, NGW = F.G * NWAVES;
    constexpr int I_1 = (DM / 64) * (EHID / 32), I_2 = (EHID / 64) * (DM / 32);
    for (int it = gw; it < NEXP * (2 * I_1 + I_2); it += NGW) {
        const int e = it / (2 * I_1 + I_2); int r = it - e * (2 * I_1 + I_2);
        const size_t eo = (size_t)(l * NEXP + e) * DM * EHID;
        if (r < I_1) { transpose_item(in_MW1 + eo, DM, EHID, WSP(bf16, WS_MOEW13) + (size_t)e * 1024 * 1024, scr, r, F.lane, RowW13{0}); continue; } r -= I_1;
        if (r < I_1) { transpose_item(in_MW3 + eo, DM, EHID, WSP(bf16, WS_MOEW13) + (size_t)e * 1024 * 1024, scr, r, F.lane, RowW13{128}); continue; } r -= I_1;
        transpose_item(in_MW2 + eo, EHID, DM, WSP(bf16, WS_MOEW2) + (size_t)e * 1024 * 512, scr, r, F.lane, RowId{});
    }
}
__device__ __forceinline__ void p0_h2(Frame& F) {
    const float* const in_HYB1 = inptr(I_HYB1);
    const float* const in_HYB2 = inptr(I_HYB2);
    const float* const in_HYFREQ = inptr(I_HYFREQ);
    const float* const in_HYW1 = inptr(I_HYW1);
    const float* const in_HYW2 = inptr(I_HYW2);
    LAS float* feat = (LAS float*)F.lds;
    LAS float* h1 = feat + 8 * 33;
    constexpr int UPL = (SEQ + CTXL) / 8;
    for (int unit = F.vcu; unit < DEPTH * UPL; unit += F.G) {
        const int l = unit / UPL, ub = unit % UPL; const bool isc = ub >= SEQ / 8; const int pos0 = isc ? (ub - SEQ / 8) * 8 : ub * 8; const float invL = isc ? 1.f / CTXL : 1.f / SEQ;
        if (F.tid < 8 * 33) { const int p = F.tid / 33, j = F.tid % 33; const float t = (float)(pos0 + p) * invL; float v;
            if (j == 0) v = t; else { const int m = j <= 16 ? j : j - 16; const float ang = 6.283185307179586f * t * (float)m; v = j <= 16 ? cosf(ang) : sinf(ang); }
            feat[F.tid] = v; }
        __syncthreads();
        const int p = F.tid >> 6, k = F.tid & 63;
        { float s = in_HYB1[l * 64 + k]; const float* w1 = in_HYW1 + (size_t)l * 33 * 64 + k;
#pragma unroll
          for (int j = 0; j < 33; ++j) s += feat[p * 33 + j] * w1[j * 64];
          h1[p * 64 + k] = sinf(in_HYFREQ[l * 64 + k] * s); }
        __syncthreads();
        { float s = in_HYB2[l * 64 + k]; const float* w2 = in_HYW2 + (size_t)l * 64 * 64 + k;
#pragma unroll 8
          for (int j = 0; j < 64; ++j) s += h1[p * 64 + j] * w2[j * 64];
          const float v = sinf(in_HYFREQ[l * 64 + k] * s);
          if (isc) WSP(float, WS_H2C)[((size_t)l * CTXL + pos0 + p) * 64 + k] = v; else WSP(float, WS_H2T)[((size_t)l * SEQ + pos0 + p) * 64 + k] = v; }
        __syncthreads();
    }
}
__device__ __forceinline__ void p0_misc(Frame& F) {
    const float* const in_LK1 = inptr(I_LK1);
    const float* const in_LK2 = inptr(I_LK2);
    const float* const in_LQ1 = inptr(I_LQ1);
    const float* const in_LQ2 = inptr(I_LQ2);
    for (int i = F.vcu * NTHR + F.tid; i < SEQ * 32; i += F.G * NTHR) { const int t = i >> 5, j = i & 31; const float inv = powf(10000.f, -(float)(j & 15) / 16.f);
        const float ang = (float)(j < 16 ? (t >> 6) : (t & 63)) * inv; WSP(f32x2, WS_ROPE)[i] = (f32x2){cosf(ang), sinf(ang)}; }
    if (F.bx == 0) {
        if (F.tid < DEPTH) { const int l = F.tid; float s1 = 0.f, s2 = 0.f;
            for (int d = 0; d < 64; ++d) { s1 += in_LQ1[l * 64 + d] * in_LK1[l * 64 + d]; s2 += in_LQ2[l * 64 + d] * in_LK2[l * 64 + d]; }
            const float li = 0.8f - 0.6f * expf(-0.3f * (float)l);
            WSP(float, WS_MISC)[l] = expf(s1) - expf(s2) + li; WSP(float, WS_MISC)[4 + l] = 1.f - li; }
        for (int i = F.tid; i < DM / 2; i += NTHR) WSP(unsigned, WS_H)[(size_t)MT * (DM / 2) + i] = 0u;
    }
}
__device__ __forceinline__ void p0_s5(Frame& F) {
    const float* const in_S5AIM = inptr(I_S5AIM);
    const float* const in_S5ARE = inptr(I_S5ARE);
    const float* const in_S5BIM = inptr(I_S5BIM);
    const float* const in_S5BRE = inptr(I_S5BRE);
    const float* const in_S5CIM = inptr(I_S5CIM);
    const float* const in_S5CRE = inptr(I_S5CRE);
    const float* const in_S5D = inptr(I_S5D);
    const float* const in_S5LDT = inptr(I_S5LDT);
    LAS f32x2* ap = (LAS f32x2*)F.lds;
    LAS f32x2* bb = ap + 2 * 33 * 64;
    LAS f32x2* cc = bb + 2 * 64 * 16;
    LAS float* kt = (LAS float*)(cc + 2 * 16 * 64);
    for (int unit = F.vcu; unit < DEPTH * 16; unit += F.G) {
        const int l = unit >> 4, g = unit & 15;
        for (int i = F.tid; i < 2 * 33 * 64; i += NTHR) { const int d = i / (33 * 64), tau = (i / 64) % 33, p = i & 63; const int pi = ((l * 2 + d) * 16 + g) * 64 + p;
            const float dt = expf(in_S5LDT[(l * 2 + d) * 16 + g]); const float xr = (float)tau * dt * in_S5ARE[pi], xi = (float)tau * dt * in_S5AIM[pi];
            const float m = expf(xr); ap[i] = (f32x2){m * cosf(xi), m * sinf(xi)}; }
        for (int i = F.tid; i < 2 * 64 * 16; i += NTHR) { const int d = i >> 10, p = (i >> 4) & 63, h = i & 15; const int pi = ((l * 2 + d) * 16 + g) * 64 + p;
            const float dt = expf(in_S5LDT[(l * 2 + d) * 16 + g]); const float ar = in_S5ARE[pi], ai = in_S5AIM[pi];
            const float m = expf(dt * ar); const float er = m * cosf(dt * ai) - 1.f, ei = m * sinf(dt * ai);
            const float den = 1.f / (ar * ar + ai * ai); const float cr = (er * ar + ei * ai) * den, ci = (ei * ar - er * ai) * den;
            const float br = in_S5BRE[(size_t)pi * 16 + h], bi = in_S5BIM[(size_t)pi * 16 + h];
            bb[i] = (f32x2){cr * br - ci * bi, cr * bi + ci * br}; }
        for (int i = F.tid; i < 2 * 16 * 64; i += NTHR) { const int d = i >> 10, h = (i >> 6) & 15, p = i & 63; const size_t ci = ((size_t)((l * 2 + d) * 16 + g) * 16 + h) * 64 + p;
            cc[i] = (f32x2){in_S5CRE[ci], in_S5CIM[ci]}; }
        __syncthreads();
        for (int i = F.tid; i < 2 * 32 * 256; i += NTHR) { const int d = i >> 13, tau = (i >> 8) & 31, h = (i >> 4) & 15, h2 = i & 15; float s = 0.f;
            for (int p = 0; p < 64; ++p) { const f32x2 c = cc[(d * 16 + h) * 64 + p], a = ap[(d * 33 + tau) * 64 + p], b = bb[(d * 64 + p) * 16 + h2];
                const float tr = c.x * a.x - c.y * a.y, ti = c.x * a.y + c.y * a.x; s += tr * b.x - ti * b.y; }
            kt[i] = s; }
        __syncthreads();
        bf16* MB = WSP(bf16, WS_S5MB) + (size_t)(l * 16 + g) * 768 * 512;
        bf16* CS = WSP(bf16, WS_S5CS) + (size_t)(l * 16 + g) * 512 * 256;
        for (int i = F.tid; i < 512 * 64; i += NTHR) { const int n = i >> 6, k8 = (i & 63) * 8, t = n >> 4, h = n & 15, s = k8 >> 4, h0 = k8 & 15; float v[8];
#pragma unroll
            for (int j = 0; j < 8; ++j) { float x = 0.f; if (t >= s) x += kt[((0 * 32 + (t - s)) * 16 + h) * 16 + h0 + j]; if (s >= t) x += kt[((1 * 32 + (s - t)) * 16 + h) * 16 + h0 + j];
                if (t == s && h == h0 + j) x += in_S5D[l * 256 + g * 16 + h]; v[j] = x; }
            *(GAS v4u*)(MB + (size_t)n * 512 + k8) = (v4u){pk2(v[0], v[1]), pk2(v[2], v[3]), pk2(v[4], v[5]), pk2(v[6], v[7])}; }
        for (int i = F.tid; i < 256 * 64; i += NTHR) { const int n = i >> 6, k8 = (i & 63) * 8, d = n >> 7, im = (n >> 6) & 1, p = n & 63, s = k8 >> 4, h0 = k8 & 15; float v[8];
            const f32x2 a = ap[(d * 33 + (d == 0 ? 31 - s : s)) * 64 + p];
#pragma unroll
            for (int j = 0; j < 8; ++j) { const f32x2 b = bb[(d * 64 + p) * 16 + h0 + j]; v[j] = im ? (a.x * b.y + a.y * b.x) : (a.x * b.x - a.y * b.y); }
            *(GAS v4u*)(MB + (size_t)(512 + n) * 512 + k8) = (v4u){pk2(v[0], v[1]), pk2(v[2], v[3]), pk2(v[4], v[5]), pk2(v[6], v[7])}; }
        for (int i = F.tid; i < 512 * 32; i += NTHR) { const int n = i >> 5, k8 = (i & 31) * 8, t = n >> 4, h = n & 15, d = k8 >> 7, im = (k8 >> 6) & 1, p0 = k8 & 63; float v[8];
#pragma unroll
            for (int j = 0; j < 8; ++j) { const f32x2 c = cc[(d * 16 + h) * 64 + p0 + j], a = ap[(d * 33 + (d == 0 ? t + 1 : 32 - t)) * 64 + p0 + j];
                v[j] = im ? -(c.x * a.y + c.y * a.x) : (c.x * a.x - c.y * a.y); }
            *(GAS v4u*)(CS + (size_t)n * 256 + k8) = (v4u){pk2(v[0], v[1]), pk2(v[2], v[3]), pk2(v[4], v[5]), pk2(v[6], v[7])}; }
        __syncthreads();
    }
}

__device__ __forceinline__ f32x2 cmul(f32x2 a, f32x2 b) { return (f32x2){a.x * b.x - a.y * b.y, a.x * b.y + a.y * b.x}; }
__device__ __forceinline__ f32x2 twid(int p, float invB) { const float x = (float)p * invB; return (f32x2){__builtin_amdgcn_cosf(x), -__builtin_amdgcn_sinf(x)}; }
template <bool INV> __device__ __forceinline__ void bfly(f32x2& a, f32x2& b, f32x2 w) {
    if (!INV) { const f32x2 s = a + b, d = a - b; a = s; b = cmul(d, w); }
    else { const f32x2 t = cmul(b, (f32x2){w.x, -w.y}); const f32x2 s = a + t, d = a - t; a = s; b = d; }
}
template <bool INV> __device__ __forceinline__ void fft_r8(LAS f32x2* buf, int B, int tid) {
    const int S = B >> 3; const float iB = 1.f / (float)B;
#pragma unroll 1
    for (int gi = tid; gi < 1024; gi += NTHR) {
        const int blk = gi / S, j = gi - blk * S, base = blk * B + j;
        f32x2 x[8];
#pragma unroll
        for (int k = 0; k < 8; ++k) x[k] = buf[base + k * S];
        if (!INV) {
#pragma unroll
            for (int k = 0; k < 4; ++k) bfly<false>(x[k], x[k + 4], twid(j + k * S, iB));
#pragma unroll
            for (int hh = 0; hh < 8; hh += 4)
#pragma unroll
                for (int k = 0; k < 2; ++k) bfly<false>(x[hh + k], x[hh + k + 2], twid(j + k * S, 2.f * iB));
            const f32x2 w = twid(j, 4.f * iB);
#pragma unroll
            for (int q = 0; q < 8; q += 2) bfly<false>(x[q], x[q + 1], w);
        } else {
            const f32x2 w = twid(j, 4.f * iB);
#pragma unroll
            for (int q = 0; q < 8; q += 2) bfly<true>(x[q], x[q + 1], w);
#pragma unroll
            for (int hh = 0; hh < 8; hh += 4)
#pragma unroll
                for (int k = 0; k < 2; ++k) bfly<true>(x[hh + k], x[hh + k + 2], twid(j + k * S, 2.f * iB));
#pragma unroll
            for (int k = 0; k < 4; ++k) bfly<true>(x[k], x[k + 4], twid(j + k * S, iB));
        }
#pragma unroll
        for (int k = 0; k < 8; ++k) buf[base + k * S] = x[k];
    }
    __syncthreads();
}
__device__ __forceinline__ void fft_r2(LAS f32x2* buf, int tid) {
    for (int i = tid; i < 4096; i += NTHR) { const f32x2 a = buf[2 * i], b = buf[2 * i + 1]; buf[2 * i] = a + b; buf[2 * i + 1] = a - b; }
    __syncthreads();
}
__device__ __forceinline__ void fft_fwd(LAS f32x2* buf, int tid) { fft_r8<false>(buf, 8192, tid); fft_r8<false>(buf, 1024, tid); fft_r8<false>(buf, 128, tid); fft_r8<false>(buf, 16, tid); fft_r2(buf, tid); }
__device__ __forceinline__ void fft_inv(LAS f32x2* buf, int tid) { fft_r2(buf, tid); fft_r8<true>(buf, 16, tid); fft_r8<true>(buf, 128, tid); fft_r8<true>(buf, 1024, tid); fft_r8<true>(buf, 8192, tid); }

constexpr float HY_DMIN = 3.0701134573253946f, HY_DMAX = 15.350567286626973f;
__device__ __forceinline__ float block_sum(float v, LAS float* red, int tid) {
    v = wave_sum(v); __syncthreads(); if ((tid & 63) == 0) red[tid >> 6] = v; __syncthreads();
    float s = 0.f;
#pragma unroll
    for (int w = 0; w < NWAVES; ++w) s += red[w];
    return s;
}
__device__ __forceinline__ void p0_filters(Frame& F) {
    const float* const in_HYSKIP = inptr(I_HYSKIP);
    const float* const in_HYW3 = inptr(I_HYW3);
    LAS f32x2* buf = (LAS f32x2*)F.lds; LAS float* w3s = (LAS float*)(F.lds + 65536); LAS float* red = w3s + 128;
    for (int unit = F.vcu; unit < DEPTH * 256; unit += F.G) {
        const int l = unit >> 8, c = unit & 255;
        if (F.tid < 128) w3s[F.tid] = in_HYW3[(size_t)l * 64 * 512 + (F.tid & 63) * 512 + (F.tid >> 6) * 256 + c];
        __syncthreads();
        const float decay = HY_DMIN + (HY_DMAX - HY_DMIN) * (float)c / 255.f;
        float asum = 0.f; float vals[16];
#pragma unroll 1
        for (int i = 0; i < 16; ++i) { const int n = F.tid + NTHR * i; float v = 0.f;
            if (n != SEQ) { const int pos = n < SEQ ? n : 2 * SEQ - n; const LAS float* w = w3s + (n < SEQ ? 0 : 64); const f32x4* hp = (const f32x4*)(WSP(float, WS_H2T) + ((size_t)l * SEQ + pos) * 64);
                float s = 0.f;
#pragma unroll
                for (int q = 0; q < 16; ++q) { const f32x4 h = hp[q]; s += h.x * w[4 * q] + h.y * w[4 * q + 1] + h.z * w[4 * q + 2] + h.w * w[4 * q + 3]; }
                v = s * expf(-((float)pos / (float)SEQ) * decay); }
            buf[n] = (f32x2){v, 0.f}; asum += fabsf(v); }
        (void)vals;
        const float tot = block_sum(asum, red, F.tid); const float nrm = 1.f / (tot + EPSF);
        for (int i = 0; i < 16; ++i) { const int n = F.tid + NTHR * i; f32x2 v = buf[n]; v.x = v.x * nrm + (n == 0 ? in_HYSKIP[l * 256 + c] : 0.f); buf[n] = v; }
        __syncthreads();
        fft_fwd(buf, F.tid);
        f32x2* dst = WSP(f32x2, WS_FSPEC) + (size_t)unit * 8192;
        for (int i = F.tid; i < 8192; i += NTHR) dst[i] = buf[i] * (1.f / 8192.f);
        __syncthreads();
    }
    LAS float* red2 = (LAS float*)(F.lds + 1024);
    LAS float* w3c = (LAS float*)F.lds;
    for (int unit = F.vcu; unit < DEPTH * 256; unit += F.G) {
        const int l = unit >> 8, c = unit & 255, n = F.tid;
        if (F.tid < 128) w3c[F.tid] = in_HYW3[(size_t)l * 64 * 512 + (F.tid & 63) * 512 + (F.tid >> 6) * 256 + c];
        __syncthreads();
        const float decay = HY_DMIN + (HY_DMAX - HY_DMIN) * (float)c / 255.f; float v = 0.f;
        if (n != CTXL) { const int pos = n < CTXL ? n : 2 * CTXL - n; const LAS float* w = w3c + (n < CTXL ? 0 : 64); const float* hp = WSP(float, WS_H2C) + ((size_t)l * CTXL + pos) * 64; float s = 0.f;
            for (int q = 0; q < 64; ++q) s += hp[q] * w[q];
            v = s * expf(-((float)pos / (float)CTXL) * decay); }
        const float tot = block_sum(fabsf(v), red2, F.tid);
        WSP(float, WS_FC)[(size_t)unit * 512 + n] = v / (tot + EPSF) + (n == 0 ? in_HYSKIP[l * 256 + c] : 0.f);
        __syncthreads();
    }
}
__device__ __forceinline__ float sconv(const bf16* P, int r0, int len, int t, int col, float w0, float w1, float w2, float bias) {
    const bf16* p = P + (size_t)(r0 + t) * INC + col;
    const float a = t > 0 ? bf2f(p[-INC]) : 0.f, b = bf2f(p[0]), c = t + 1 < len ? bf2f(p[INC]) : 0.f;
    return a * w0 + b * w1 + c * w2 + bias;
}
__device__ __forceinline__ void hyena_unit(Frame& F, int l, int unit) {
    const float* const in_HYCB = inptr(I_HYCB);
    const float* const in_HYCW = inptr(I_HYCW);
    LAS f32x2* buf = (LAS f32x2*)F.lds;
    const int c = unit >> 2, bp = unit & 3; const bf16* P = WSP(bf16, WS_P);
    const float* cw = in_HYCW + (size_t)l * 3 * 768; const float* cb = in_HYCB + (size_t)l * 768;
    const float a0 = cw[256 + c], a1 = cw[768 + 256 + c], a2 = cw[1536 + 256 + c], ab = cb[256 + c];
    const float v0 = cw[512 + c], v1 = cw[768 + 512 + c], v2 = cw[1536 + 512 + c], vb = cb[512 + c];
    for (int i = 0; i < 8; ++i) { const int t = F.tid + NTHR * i; float z[2];
#pragma unroll
        for (int q = 0; q < 2; ++q) { const int r0 = (2 * bp + q) * SEQ; z[q] = sconv(P, r0, SEQ, t, 256 + c, a0, a1, a2, ab) * sconv(P, r0, SEQ, t, 512 + c, v0, v1, v2, vb); }
        buf[t] = (f32x2){z[0], z[1]}; buf[SEQ + t] = (f32x2){0.f, 0.f}; }
    __syncthreads();
    fft_fwd(buf, F.tid);
    const f32x2* fs = WSP(f32x2, WS_FSPEC) + (size_t)(l * 256 + c) * 8192;
    for (int i = F.tid; i < 8192; i += NTHR) buf[i] = cmul(buf[i], fs[i]);
    __syncthreads();
    fft_inv(buf, F.tid);
    float* o0 = WSP(float, WS_HYW) + ((size_t)(2 * bp) * 256 + c) * SEQ; float* o1 = o0 + (size_t)256 * SEQ;
    for (int t = F.tid; t < SEQ; t += NTHR) { const f32x2 v = buf[t]; o0[t] = v.x; o1[t] = v.y; }
    __syncthreads();
}
__device__ __forceinline__ void hyena_ctx_unit(Frame& F, int l, int c) {
    const float* const in_HYCB = inptr(I_HYCB);
    const float* const in_HYCW = inptr(I_HYCW);
    LAS float* z = (LAS float*)F.lds; LAS float* fc = z + NB * CTXL; const bf16* P = WSP(bf16, WS_P);
    const float* cw = in_HYCW + (size_t)l * 3 * 768; const float* cb = in_HYCB + (size_t)l * 768;
    const float a0 = cw[256 + c], a1 = cw[768 + 256 + c], a2 = cw[1536 + 256 + c], ab = cb[256 + c];
    const float v0 = cw[512 + c], v1 = cw[768 + 512 + c], v2 = cw[1536 + 512 + c], vb = cb[512 + c];
    fc[F.tid] = WSP(float, WS_FC)[(size_t)(l * 256 + c) * 512 + F.tid];
    for (int i = F.tid; i < NB * CTXL; i += NTHR) { const int b = i >> 8, t = i & 255; const int r0 = ML + b * CTXL;
        z[i] = sconv(P, r0, CTXL, t, 256 + c, a0, a1, a2, ab) * sconv(P, r0, CTXL, t, 512 + c, v0, v1, v2, vb); }
    __syncthreads();
    for (int i = F.tid; i < NB * CTXL; i += NTHR) { const int b = i >> 8, t = i & 255; float s = 0.f;
        for (int k = 0; k < CTXL; ++k) s += fc[(t - k) & 511] * z[b * CTXL + k];
        WSP(float, WS_HYWC)[((size_t)b * 256 + c) * CTXL + t] = s; }
    __syncthreads();
}
__device__ __forceinline__ void hyena_fin_unit(Frame& F, int l, int unit) {
    const float* const in_HYCB = inptr(I_HYCB);
    const float* const in_HYCW = inptr(I_HYCW);
    const float* const in_HYNG = inptr(I_HYNG);
    LAS float* wt = (LAS float*)F.lds;
    const int r0 = unit * 64; const bool isc = r0 >= ML; const int b = isc ? (r0 - ML) / CTXL : r0 / SEQ; const int len = isc ? CTXL : SEQ;
    const int seq0 = isc ? ML + b * CTXL : b * SEQ, t0 = r0 - seq0;
    const float* src = isc ? WSP(float, WS_HYWC) + (size_t)b * 256 * CTXL : WSP(float, WS_HYW) + (size_t)b * 256 * SEQ;
    for (int i = F.tid; i < 256 * 16; i += NTHR) { const int c = i >> 4, q = i & 15; const f32x4 v = *(const f32x4*)(src + (size_t)c * len + t0 + 4 * q);
        wt[c * 65 + 4 * q] = v.x; wt[c * 65 + 4 * q + 1] = v.y; wt[c * 65 + 4 * q + 2] = v.z; wt[c * 65 + 4 * q + 3] = v.w; }
    __syncthreads();
    const bf16* P = WSP(bf16, WS_P); const float* cw = in_HYCW + (size_t)l * 3 * 768; const float* cb = in_HYCB + (size_t)l * 768;
    for (int tt = 0; tt < 8; ++tt) { const int tl = F.wave * 8 + tt, t = t0 + tl; float v[4]; float ss = 0.f;
#pragma unroll
        for (int j = 0; j < 4; ++j) { const int c = F.lane + 64 * j; const float x0 = sconv(P, seq0, len, t, c, cw[c], cw[768 + c], cw[1536 + c], cb[c]); v[j] = x0 * wt[c * 65 + tl]; ss += v[j] * v[j]; }
        const float rs = rsqrtf(wave_sum(ss) * (1.f / 256.f) + EPSF);
#pragma unroll
        for (int j = 0; j < 4; ++j) { const int c = F.lane + 64 * j; WSP(bf16, WS_MIX)[(size_t)(r0 + tl) * DM + c] = (bf16)f2bf(v[j] * rs * in_HYNG[l * 256 + c]); }
    }
    __syncthreads();
}

__device__ __forceinline__ void n1_phase(Frame& F, int l) {
    const float* const in_CTX = inptr(I_CTX);
    const float* const in_FING = inptr(I_FING);
    const float* const in_N1G = inptr(I_N1G);
    const float* const in_X = inptr(I_X);
    const int gw = F.vcu * NWAVES + F.wave, NGW = F.G * NWAVES;
    const int nrows = l == DEPTH ? ML : MT;
    for (int r = gw; r < nrows; r += NGW) {
        const int bi = r < ML ? r >> 12 : 8;
        f32x4 v[4];
        if (l == 0) { const float* src = r < ML ? in_X + (size_t)r * DM : in_CTX + (size_t)(r - ML) * DM;
#pragma unroll
            for (int j = 0; j < 4; ++j) v[j] = *(const f32x4*)(src + 4 * F.lane + 256 * j);
        } else {
            const float* src = WSP(float, WS_X) + (size_t)r * DM; const int* ts = (const int*)(F.ws + WS_TOK + TK_SLOT) + 2 * r; const int sa = ts[0], sb = ts[1];
            const bf16* ya = WSP(bf16, WS_YB) + (size_t)sa * DM; const bf16* yb = WSP(bf16, WS_YB) + (size_t)sb * DM;
            const float* g2 = WSP(float, WS_MODV) + (size_t)((l - 1) * 9 + bi) * NMOD + 5 * DM;
#pragma unroll
            for (int j = 0; j < 4; ++j) { const int c = 4 * F.lane + 256 * j; const f32x4 x = *(const f32x4*)(src + c), g = *(const f32x4*)(g2 + c);
                const v2u a = *(const v2u*)(ya + c), b = *(const v2u*)(yb + c);
                v[j] = x + g * (f32x4){bflo(a.x) + bflo(b.x), bfhi(a.x) + bfhi(b.x), bflo(a.y) + bflo(b.y), bfhi(a.y) + bfhi(b.y)}; }
        }
        float ss = 0.f;
#pragma unroll
        for (int j = 0; j < 4; ++j) ss += v[j].x * v[j].x + v[j].y * v[j].y + v[j].z * v[j].z + v[j].w * v[j].w;
        const float rs = rsqrtf(wave_sum(ss) * (1.f / DM) + EPSF);
        if (l == DEPTH) {
#pragma unroll
            for (int j = 0; j < 4; ++j) { const int c = 4 * F.lane + 256 * j; *(f32x4*)(F.out + (size_t)r * DM + c) = v[j] * rs * *(const f32x4*)(in_FING + c); }
        } else {
            const float* mv = WSP(float, WS_MODV) + (size_t)(l * 9 + bi) * NMOD; const float* ng = in_N1G + l * DM;
#pragma unroll
            for (int j = 0; j < 4; ++j) { const int c = 4 * F.lane + 256 * j; *(f32x4*)(WSP(float, WS_X) + (size_t)r * DM + c) = v[j];
                const f32x4 h = v[j] * rs * *(const f32x4*)(ng + c) * (1.f + *(const f32x4*)(mv + DM + c)) + *(const f32x4*)(mv + c);
                *(v2u*)(WSP(bf16, WS_H) + (size_t)r * DM + c) = (v2u){pk2(h.x, h.y), pk2(h.z, h.w)}; }
        }
    }
}
__device__ __forceinline__ void n2r_phase(Frame& F, int l) {
    const float* const in_MBE = inptr(I_MBE);
    const float* const in_MBG = inptr(I_MBG);
    const float* const in_MWE = inptr(I_MWE);
    const float* const in_MWG = inptr(I_MWG);
    const float* const in_N2G = inptr(I_N2G);
    LAS float* wl = (LAS float*)F.lds;
    for (int i = F.tid; i < 1024 * 36; i += NTHR) { const int k = i / 36, n = i - k * 36; wl[i] = n < 32 ? in_MWE[((size_t)l * DM + k) * 32 + n] : in_MWG[((size_t)l * DM + k) * 4 + (n - 32)]; }
    __syncthreads();
    const int gw = F.vcu * NWAVES + F.wave, NGW = F.G * NWAVES, rr = F.lane & 15, q = F.lane >> 4;
    const float* ng = in_N2G + l * DM;
    gu32* cnt = F.ctl + CW_CNT + l * 64;
    for (int grp = gw; grp < MT / 16; grp += NGW) {
        const int r = grp * 16 + rr; const int bi = r < ML ? r >> 12 : 8;
        const float* xr = WSP(float, WS_X) + (size_t)r * DM + 256 * q; const float* mv = WSP(float, WS_MODV) + (size_t)(l * 9 + bi) * NMOD;
        float ss = 0.f;
#pragma unroll 8
        for (int s = 0; s < 64; ++s) { const f32x4 x = *(const f32x4*)(xr + 4 * s); ss += x.x * x.x + x.y * x.y + x.z * x.z + x.w * x.w; }
        ss = xor_add<16>(ss); ss = xor_add<32>(ss);
        const float rs = rsqrtf(ss * (1.f / DM) + EPSF);
        f32x4 d0 = {0.f, 0.f, 0.f, 0.f}, d1 = d0, d2 = d0;
        bf16* hrow = WSP(bf16, WS_H) + (size_t)r * DM + 256 * q;
#pragma unroll 2
        for (int s = 0; s < 64; ++s) { const int c = 256 * q + 4 * s; const f32x4 x = *(const f32x4*)(xr + 4 * s);
            const f32x4 h = x * rs * *(const f32x4*)(ng + c) * (1.f + *(const f32x4*)(mv + 4 * DM + c)) + *(const f32x4*)(mv + 3 * DM + c);
            *(v2u*)(hrow + 4 * s) = (v2u){pk2(h.x, h.y), pk2(h.z, h.w)};
#pragma unroll
            for (int e = 0; e < 4; ++e) { const LAS float* wk = wl + (c + e) * 36 + rr; const float hv = h[e];
                const float w0 = wk[0], w1 = wk[16], w2 = rr < 4 ? wk[32] : 0.f;
                d0 = __builtin_amdgcn_mfma_f32_16x16x4f32(w0, hv, d0, 0, 0, 0); d1 = __builtin_amdgcn_mfma_f32_16x16x4f32(w1, hv, d1, 0, 0, 0); d2 = __builtin_amdgcn_mfma_f32_16x16x4f32(w2, hv, d2, 0, 0, 0); } }
        int G = 0; float pg = 0.f;
        { const float b0 = in_MBG[l * 4], b1 = in_MBG[l * 4 + 1], b2 = in_MBG[l * 4 + 2], b3 = in_MBG[l * 4 + 3];
          const float g0 = d2.x + b0, g1 = d2.y + b1, g2 = d2.z + b2, g3 = d2.w + b3; float m = g0; G = 0;
          if (g1 > m) { m = g1; G = 1; } if (g2 > m) { m = g2; G = 2; } if (g3 > m) { m = g3; G = 3; }
          pg = 1.f / (fexp(g0 - m) + fexp(g1 - m) + fexp(g2 - m) + fexp(g3 - m)); }
        G = __builtin_amdgcn_ds_bpermute(rr << 2, G);
        const f32x4 t = (G >> 1) ? d1 : d0;
        float ev[8];
#pragma unroll
        for (int j = 0; j < 8; ++j) { const int src = rr + 16 * (2 * (G & 1) + (j >> 2)); const float x = (j & 3) == 0 ? t.x : (j & 3) == 1 ? t.y : (j & 3) == 2 ? t.z : t.w; ev[j] = __builtin_bit_cast(float, __builtin_amdgcn_ds_bpermute(src << 2, __builtin_bit_cast(int, x))); }
        if (q == 0) {
#pragma unroll
            for (int j = 0; j < 8; ++j) ev[j] += in_MBE[l * 32 + G * 8 + j];
            int ia = 0; float ma = ev[0];
#pragma unroll
            for (int j = 1; j < 8; ++j) if (ev[j] > ma) { ma = ev[j]; ia = j; }
            int ib = -1; float mb = -3.0e38f;
#pragma unroll
            for (int j = 0; j < 8; ++j) if (j != ia && ev[j] > mb) { mb = ev[j]; ib = j; }
            const float eb = fexp(mb - ma); const float ga = pg / (1.f + eb), gb = pg * eb / (1.f + eb);
            const int ea = G * 8 + ia, eb_ = G * 8 + ib;
            const int pa = (int)__hip_atomic_fetch_add(cnt + ea, 1u, RLX_AGENT), pb = (int)__hip_atomic_fetch_add(cnt + eb_, 1u, RLX_AGENT);
            int* te = (int*)(F.ws + WS_TOK + TK_E) + 2 * r; int* tp = (int*)(F.ws + WS_TOK + TK_POS) + 2 * r; float* tg = (float*)(F.ws + WS_TOK + TK_GATE) + 2 * r;
            te[0] = ea; te[1] = eb_; tp[0] = pa; tp[1] = pb; tg[0] = ga; tg[1] = gb;
        }
    }
    __syncthreads();
}
__device__ __forceinline__ void assign_phase(Frame& F, int l) {
    LAS int* ps = (LAS int*)F.lds;
    if (F.tid == 0) { int acc = 0; for (int e = 0; e < NEXP; ++e) { const int c = (int)__hip_atomic_load(F.ctl + CW_CNT + l * 64 + e, RLX_AGENT); ps[e] = acc; ps[32 + e] = c; acc += (c + 255) / 256 * 256; } ps[64] = acc; }
    __syncthreads();
    int* stok = (int*)(F.ws + WS_TOK + TK_STOK); float* sgate = (float*)(F.ws + WS_TOK + TK_SGATE); int* tslot = (int*)(F.ws + WS_TOK + TK_SLOT);
    const int* te = (const int*)(F.ws + WS_TOK + TK_E); const int* tp = (const int*)(F.ws + WS_TOK + TK_POS); const float* tg = (const float*)(F.ws + WS_TOK + TK_GATE);
    for (int i = F.vcu * NTHR + F.tid; i < MT * 2; i += F.G * NTHR) { const int dest = ps[te[i]] + tp[i]; stok[dest] = i >> 1; sgate[dest] = tg[i]; tslot[i] = dest; }
    for (int i = F.vcu * NTHR + F.tid; i < NEXP * 256; i += F.G * NTHR) { const int e = i >> 8, j = i & 255, c = ps[32 + e], rem = c & 255;
        if (rem != 0 && j >= rem) { const int dest = ps[e] + (c & ~255) + j; stok[dest] = MT; sgate[dest] = 0.f; } }
    if (F.bx == 0) { int* tile_e = (int*)(F.ws + WS_TOK + TK_TILEE); const int nt = ps[64] / 256;
        for (int t = F.tid; t < nt; t += NTHR) { int e = 0; for (int k = 1; k < NEXP; ++k) if (t * 256 >= ps[k]) e = k; tile_e[t] = e; }
        if (F.tid == 0) __hip_atomic_store(F.ctl + CW_NTILES + l, (unsigned)nt, RLX_AGENT); }
    __syncthreads();
}
__device__ __forceinline__ void s5_scan_phase(Frame& F, int l) {
    const float* const in_S5AIM = inptr(I_S5AIM);
    const float* const in_S5ARE = inptr(I_S5ARE);
    const float* const in_S5LDT = inptr(I_S5LDT);
    const int item = F.vcu * NTHR + F.tid; if (item >= NB * 16 * 2 * 64) return;
    const int p = item & 63, d = (item >> 6) & 1, g = (item >> 7) & 15, b = item >> 11;
    const int pi = ((l * 2 + d) * 16 + g) * 64 + p; const float dt = expf(in_S5LDT[(l * 2 + d) * 16 + g]);
    const float m = expf(32.f * dt * in_S5ARE[pi]), ang = 32.f * dt * in_S5AIM[pi]; const float ar = m * cosf(ang), ai = m * sinf(ang);
    const float* ST = WSP(float, WS_ST) + (size_t)g * S5RP * 256 + d * 128 + p; bf16* HIN = WSP(bf16, WS_HIN) + (size_t)g * S5RP * 256 + d * 128 + p;
    float hr = 0.f, hi = 0.f;
    for (int step = 0; step < 136; ++step) {
        int row;
        if (d == 0) row = step < 8 ? 1024 + b * 8 + step : b * 128 + (step - 8);
        else row = step < 8 ? 1024 + b * 8 + (7 - step) : b * 128 + (135 - step);
        HIN[(size_t)row * 256] = (bf16)f2bf(hr); HIN[(size_t)row * 256 + 64] = (bf16)f2bf(hi);
        const float sr = ST[(size_t)row * 256], si = ST[(size_t)row * 256 + 64];
        const float nr = ar * hr - ai * hi + sr, ni = ar * hi + ai * hr + si; hr = nr; hi = ni;
    }
}

struct ListOrder {
    int n, per, ncol, rowmul, colmul, G, c;
    __device__ __forceinline__ bool next(int i, pg8::Unit& u) const { const int L = i * G + c; if (L >= n) return false; const int a = L / per, r = L - a * per; u.pm = rowmul * a + r / ncol; u.pn = colmul * a + r % ncol; return true; }
    __device__ __forceinline__ void a_ready(const pg8::Unit&) const {}
    __device__ __forceinline__ void done(const pg8::Unit&) const {}
};
struct MoeOrder {
    const int* tile_e; int ntiles, G, c;
    __device__ __forceinline__ bool next(int i, pg8::Unit& u) const { const int L = i * G + c; if (L >= ntiles * 4) return false; const int t = L >> 2; u.pm = t; u.pn = tile_e[t] * 4 + (L & 3); return true; }
    __device__ __forceinline__ void a_ready(const pg8::Unit&) const {}
    __device__ __forceinline__ void done(const pg8::Unit&) const {}
};
using pg8::Unit; using pg8::HALF; using pg8::BM;
#define EPI_ROWS_BEGIN  _Pragma("unroll") for (int ai = 0; ai < 2; ++ai) _Pragma("unroll") for (int m = 0; m < 4; ++m) { const int row = u.pm * BM + ai * HALF + wr * 64 + m * 16 + fr;
#define EPI_ROWS_END asm volatile("" ::: "memory"); }
__device__ __forceinline__ v4u pack8(const f32x4 a, const f32x4 b) { return (v4u){pk2(a.x, a.y), pk2(a.z, a.w), pk2(b.x, b.y), pk2(b.z, b.w)}; }
struct EpiG1 {
    static constexpr bool PERM = true, AFTER_DRAIN = false;
    bf16* P; bf16* QR; bf16* U5; const f32x2* rope;
    __device__ __forceinline__ void operator()(const f32x4 (&acc)[2][2][4][2], const Unit& u, int wr, int wc, int fr, int fq) const {
        const int pn = u.pn; const bool lat = u.pm < ML / BM;
        EPI_ROWS_BEGIN
#pragma unroll
            for (int bj = 0; bj < 2; ++bj) { const int cl = bj * HALF + wc * 32 + 8 * fq, col = pn * BM + cl; const f32x4 v0 = acc[ai][bj][m][0], v1 = acc[ai][bj][m][1];
                if (pn == 3) { const int g = cl >> 4, h0 = cl & 15; *(GAS v4u*)(U5 + ((size_t)g * S5RP + (row >> 5)) * 512 + (row & 31) * 16 + h0) = pack8(v0, v1); }
                else if (pn >= 4 && pn < 8) {
                    const bool isq = pn < 6;
                    if (isq || !lat) *(GAS v4u*)(P + (size_t)row * INC + col) = pack8(v0, v1);
                    if (lat) { const int j0 = (cl & 63) >> 1; const f32x4* rp = (const f32x4*)(rope + (size_t)(row & (SEQ - 1)) * 32 + j0); const f32x4 c0 = rp[0], c1 = rp[1];
                        const f32x4 r0 = {v0.x * c0.x - v0.y * c0.y, v0.x * c0.y + v0.y * c0.x, v0.z * c0.z - v0.w * c0.w, v0.z * c0.w + v0.w * c0.z};
                        const f32x4 r1 = {v1.x * c1.x - v1.y * c1.y, v1.x * c1.y + v1.y * c1.x, v1.z * c1.z - v1.w * c1.w, v1.z * c1.w + v1.w * c1.z};
                        if (isq) *(GAS v4u*)(QR + (size_t)row * 512 + (col - C_Q)) = pack8(r0, r1); else *(GAS v4u*)(P + (size_t)row * INC + col) = pack8(r0, r1); }
                } else *(GAS v4u*)(P + (size_t)row * INC + col) = pack8(v0, v1);
            }
        EPI_ROWS_END
    }
};
struct EpiG2 {
    static constexpr bool PERM = false, AFTER_DRAIN = false;
    float* X; const float* modv_l;
    __device__ __forceinline__ void operator()(const f32x4 (&acc)[2][2][4][2], const Unit& u, int wr, int wc, int fr, int fq) const {
        const int bi = u.pm < ML / BM ? u.pm >> 4 : 8; const float* g1 = modv_l + (size_t)bi * NMOD + 2 * DM; const int col0 = u.pn * BM + wc * 32 + 4 * fq;
        f32x4 gv[2][2];
#pragma unroll
        for (int bj = 0; bj < 2; ++bj)
#pragma unroll
            for (int n = 0; n < 2; ++n) gv[bj][n] = *(const f32x4*)(g1 + col0 + bj * HALF + n * 16);
        EPI_ROWS_BEGIN
            float* xr = X + (size_t)row * DM + col0;
#pragma unroll
            for (int bj = 0; bj < 2; ++bj)
#pragma unroll
                for (int n = 0; n < 2; ++n) { f32x4* p = (f32x4*)(xr + bj * HALF + n * 16); *p = *p + gv[bj][n] * acc[ai][bj][m][n]; }
        EPI_ROWS_END
    }
};
struct EpiUp {
    static constexpr bool PERM = true, AFTER_DRAIN = false;
    bf16* HID;
    __device__ __forceinline__ void operator()(const f32x4 (&acc)[2][2][4][2], const Unit& u, int wr, int wc, int fr, int fq) const {
        const int col = (u.pn & 3) * 128 + wc * 32 + 8 * fq;
        EPI_ROWS_BEGIN
            f32x4 o[2];
#pragma unroll
            for (int n = 0; n < 2; ++n) { const f32x4 a = acc[ai][0][m][n], b = acc[ai][1][m][n]; o[n] = (f32x4){fsilu(a.x) * b.x, fsilu(a.y) * b.y, fsilu(a.z) * b.z, fsilu(a.w) * b.w}; }
            *(GAS v4u*)(HID + (size_t)row * EHID + col) = pack8(o[0], o[1]);
        EPI_ROWS_END
    }
};
struct EpiDown {
    static constexpr bool PERM = true, AFTER_DRAIN = false;
    bf16* YB; const float* sgate;
    __device__ __forceinline__ void operator()(const f32x4 (&acc)[2][2][4][2], const Unit& u, int wr, int wc, int fr, int fq) const {
        EPI_ROWS_BEGIN
            const float gt = sgate[row];
#pragma unroll
            for (int bj = 0; bj < 2; ++bj) *(GAS v4u*)(YB + (size_t)row * DM + (u.pn & 3) * BM + bj * HALF + wc * 32 + 8 * fq) = pack8(acc[ai][bj][m][0] * gt, acc[ai][bj][m][1] * gt);
        EPI_ROWS_END
    }
};
struct EpiS5i {
    static constexpr bool PERM = true, AFTER_DRAIN = false;
    float* YI; float* ST;
    __device__ __forceinline__ void operator()(const f32x4 (&acc)[2][2][4][2], const Unit& u, int wr, int wc, int fr, int fq) const {
        const int g = u.pm / 5, i5 = u.pm - 5 * g, j = u.pn - 3 * g;
        EPI_ROWS_BEGIN
            const int cr = row - g * S5RP; (void)i5;
#pragma unroll
            for (int bj = 0; bj < 2; ++bj) { const int cl = bj * HALF + wc * 32 + 8 * fq; float* dst;
                if (j < 2) { const int n = j * BM + cl; dst = YI + ((size_t)cr * 32 + (n >> 4)) * 256 + g * 16 + (n & 15); } else dst = ST + ((size_t)g * S5RP + cr) * 256 + cl;
                *(f32x4*)dst = acc[ai][bj][m][0]; *(f32x4*)(dst + 4) = acc[ai][bj][m][1]; }
        EPI_ROWS_END
    }
};
struct EpiS5c {
    static constexpr bool PERM = true, AFTER_DRAIN = false;
    const float* YI; bf16* GY;
    __device__ __forceinline__ void operator()(const f32x4 (&acc)[2][2][4][2], const Unit& u, int wr, int wc, int fr, int fq) const {
        const int g = u.pm / 5, j = u.pn - 2 * g;
        EPI_ROWS_BEGIN
            const int cr = row - g * S5RP;
#pragma unroll
            for (int bj = 0; bj < 2; ++bj) { const int n = j * BM + bj * HALF + wc * 32 + 8 * fq; const size_t o = ((size_t)cr * 32 + (n >> 4)) * 256 + g * 16 + (n & 15);
                const f32x4 y0 = acc[ai][bj][m][0] + *(const f32x4*)(YI + o), y1 = acc[ai][bj][m][1] + *(const f32x4*)(YI + o + 4);
                *(GAS v4u*)(GY + o) = pack8((f32x4){fgelu_tanh(y0.x), fgelu_tanh(y0.y), fgelu_tanh(y0.z), fgelu_tanh(y0.w)}, (f32x4){fgelu_tanh(y1.x), fgelu_tanh(y1.y), fgelu_tanh(y1.z), fgelu_tanh(y1.w)}); }
        EPI_ROWS_END
    }
};
struct EpiGlu {
    static constexpr bool PERM = true, AFTER_DRAIN = true;
    const bf16* GY; bf16* MIX; const float* ng;
    __device__ __forceinline__ void fused(f32x4 (&acc)[2][2][4][2], const Unit& u, int wr, int wc, int fr, int fq, PG8_LAS unsigned char* lds, int wid, int lane) const {
        PG8_LAS float* part = (PG8_LAS float*)lds;
        EPI_ROWS_BEGIN
            float ss = 0.f;
#pragma unroll
            for (int bj = 0; bj < 2; ++bj) { const int col = bj * HALF + wc * 32 + 8 * fq; const v4u gw = *(const GAS v4u*)(GY + (size_t)row * 256 + col);
                const f32x4 g0 = {bflo(gw.x), bfhi(gw.x), bflo(gw.y), bfhi(gw.y)}, g1 = {bflo(gw.z), bfhi(gw.z), bflo(gw.w), bfhi(gw.w)};
                f32x4& a0 = acc[ai][bj][m][0]; f32x4& a1 = acc[ai][bj][m][1];
                a0 = (f32x4){g0.x * fsigmoid(a0.x), g0.y * fsigmoid(a0.y), g0.z * fsigmoid(a0.z), g0.w * fsigmoid(a0.w)};
                a1 = (f32x4){g1.x * fsigmoid(a1.x), g1.y * fsigmoid(a1.y), g1.z * fsigmoid(a1.z), g1.w * fsigmoid(a1.w)};
                ss += a0.x * a0.x + a0.y * a0.y + a0.z * a0.z + a0.w * a0.w + a1.x * a1.x + a1.y * a1.y + a1.z * a1.z + a1.w * a1.w; }
            ss = xor_add<16>(ss); ss = xor_add<32>(ss);
            if (fq == 0) part[(ai * HALF + wr * 64 + m * 16 + fr) * 4 + wc] = ss;
        EPI_ROWS_END
        asm volatile("s_waitcnt lgkmcnt(0)" ::: "memory"); __builtin_amdgcn_s_barrier(); asm volatile("" ::: "memory");
        EPI_ROWS_BEGIN
            const int lr = ai * HALF + wr * 64 + m * 16 + fr; const f32x4 pp = *(PG8_LAS f32x4*)(part + lr * 4); const float rs = rsqrtf((pp.x + pp.y + pp.z + pp.w) * (1.f / 256.f) + EPSF);
#pragma unroll
            for (int bj = 0; bj < 2; ++bj) { const int col = bj * HALF + wc * 32 + 8 * fq; const f32x4 n0 = *(const f32x4*)(ng + col), n1 = *(const f32x4*)(ng + col + 4);
                *(GAS v4u*)(MIX + (size_t)row * DM + 256 + col) = pack8(acc[ai][bj][m][0] * rs * n0, acc[ai][bj][m][1] * rs * n1); }
        EPI_ROWS_END
        asm volatile("s_waitcnt lgkmcnt(0)" ::: "memory"); __builtin_amdgcn_s_barrier(); asm volatile("" ::: "memory");
    }
};

namespace att {
constexpr int KVBLK = 64, QBLK = 32;
constexpr int SHM_V = KVBLK * 128 * 2, SHM_K = KVBLK * 128 * 2;
constexpr float SCALE = 0.125f, THR = 8.f;
#define KSWZ(row, colB) ((row) * 256 + ((colB) ^ (((row) & 7) << 4)))
#define SBAR() __builtin_amdgcn_sched_barrier(0)
__device__ __forceinline__ int crow(int r, int hi) { return (r & 3) + 8 * (r >> 2) + 4 * hi; }
__device__ __forceinline__ unsigned cvtpk(float lo, float hi) { unsigned r; asm volatile("v_cvt_pk_bf16_f32 %0, %1, %2" : "=v"(r) : "v"(lo), "v"(hi)); return r; }
__device__ __forceinline__ void partialSM(f32x16& p0, f32x16& p1, float& m_reg, float& mn, float& alpha) {
  constexpr float C = SCALE * 1.4426950408889634f;
  float pmax = p0[0];
#pragma unroll
  for (int r = 1; r < 16; ++r) pmax = fmaxf(pmax, p0[r]);
#pragma unroll
  for (int r = 0; r < 16; ++r) pmax = fmaxf(pmax, p1[r]);
  { auto rr = __builtin_amdgcn_permlane32_swap(__float_as_uint(pmax), __float_as_uint(pmax), false, false);
    pmax = fmaxf(__uint_as_float(rr[0]), __uint_as_float(rr[1])); }
  if (__builtin_expect(__all(pmax - m_reg <= THR / SCALE), 1)) { mn = m_reg; alpha = 1.f; }
  else { mn = fmaxf(m_reg, pmax); alpha = __builtin_amdgcn_exp2f((m_reg - mn) * C); m_reg = mn; }
  float mnC = -mn * C;
#pragma unroll
  for (int r = 0; r < 16; ++r) p0[r] = fmaf(p0[r], C, mnC);
#pragma unroll
  for (int r = 0; r < 16; ++r) p1[r] = fmaf(p1[r], C, mnC);
#pragma unroll
  for (int r = 0; r < 16; ++r) p0[r] = __builtin_amdgcn_exp2f(p0[r]);
}
__device__ __forceinline__ void finishSM(f32x16& p0, f32x16& p1, float alpha, float& l_reg, bf16x8& pa0, bf16x8& pa1, bf16x8& pa2, bf16x8& pa3) {
#pragma unroll
  for (int r = 0; r < 16; ++r) p1[r] = __builtin_amdgcn_exp2f(p1[r]);
  float ps = 0;
#pragma unroll
  for (int r = 0; r < 16; ++r) ps += p0[r];
#pragma unroll
  for (int r = 0; r < 16; ++r) ps += p1[r];
  { auto rr = __builtin_amdgcn_permlane32_swap(__float_as_uint(ps), __float_as_uint(ps), false, false);
    ps = __uint_as_float(rr[0]) + __uint_as_float(rr[1]); }
  l_reg = l_reg * alpha + ps;
#define PK4(P, BASE, OUT) do { unsigned a0 = cvtpk(P[BASE + 0], P[BASE + 1]), a1 = cvtpk(P[BASE + 2], P[BASE + 3]);   \
    unsigned b0 = cvtpk(P[BASE + 4], P[BASE + 5]), b1 = cvtpk(P[BASE + 6], P[BASE + 7]);                              \
    auto r0 = __builtin_amdgcn_permlane32_swap(a0, b0, false, false); auto r1 = __builtin_amdgcn_permlane32_swap(a1, b1, false, false); \
    v4u w = {r0[0], r1[0], r0[1], r1[1]}; OUT = __builtin_bit_cast(bf16x8, w); } while (0)
  PK4(p0, 0, pa0); PK4(p0, 8, pa1); PK4(p1, 0, pa2); PK4(p1, 8, pa3);
#undef PK4
}
__device__ __forceinline__ void qkt(f32x16& p0, f32x16& p1, const LAS char* Ks, const bf16x8* qr, int r32, int hi, int sub) {
  p0 = f32x16{}; p1 = f32x16{};
#pragma unroll
  for (int d0 = 0; d0 < 4; ++d0) { const int cb = sub * 128 + (d0 * 16 + hi * 8) * 2;
    const bf16x8 b0 = *(const LAS bf16x8*)(Ks + KSWZ(r32, cb));
    const bf16x8 b1 = *(const LAS bf16x8*)(Ks + KSWZ(32 + r32, cb));
    p0 = __builtin_amdgcn_mfma_f32_32x32x16_bf16(b0, qr[d0], p0, 0, 0, 0);
    p1 = __builtin_amdgcn_mfma_f32_32x32x16_bf16(b1, qr[d0], p1, 0, 0, 0); }
}
__device__ __forceinline__ int v_st(int k, int c) { const int kk = (k & ~0xC) | ((k & 4) << 1) | ((k & 8) >> 1); return ((kk >> 3) * 4 + (c >> 5)) * 512 + ((kk & 7) * 32 + (c & 31)) * 2; }
__device__ __forceinline__ int v_rd_base(int lane) { return ((lane & 3) << 3) | (((lane >> 2) & 3) << 6) | (((lane >> 4) & 1) << 5) | (((lane >> 5) & 1) << 8); }
constexpr int v_rd_off(int d0, int ks, int half) { return d0 * 512 + ks * 4096 + half * 2048; }
template <int OFF> __device__ __forceinline__ s16x4 tr_read(int vb) { s16x4 r; asm volatile("ds_read_b64_tr_b16 %0, %1 offset:%2" : "=&v"(r) : "v"(vb), "i"(OFF) : "memory"); return r; }
template <int D0> __device__ __forceinline__ void pv_one(f32x16& od, int vb, bf16x8 pa0, bf16x8 pa1, bf16x8 pa2, bf16x8 pa3) {
  const s16x4 l0 = tr_read<v_rd_off(D0, 0, 0)>(vb), h0 = tr_read<v_rd_off(D0, 0, 1)>(vb), l1 = tr_read<v_rd_off(D0, 1, 0)>(vb), h1 = tr_read<v_rd_off(D0, 1, 1)>(vb);
  const s16x4 l2 = tr_read<v_rd_off(D0, 2, 0)>(vb), h2 = tr_read<v_rd_off(D0, 2, 1)>(vb), l3 = tr_read<v_rd_off(D0, 3, 0)>(vb), h3 = tr_read<v_rd_off(D0, 3, 1)>(vb);
  asm volatile("s_waitcnt lgkmcnt(0)" ::: "memory"); SBAR();
#define PK(L, H) (bf16x8){L[0], L[1], L[2], L[3], H[0], H[1], H[2], H[3]}
  od = __builtin_amdgcn_mfma_f32_32x32x16_bf16(pa0, PK(l0, h0), od, 0, 0, 0);
  od = __builtin_amdgcn_mfma_f32_32x32x16_bf16(pa1, PK(l1, h1), od, 0, 0, 0);
  od = __builtin_amdgcn_mfma_f32_32x32x16_bf16(pa2, PK(l2, h2), od, 0, 0, 0);
  od = __builtin_amdgcn_mfma_f32_32x32x16_bf16(pa3, PK(l3, h3), od, 0, 0, 0);
#undef PK
}
__device__ __forceinline__ void pv_d0(f32x16* o, int vb, bf16x8 pa0, bf16x8 pa1, bf16x8 pa2, bf16x8 pa3) {
  pv_one<0>(o[0], vb, pa0, pa1, pa2, pa3); pv_one<1>(o[1], vb, pa0, pa1, pa2, pa3); pv_one<2>(o[2], vb, pa0, pa1, pa2, pa3); pv_one<3>(o[3], vb, pa0, pa1, pa2, pa3);
}
__device__ __forceinline__ void attn_unit(LAS char* lds, const bf16* P, const bf16* QR, bf16* MIX, const float* subln, float lam, float oml, int unit, int tid_) {
  asm volatile("" : "+v"(tid_));
  const int tid = tid_, wid = tid >> 6, lane = tid & 63, r32 = lane & 31, hi = lane >> 5, sub = wid >> 2, wq = wid & 3;
  const bool isl = unit < 1024; int b, h, q0;
  if (isl) { const int bh = unit >> 5; b = bh >> 2; h = bh & 3; q0 = b * SEQ + (unit & 31) * 128; } else { const int u2 = unit - 1024, bh = u2 >> 1; b = bh >> 2; h = bh & 3; q0 = ML + b * CTXL + (u2 & 1) * 128; }
  const int NT = isl ? 68 : 4; const int crow0 = ML + b * CTXL, lrow0 = b * SEQ;
  LAS char* V_lds = lds; LAS char* K_lds = lds + 2 * SHM_V;
  LAS float* ws = (LAS float*)(lds + 2 * SHM_V + 2 * SHM_K) + wid * 64; LAS float* li_l = ws; LAS float* al_l = ws + 32;
  float m_reg = -1e30f, l_reg = 0; f32x16 o[4] = {}; bf16x8 qr[4];
  const int qrow = q0 + wq * QBLK + r32;
  { const bf16* Qw = P + (size_t)qrow * INC + C_Q + h * 128 + sub * 64 + hi * 8;
#pragma unroll
    for (int d0 = 0; d0 < 4; ++d0) qr[d0] = *(const bf16x8*)(Qw + d0 * 16); }
  const int sr = tid >> 4, sc = (tid & 15) * 8, vst0 = v_st(sr, sc), vst1 = v_st(32 + sr, sc);
  const int vb0 = (int)(unsigned long)V_lds + v_rd_base(lane);
  const bf16* Kc = P + C_K + h * 128 + sc; const bf16* Vc = P + C_V + h * 128 + sc;
  struct { bf16x8 vs0, vs1, ks0, ks1; } sr_[2];
#define TROW(j) (((j) < 4 ? crow0 + (j) * 64 : lrow0 + ((j) - 4) * 64) + sr)
#define SLOAD(i, j) do { const size_t _r = (size_t)TROW(j) * INC; sr_[i].vs0 = *(const bf16x8*)(Vc + _r); sr_[i].vs1 = *(const bf16x8*)(Vc + _r + (size_t)32 * INC); \
    sr_[i].ks0 = *(const bf16x8*)(Kc + _r); sr_[i].ks1 = *(const bf16x8*)(Kc + _r + (size_t)32 * INC); } while (0)
#define SWRITE(bb, i) do { *(LAS bf16x8*)(V_lds + (bb) * SHM_V + vst0) = sr_[i].vs0; *(LAS bf16x8*)(V_lds + (bb) * SHM_V + vst1) = sr_[i].vs1; const int kc = sc * 2; \
    *(LAS bf16x8*)(K_lds + (bb) * SHM_K + KSWZ(sr, kc)) = sr_[i].ks0; *(LAS bf16x8*)(K_lds + (bb) * SHM_K + KSWZ(32 + sr, kc)) = sr_[i].ks1; } while (0)
#define SWAIT() asm volatile("s_waitcnt vmcnt(4)" ::: "memory")
#define RESC(a) do { if (__any((a) < 1.f)) { if (hi == 0) al_l[r32] = (a); asm volatile("s_waitcnt lgkmcnt(0)" ::: "memory"); \
    _Pragma("unroll") for (int d = 0; d < 4; ++d) _Pragma("unroll") for (int r = 0; r < 16; ++r) o[d][r] *= al_l[crow(r, hi)]; } } while (0)
  f32x16 pA0, pA1, pB0, pB1; float mnA, mnB, alA, alB; bf16x8 pa0, pa1, pa2, pa3;
  SLOAD(0, 0); asm volatile("s_waitcnt vmcnt(0)" ::: "memory"); SWRITE(0, 0); __syncthreads();
  qkt(pA0, pA1, K_lds, qr, r32, hi, sub); partialSM(pA0, pA1, m_reg, mnA, alA);
  SLOAD(1, 1); if (2 < NT) SLOAD(0, 2);
  SWAIT(); SWRITE(1, 1); __syncthreads();
  for (int j = 1; j + 1 < NT; j += 2) {
    SBAR(); qkt(pB0, pB1, K_lds + SHM_K, qr, r32, hi, sub);
    finishSM(pA0, pA1, alA, l_reg, pa0, pa1, pa2, pa3); SBAR();
    SLOAD(1, j + 2); SBAR();
    pv_d0(o, vb0, pa0, pa1, pa2, pa3); partialSM(pB0, pB1, m_reg, mnB, alB);
    __syncthreads(); SWAIT(); SWRITE(0, 0);
    RESC(alB); __syncthreads();
    if (isl && j == 3) { const bf16* Qw = QR + (size_t)qrow * 512 + h * 128 + sub * 64 + hi * 8;
#pragma unroll
      for (int d0 = 0; d0 < 4; ++d0) qr[d0] = *(const bf16x8*)(Qw + d0 * 16); }
    SBAR(); qkt(pA0, pA1, K_lds, qr, r32, hi, sub);
    finishSM(pB0, pB1, alB, l_reg, pa0, pa1, pa2, pa3); SBAR();
    if (j + 3 < NT) SLOAD(0, j + 3); SBAR();
    pv_d0(o, vb0 + SHM_V, pa0, pa1, pa2, pa3); partialSM(pA0, pA1, m_reg, mnA, alA);
    __syncthreads(); SWAIT(); SWRITE(1, 1);
    RESC(alA); __syncthreads();
  }
  SBAR(); qkt(pB0, pB1, K_lds + SHM_K, qr, r32, hi, sub);
  finishSM(pA0, pA1, alA, l_reg, pa0, pa1, pa2, pa3); SBAR();
  pv_d0(o, vb0, pa0, pa1, pa2, pa3); partialSM(pB0, pB1, m_reg, mnB, alB);
  __syncthreads(); RESC(alB);
  finishSM(pB0, pB1, alB, l_reg, pa0, pa1, pa2, pa3); SBAR();
  pv_d0(o, vb0 + SHM_V, pa0, pa1, pa2, pa3);
  if (hi == 0) li_l[r32] = l_reg; asm volatile("s_waitcnt lgkmcnt(0)" ::: "memory");
  float rli[16];
#pragma unroll
  for (int r = 0; r < 16; ++r) rli[r] = __builtin_amdgcn_rcpf(li_l[crow(r, hi)]);
  __syncthreads();
  LAS float* ex = (LAS float*)lds + wq * 4096 + lane;
  if (sub == 1) {
#pragma unroll
    for (int d = 0; d < 4; ++d)
#pragma unroll
      for (int r = 0; r < 16; ++r) ex[(d * 16 + r) * 64] = o[d][r] * rli[r] * lam;
  }
  __syncthreads();
  if (sub == 0) {
    float ss[16];
#pragma unroll
    for (int r = 0; r < 16; ++r) { float s = 0.f;
#pragma unroll
      for (int d = 0; d < 4; ++d) { const float v = o[d][r] * rli[r] - ex[(d * 16 + r) * 64]; o[d][r] = v; s += v * v; }
      ss[r] = s; }
#pragma unroll
    for (int r = 0; r < 16; ++r) { float s = ss[r]; s = xor_add<1>(s); s = xor_add<2>(s); s = xor_add<4>(s); s = xor_add<8>(s); s = xor_add<16>(s); ss[r] = rsqrtf(s * (1.f / 128.f) + EPSF) * oml; }
    bf16* Ow = MIX + (size_t)(q0 + wq * QBLK) * DM + 512 + h * 128 + r32;
#pragma unroll
    for (int d = 0; d < 4; ++d) { const float gsc = subln[d * 32 + r32];
#pragma unroll
      for (int r = 0; r < 16; ++r) Ow[(size_t)crow(r, hi) * DM + d * 32] = (bf16)f2bf(o[d][r] * ss[r] * gsc); }
  }
  __syncthreads();
#undef TROW
#undef SLOAD
#undef SWRITE
#undef SWAIT
#undef RESC
}
#undef KSWZ
}

__global__ void __launch_bounds__(NTHR, 2) mega_fwd(Args args) {
    extern __shared__ __attribute__((aligned(16))) unsigned char lds_raw[];
    Frame F;
    F.lds = (LAS unsigned char*)lds_raw; F.out = args.out; F.ws = args.ws; F.ctl = (gu32*)(args.ws + WS_CTL);
    const int wave0 = __builtin_amdgcn_readfirstlane((int)threadIdx.x >> 6);
    F.tid = threadIdx.x; F.lane = F.tid & 63; F.wave = wave0;
    F.G = gridDim.x; F.bx = blockIdx.x; F.vcu = F.bx;
    volatile LAS unsigned* MISC = (volatile LAS unsigned*)(F.lds + MISC_OFF);
    for (int u = F.tid; u < 256; u += NTHR) MISC[u] = 0u;
    __syncthreads();
    const int lo = args.ph_lo, hi = args.ph_hi;
    const bool multi = (hi - lo) > 1;
    XcdBarrier bar; bar.bar = (unsigned*)(F.ctl + CW_BAR); bar.x = 0; bar.st = nullptr;
    if (multi) bar = xcd_barrier_post((unsigned*)(F.ctl + CW_BAR), MISC + 8, F.tid);
#ifndef PH_MASK
#define PH_MASK 0xFFFFFFFFu
#endif
#define IN(k) (lo <= (k) && (k) < hi)
#define PHM(bit) ((PH_MASK >> (bit)) & 1u)
#define FRESH() do { const int t_ = (wave0 << 6) | lane_id_asm(); F.tid = t_; F.lane = t_ & 63; F.wave = wave0; \
    unsigned char* w_ = args.ws; asm volatile("" : "+s"(w_)); F.ws = w_; F.ctl = (gu32*)(w_ + WS_CTL); \
    int bx_ = blockIdx.x, g_ = gridDim.x; asm volatile("" : "+s"(bx_), "+s"(g_)); F.bx = bx_; F.G = g_; F.vcu = (g_ % 8 == 0) ? (bx_ % 8) * (g_ / 8) + bx_ / 8 : bx_; } while (0)
#define SEAM(k) do { if (IN(k) && IN((k) + 1)) { XcdBarrier b_ = bar; unsigned char* p_ = args.ws; asm volatile("" : "+s"(p_)); b_.bar = (unsigned*)(p_ + WS_CTL) + CW_BAR; xcd_barrier(b_, (wave0 << 6) | lane_id_asm()); } } while (0)
    PG8_LAS unsigned char* glds = (PG8_LAS unsigned char*)lds_raw;

    if (PHM(0) && IN(0)) { FRESH(); p0_modv(F); p0_weights(F); __syncthreads(); p0_h2(F); p0_s5(F); p0_misc(F); }
    SEAM(0);
    if (PHM(1) && IN(1)) { FRESH(); p0_filters(F); }
    SEAM(1);

#pragma unroll 1
    for (int l = 0; l < DEPTH; ++l) {
        const int pb = PH_LAYER0 + l * NPL;
        if (PHM(2) && IN(pb + 0)) { FRESH(); n1_phase(F, l); __syncthreads(); moe_weights(F, l); }
        SEAM(pb + 0);
        if (PHM(3) && IN(pb + 1)) { FRESH();
            pg8::Gemm g{WSP(bf16, WS_H), WSP(bf16, WS_WINT) + (size_t)l * INC * DM, MT, INC, DM}; pg8::StaticOrder S; S.init(MT, INC, F.G, F.bx);
            EpiG1 E{WSP(bf16, WS_P), WSP(bf16, WS_QR), WSP(bf16, WS_U5), WSP(f32x2, WS_ROPE)};
            pg8::gemm_phase<EpiG1, pg8::StaticOrder, true, true, false>(glds, g, S, E, F.tid);
        }
        SEAM(pb + 1);
        if (PHM(4) && IN(pb + 2)) { FRESH();
            const float lam = WSP(float, WS_MISC)[l], oml = WSP(float, WS_MISC)[4 + l];
#if !defined(SUBM) || (SUBM & 1)
            for (int u = F.vcu; u < 1088; u += F.G) att::attn_unit((LAS char*)lds_raw, WSP(bf16, WS_P), WSP(bf16, WS_QR), WSP(bf16, WS_MIX), inptr(I_SUBLN) + l * 128, lam, oml, u, F.tid);
#endif
            __syncthreads();
#if !defined(SUBM) || (SUBM & 2)
            for (int u = F.vcu; u < 1024; u += F.G) hyena_unit(F, l, u);
            for (int u = F.vcu; u < 256; u += F.G) hyena_ctx_unit(F, l, u);
#endif
            __syncthreads();
#if !defined(SUBM) || (SUBM & 4)
            { pg8::Gemm g{WSP(bf16, WS_U5), WSP(bf16, WS_S5MB) + (size_t)l * 16 * 768 * 512, 16 * S5RP, 16 * 768, 512}; ListOrder S{240, 15, 3, 5, 3, F.G, F.bx};
              EpiS5i E{WSP(float, WS_YI), WSP(float, WS_ST)};
              pg8::gemm_phase<EpiS5i, ListOrder, true, true, false>(glds, g, S, E, F.tid); }
#endif
        }
        SEAM(pb + 2);
        if (PHM(5) && IN(pb + 3)) { FRESH(); s5_scan_phase(F, l); }
        SEAM(pb + 3);
        if (PHM(6) && IN(pb + 4)) { FRESH();
            pg8::Gemm g{WSP(bf16, WS_HIN), WSP(bf16, WS_S5CS) + (size_t)l * 16 * 512 * 256, 16 * S5RP, 16 * 512, 256}; ListOrder S{160, 10, 2, 5, 2, F.G, F.bx};
            EpiS5c E{WSP(float, WS_YI), WSP(bf16, WS_GY)};
            pg8::gemm_phase<EpiS5c, ListOrder, true, true, false>(glds, g, S, E, F.tid);
        }
        SEAM(pb + 4);
        if (PHM(7) && IN(pb + 5)) { FRESH();
            { pg8::Gemm g{WSP(bf16, WS_GY), WSP(bf16, WS_GLUT) + (size_t)l * 65536, MT, 256, 256}; ListOrder S{MT / 256, 1, 1, 1, 0, F.G, F.bx};
              EpiGlu E{WSP(bf16, WS_GY), WSP(bf16, WS_MIX), inptr(I_S5NG) + l * 256};
              pg8::gemm_phase<EpiGlu, ListOrder, false, true, false>(glds, g, S, E, F.tid); }
            __syncthreads();
            for (int u = F.vcu; u < MT / 64; u += F.G) hyena_fin_unit(F, l, u);
        }
        SEAM(pb + 5);
        if (PHM(8) && IN(pb + 6)) { FRESH();
            pg8::Gemm g{WSP(bf16, WS_MIX), WSP(bf16, WS_WOUTT) + (size_t)l * DM * DM, MT, DM, DM}; pg8::StaticOrder S; S.init(MT, DM, F.G, F.bx);
            EpiG2 E{WSP(float, WS_X), WSP(float, WS_MODV) + (size_t)l * 9 * NMOD};
            pg8::gemm_phase<EpiG2, pg8::StaticOrder, true, true, false>(glds, g, S, E, F.tid);
        }
        SEAM(pb + 6);
        if (PHM(9) && IN(pb + 7)) { FRESH(); n2r_phase(F, l); }
        SEAM(pb + 7);
        if (PHM(10) && IN(pb + 8)) { FRESH(); assign_phase(F, l); }
        SEAM(pb + 8);
        if (PHM(11) && IN(pb + 9)) { FRESH();
            const int ntiles = (int)__hip_atomic_load(F.ctl + CW_NTILES + l, RLX_AGENT);
            pg8::Gemm g{WSP(bf16, WS_H), WSP(bf16, WS_MOEW13), NSLOT, NEXP * 1024, DM}; MoeOrder S{(const int*)(F.ws + WS_TOK + TK_TILEE), ntiles, F.G, F.bx};
            EpiUp E{WSP(bf16, WS_HID)};
            pg8::gemm_phase<EpiUp, MoeOrder, true, true, true>(glds, g, S, E, F.tid, (const int*)(F.ws + WS_TOK + TK_STOK));
        }
        SEAM(pb + 9);
        if (PHM(12) && IN(pb + 10)) { FRESH();
            const int ntiles = (int)__hip_atomic_load(F.ctl + CW_NTILES + l, RLX_AGENT);
            pg8::Gemm g{WSP(bf16, WS_HID), WSP(bf16, WS_MOEW2), NSLOT, NEXP * 1024, EHID}; MoeOrder S{(const int*)(F.ws + WS_TOK + TK_TILEE), ntiles, F.G, F.bx};
            EpiDown E{WSP(bf16, WS_YB), (const float*)(F.ws + WS_TOK + TK_SGATE)};
            pg8::gemm_phase<EpiDown, MoeOrder, true, true, false>(glds, g, S, E, F.tid);
        }
        SEAM(pb + 10);
    }
    if (PHM(13) && IN(PH_FINAL)) { FRESH(); n1_phase(F, DEPTH); }
#undef IN
#undef SEAM
}

#ifndef MK_SPLIT
#define MK_SPLIT 0
#endif
extern "C" void kernel_launch(void* const* d_in, const int* in_sizes, int n_in, void* d_out, int out_size, void* d_ws, size_t ws_size, hipStream_t stream) {
    static int grid = 0;
    if (grid == 0) {
        if (n_in != 43 || out_size != ML * DM || ws_size < WS_END) { fprintf(stderr, "kernel_launch: unexpected problem: n_in %d out %d ws %zu (need %zu)\n", n_in, out_size, ws_size, (size_t)WS_END); grid = -1; return; }
        int dev = 0, cus = 0, per_cu = 0;
        if (hipGetDevice(&dev) != hipSuccess || hipDeviceGetAttribute(&cus, hipDeviceAttributeMultiprocessorCount, dev) != hipSuccess) { grid = -1; return; }
        if (hipFuncSetAttribute((const void*)mega_fwd, hipFuncAttributeMaxDynamicSharedMemorySize, LDS_BYTES) != hipSuccess) { fprintf(stderr, "kernel_launch: hipFuncSetAttribute failed\n"); grid = -1; return; }
        if (hipOccupancyMaxActiveBlocksPerMultiprocessor(&per_cu, (const void*)mega_fwd, NTHR, LDS_BYTES) != hipSuccess || per_cu < 1) fprintf(stderr, "kernel_launch: occupancy query says %d\n", per_cu);
        (void)hipGetLastError();
        grid = cus;
    }
    if (grid < 0) return;
    if (hipMemsetAsync((char*)d_ws + WS_CTL, 0, CTL_ZERO_BYTES, stream) != hipSuccess) return;
    Args a{};
    for (int i = 0; i < 43; ++i) a.in[i] = (const float*)d_in[i];
    a.out = (float*)d_out; a.ws = (unsigned char*)d_ws;
#if MK_SPLIT
    for (int p = 0; p < PH_TOTAL; ++p) { a.ph_lo = p; a.ph_hi = p + 1; hipLaunchKernelGGL(mega_fwd, dim3(grid), dim3(NTHR), LDS_BYTES, stream, a); }
#else
    a.ph_lo = 0; a.ph_hi = PH_TOTAL; hipLaunchKernelGGL(mega_fwd, dim3(grid), dim3(NTHR), LDS_BYTES, stream, a);
#endif
    const hipError_t le = hipPeekAtLastError();
    if (le != hipSuccess) fprintf(stderr, "kernel_launch: launch failed: %s\n", hipGetErrorName(le));
}
```

```cpp
#include <hip/hip_runtime.h>
#include <cstdio>
#include <cstdint>
#include <cmath>
__device__ __forceinline__ int lane_id_asm() { int l; asm volatile("v_mbcnt_lo_u32_b32 %0, -1, 0\n\tv_mbcnt_hi_u32_b32 %0, -1, %0" : "=v"(l)); return l; }
namespace pg8 {
#define PG8_LAS __attribute__((address_space(3)))
typedef unsigned short bf16_t;
typedef short bf16x8 __attribute__((ext_vector_type(8)));
typedef float f32x4 __attribute__((ext_vector_type(4)));
typedef unsigned u32x4 __attribute__((ext_vector_type(4)));
constexpr int BM = 256, BK = 64, HALF = 128, HTB = HALF * BK * 2  , STAGE_BYTES = 8 * HTB, NXCD = 8, WGM = 8;

__host__ __device__ __forceinline__ int lds_byte(int r, int c) { const int st = (r >> 4) * 2 + (c >> 5), rr = r & 15, cc = c & 31, ob = rr * 64 + cc * 2; return st * 1024 + (ob ^ (((ob >> 9) & 1) << 5)); }
__host__ __device__ __forceinline__ void stage_rc(int b, int& R, int& C) { const int st = b / 1024, sb = b % 1024, swz = sb ^ (((sb >> 9) & 1) << 5); R = (st >> 1) * 16 + swz / 64; C = (st & 1) * 32 + (swz % 64) / 2; }
__host__ __device__ __forceinline__ int perm32(int rho) { const int n = rho >> 4, i = rho & 15; return 8 * (i >> 2) + 4 * n + (i & 3); }

struct Unit { int pm, pn; };
struct Gemm { const bf16_t* A; const bf16_t* Bt; int M, N, K; };

struct StaticOrder {
    int nM, nN, nwg, G, c;
    __host__ __device__ void init(int M, int N, int G_, int c_) { nM = M / BM; nN = N / BM; nwg = nM * nN; G = G_; c = c_; }
    __host__ __device__ bool next(int i, Unit& u) const {
        const long L = (long)i * G + c; if (L >= nwg) return false;
        int wgid = (int)L; { const int q = nwg / NXCD, r = nwg % NXCD, xcd = wgid % NXCD, off = wgid / NXCD; wgid = (xcd < r ? xcd * (q + 1) : r * (q + 1) + (xcd - r) * q) + off; }
        const int nig = WGM * nN, gid = wgid / nig, fm = gid * WGM, gsz = (nM - fm) < WGM ? (nM - fm) : WGM;
        u.pm = fm + ((wgid % nig) % gsz); u.pn = (wgid % nig) / gsz; return true;
    }
    __device__ __forceinline__ void a_ready(const Unit&) const {}
    __device__ __forceinline__ void done(const Unit&) const {}
};

__device__ __forceinline__ unsigned cvt_pk_bf16(float lo, float hi) { unsigned r; asm volatile("v_cvt_pk_bf16_f32 %0, %1, %2" : "=v"(r) : "v"(lo), "v"(hi)); return r; }
typedef float f32x2 __attribute__((ext_vector_type(2)));
template <class Epi, class Sched, bool ALIGN_EPI = false, bool SP2 = false, bool GATHER = false>
__device__ __forceinline__ void gemm_phase(PG8_LAS unsigned char* lds, const Gemm g, const Sched& S, const Epi& E, int tid_, const int* rowidx = nullptr) {
    asm volatile("" : "+v"(tid_));
    const int tid = tid_, wid = __builtin_amdgcn_readfirstlane(tid >> 6), lane = tid & 63, wr = wid >> 2, wc = wid & 3, fr = lane & 15, fq = lane >> 4;
    const int K = g.K, nt = K / BK;
    unsigned voffA[2], voffB[2]; int RA[2], CA[2]; unsigned oC[2][2], oN[2][2];
#pragma unroll
    for (int i = 0; i < 2; ++i) { int R, C; stage_rc(tid * 16 + i * 8192, R, C); const int Rb = Epi::PERM ? ((R & ~31) + perm32(R & 31)) : R;
        voffA[i] = (unsigned)(R * K + C) * 2u; voffB[i] = (unsigned)(Rb * K + C) * 2u; RA[i] = R; CA[i] = C; }
    const size_t kstep = (size_t)(BK * 2);
    const size_t hstep = (size_t)HALF * K * 2;
    const size_t tstep = 2 * hstep;
    const size_t tstepA = GATHER ? (size_t)0 : tstep;
    const unsigned ldsw = (unsigned)wid * 1024u;
    const int aoff = lds_byte(wr * 64 + fr, fq * 8), boff = lds_byte(wc * 32 + fr, fq * 8);
#define PG8_SA(b, h) (((b) * 2 + (h)) * HTB)
#define PG8_SB(b, h) ((4 + (b) * 2 + (h)) * HTB)
#define PG8_STAGEA(bufoff, gbase, h, NX) do { _Pragma("unroll") for (int _i = 0; _i < 2; ++_i) { \
        const unsigned _o = GATHER ? ((NX) ? oN[h][_i] : oC[h][_i]) : (unsigned)((h) * hstep) + voffA[_i]; \
        __builtin_amdgcn_global_load_lds((const unsigned*)((const char*)(gbase) + _o), (PG8_LAS unsigned*)(lds + (bufoff) + ldsw + _i * 8192), 16, 0, 0); } } while (0)
#define PG8_GIDX(dst, pm_) do { _Pragma("unroll") for (int _h = 0; _h < 2; ++_h) _Pragma("unroll") for (int _i = 0; _i < 2; ++_i) \
        dst[_h][_i] = ((unsigned)rowidx[(pm_) * BM + _h * HALF + RA[_i]] * (unsigned)K + (unsigned)CA[_i]) * 2u; } while (0)
#define PG8_STAGE(bufoff, gbase, voff) do { _Pragma("unroll") for (int _i = 0; _i < 2; ++_i) \
        __builtin_amdgcn_global_load_lds((const unsigned*)((const char*)(gbase) + (voff)[_i]), (PG8_LAS unsigned*)(lds + (bufoff) + ldsw + _i * 8192), 16, 0, 0); } while (0)
#define PG8_LDA(dst, b, h) do { _Pragma("unroll") for (int m = 0; m < 4; ++m) _Pragma("unroll") for (int k = 0; k < 2; ++k) dst[m][k] = *(const PG8_LAS bf16x8*)(lds + PG8_SA(b, h) + aoff + m * 2048 + k * 1024); } while (0)
#define PG8_LDB(dst, b, h) do { _Pragma("unroll") for (int n = 0; n < 2; ++n) _Pragma("unroll") for (int k = 0; k < 2; ++k) dst[n][k] = *(const PG8_LAS bf16x8*)(lds + PG8_SB(b, h) + boff + n * 2048 + k * 1024); } while (0)
#define PG8_MMA(ai, bj, At, Bt) do { __builtin_amdgcn_s_setprio(1); _Pragma("unroll") for (int m = 0; m < 4; ++m) _Pragma("unroll") for (int n = 0; n < 2; ++n) _Pragma("unroll") for (int k = 0; k < 2; ++k) \
        acc[ai][bj][m][n] = __builtin_amdgcn_mfma_f32_16x16x32_bf16(Bt[n][k], At[m][k], acc[ai][bj][m][n], 0, 0, 0); __builtin_amdgcn_s_setprio(0); } while (0)
#define PG8_WAIT_V(n) asm volatile("s_waitcnt vmcnt(" #n ")" ::: "memory")
#define PG8_WAIT_L(n) asm volatile("s_waitcnt lgkmcnt(" #n ")" ::: "memory")
#define PG8_BAR __builtin_amdgcn_s_barrier()
#define PG8_SCHED __builtin_amdgcn_sched_barrier(0)
    Unit cur, nxt; int ui = 0;
    if (!S.next(0, cur)) return;
    f32x4 acc[2][2][4][2];
#pragma unroll
    for (int a = 0; a < 2; ++a)
#pragma unroll
        for (int b = 0; b < 2; ++b)
#pragma unroll
            for (int m = 0; m < 4; ++m)
#pragma unroll
                for (int n = 0; n < 2; ++n) acc[a][b][m][n] = (f32x4){0.f, 0.f, 0.f, 0.f};
    bf16x8 At[4][2], B0[2][2], B1[2][2];
    const char* cA = (const char*)g.A + (size_t)cur.pm * tstepA; const char* cB = (const char*)g.Bt + (size_t)cur.pn * tstep;
    if constexpr (GATHER) { PG8_GIDX(oC, cur.pm); asm volatile("s_waitcnt vmcnt(0)" ::: "memory"); }
    S.a_ready(cur);
    if constexpr (SP2) {
        PG8_STAGE(PG8_SB(0, 0), cB, voffB); PG8_STAGE(PG8_SB(0, 1), cB + hstep, voffB); PG8_STAGEA(PG8_SA(0, 0), cA, 0, false); PG8_STAGEA(PG8_SA(0, 1), cA, 1, false);
        if (wr == 1) PG8_BAR;
        PG8_WAIT_V(2); PG8_BAR;
        PG8_STAGE(PG8_SB(1, 0), cB + kstep, voffB); PG8_STAGEA(PG8_SA(1, 0), cA + kstep, 0, false); PG8_STAGE(PG8_SB(1, 1), cB + hstep + kstep, voffB);
        PG8_WAIT_V(6); PG8_BAR;
    } else {
        PG8_STAGE(PG8_SB(0, 0), cB, voffB); PG8_STAGEA(PG8_SA(0, 0), cA, 0, false); PG8_STAGE(PG8_SB(0, 1), cB + hstep, voffB); PG8_STAGEA(PG8_SA(0, 1), cA, 1, false);
        if (wr == 1) PG8_BAR;
        PG8_WAIT_V(4); PG8_BAR;
        PG8_STAGE(PG8_SB(1, 0), cB + kstep, voffB); PG8_STAGEA(PG8_SA(1, 0), cA + kstep, 0, false); PG8_STAGE(PG8_SB(1, 1), cB + hstep + kstep, voffB);
        PG8_WAIT_V(6); PG8_BAR;
    }
    for (;;) {
        const bool has_next = S.next(ui + 1, nxt);
        const char* nA = has_next ? (const char*)g.A + (size_t)nxt.pm * tstepA : cA; const char* nB = has_next ? (const char*)g.Bt + (size_t)nxt.pn * tstep : cB;
        if constexpr (GATHER) { if (has_next) { PG8_GIDX(oN, nxt.pm); asm volatile("s_waitcnt vmcnt(0)" ::: "memory"); } else { _Pragma("unroll") for (int _h = 0; _h < 2; ++_h) _Pragma("unroll") for (int _i = 0; _i < 2; ++_i) oN[_h][_i] = oC[_h][_i]; } }
        for (int t = 0; t < nt; t += 2) {
            const bool last = (t == nt - 2);
            const char* a1 = cA + (size_t)(t + 1) * kstep;
            const char* a2 = last ? nA : cA + (size_t)(t + 2) * kstep; const char* b2 = last ? nB : cB + (size_t)(t + 2) * kstep;
            const char* a3 = a2 + kstep; const char* b3 = b2 + kstep;
            if (last && has_next) S.a_ready(nxt);
            if constexpr (SP2) {
            PG8_LDB(B0, 0, 0); PG8_LDB(B1, 0, 1); PG8_SCHED; PG8_LDA(At, 0, 0); PG8_STAGEA(PG8_SA(1, 1), a1, 1, false);
            PG8_WAIT_V(8); PG8_WAIT_L(0); PG8_BAR; PG8_MMA(0, 0, At, B0); PG8_MMA(0, 1, At, B1); PG8_BAR; PG8_SCHED;
            PG8_LDA(At, 0, 1); PG8_STAGE(PG8_SB(0, 0), b2, voffB); PG8_STAGE(PG8_SB(0, 1), b2 + hstep, voffB); PG8_STAGEA(PG8_SA(0, 0), a2, 0, last);
            PG8_WAIT_V(8); PG8_WAIT_L(0); PG8_BAR; PG8_MMA(1, 0, At, B0); PG8_MMA(1, 1, At, B1); PG8_BAR; PG8_SCHED;
            PG8_LDB(B0, 1, 0); PG8_LDB(B1, 1, 1); PG8_SCHED; PG8_LDA(At, 1, 0); PG8_STAGEA(PG8_SA(0, 1), a2, 1, last);
            PG8_WAIT_V(8); PG8_WAIT_L(0); PG8_BAR; PG8_MMA(0, 0, At, B0); PG8_MMA(0, 1, At, B1); PG8_BAR; PG8_SCHED;
            PG8_LDA(At, 1, 1); PG8_STAGE(PG8_SB(1, 0), b3, voffB); PG8_STAGE(PG8_SB(1, 1), b3 + hstep, voffB); PG8_STAGEA(PG8_SA(1, 0), a3, 0, last);
            PG8_WAIT_V(8); PG8_WAIT_L(0); PG8_BAR; PG8_MMA(1, 0, At, B0); PG8_MMA(1, 1, At, B1); PG8_BAR; PG8_SCHED;
            } else {
            PG8_LDB(B0, 0, 0); PG8_SCHED; PG8_LDA(At, 0, 0); PG8_STAGEA(PG8_SA(1, 1), a1, 1, false);
            PG8_WAIT_L(8); PG8_BAR; PG8_WAIT_L(0); PG8_MMA(0, 0, At, B0); PG8_BAR; PG8_SCHED;
            PG8_LDB(B1, 0, 1); PG8_STAGE(PG8_SB(0, 0), b2, voffB);
            PG8_BAR; PG8_WAIT_L(0); PG8_MMA(0, 1, At, B1); PG8_BAR;
            PG8_LDA(At, 0, 1); PG8_STAGEA(PG8_SA(0, 0), a2, 0, last);
            PG8_BAR; PG8_WAIT_L(0); PG8_MMA(1, 0, At, B0); PG8_BAR; PG8_SCHED;
            PG8_STAGE(PG8_SB(0, 1), b2 + hstep, voffB);
            PG8_WAIT_V(6); PG8_BAR; PG8_MMA(1, 1, At, B1); PG8_BAR;
            PG8_LDB(B0, 1, 0); PG8_SCHED; PG8_LDA(At, 1, 0); PG8_STAGEA(PG8_SA(0, 1), a2, 1, last);
            PG8_WAIT_L(8); PG8_BAR; PG8_WAIT_L(0); PG8_MMA(0, 0, At, B0); PG8_BAR; PG8_SCHED;
            PG8_LDB(B1, 1, 1); PG8_STAGE(PG8_SB(1, 0), b3, voffB);
            PG8_BAR; PG8_WAIT_L(0); PG8_MMA(0, 1, At, B1); PG8_BAR;
            PG8_LDA(At, 1, 1); PG8_STAGEA(PG8_SA(1, 0), a3, 0, last);
            PG8_BAR; PG8_WAIT_L(0); PG8_MMA(1, 0, At, B0); PG8_BAR; PG8_SCHED;
            PG8_STAGE(PG8_SB(1, 1), b3 + hstep, voffB);
            PG8_WAIT_V(6); PG8_BAR; PG8_MMA(1, 1, At, B1); PG8_BAR;
            }
        }
        if constexpr (ALIGN_EPI) { if (wr == 0) PG8_BAR; }
        if constexpr (!Epi::AFTER_DRAIN) { const int l2_ = lane_id_asm(); E(acc, cur, wr, wc, l2_ & 15, l2_ >> 4); S.done(cur); }
        if (!has_next) break;
#pragma unroll
        for (int a = 0; a < 2; ++a)
#pragma unroll
            for (int b = 0; b < 2; ++b)
#pragma unroll
                for (int m = 0; m < 4; ++m)
#pragma unroll
                    for (int n = 0; n < 2; ++n) acc[a][b][m][n] = (f32x4){0.f, 0.f, 0.f, 0.f};
        cur = nxt; cA = nA; cB = nB; ++ui;
        if constexpr (GATHER) { _Pragma("unroll") for (int _h = 0; _h < 2; ++_h) _Pragma("unroll") for (int _i = 0; _i < 2; ++_i) oC[_h][_i] = oN[_h][_i]; }
        if constexpr (ALIGN_EPI) { if (wr == 1) PG8_BAR; }
    }
    PG8_WAIT_V(0);
    if constexpr (!ALIGN_EPI) { if (wr == 0) PG8_BAR; }
    PG8_BAR;
    if constexpr (Epi::AFTER_DRAIN) { const int l2_ = lane_id_asm(); E.fused(acc, cur, wr, wc, l2_ & 15, l2_ >> 4, lds, wid, l2_); S.done(cur); }
#undef PG8_SA
#undef PG8_SB
#undef PG8_STAGE
#undef PG8_STAGEA
#undef PG8_GIDX
#undef PG8_LDA
#undef PG8_LDB
#undef PG8_MMA
#undef PG8_WAIT_V
#undef PG8_WAIT_L
#undef PG8_BAR
#undef PG8_SCHED
}
}

constexpr int DM = 1024, NB = 8, SEQ = 4096, CTXL = 256, DEPTH = 4;
constexpr int ML = NB * SEQ;
constexpr int MC = NB * CTXL;
constexpr int MT = ML + MC;
constexpr int INC = 2560;
constexpr int C_S5 = 768, C_Q = 1024, C_K = 1536, C_V = 2048;
constexpr int NMOD = 6 * DM;
constexpr int NEXP = 32, EHID = 512;
constexpr int NSLOT = (MT * 2 / 256 + NEXP) * 256;
constexpr float EPSF = 1e-6f;
constexpr int S5T = 32;
constexpr int S5ROWS = MT / S5T;
constexpr int S5RP = 1280;
constexpr int NWAVES = 8, NTHR = 512;
constexpr int NPL = 11;
constexpr int PH_LAYER0 = 2, PH_FINAL = PH_LAYER0 + DEPTH * NPL, PH_TOTAL = PH_FINAL + 1;

constexpr size_t MiB = 1u << 20;
constexpr size_t WS_CTL = 0, CTL_ZERO_BYTES = 1 * MiB;
constexpr size_t WS_MODV = 2 * MiB;
constexpr size_t WS_MISC = 3 * MiB;
constexpr size_t WS_ROPE = 4 * MiB;
constexpr size_t WS_H2T = 5 * MiB;
constexpr size_t WS_H2C = 9 * MiB;
constexpr size_t WS_FC = 10 * MiB;
constexpr size_t WS_WGE = 12 * MiB;
constexpr size_t WS_GLUT = 13 * MiB;
constexpr size_t WS_WINT = 16 * MiB;
constexpr size_t WS_WOUTT = 36 * MiB;
constexpr size_t WS_S5MB = 44 * MiB;
constexpr size_t WS_S5CS = 92 * MiB;
constexpr size_t WS_FSPEC = 108 * MiB;
constexpr size_t WS_X = 172 * MiB;
constexpr size_t WS_H = 308 * MiB;
constexpr size_t WS_MOEW13 = 377 * MiB;
constexpr size_t WS_MOEW2 = 441 * MiB;
constexpr size_t WS_U5 = 473 * MiB;
constexpr size_t WS_YI = 493 * MiB;
constexpr size_t WS_ST = 533 * MiB;
constexpr size_t WS_HIN = 553 * MiB;
constexpr size_t WS_GY = 563 * MiB;
constexpr size_t WS_HYW = 583 * MiB;
constexpr size_t WS_HYWC = 615 * MiB;
constexpr size_t WS_TOK = 617 * MiB;
constexpr size_t WS_R = 620 * MiB;
constexpr size_t WS_P = WS_R;
constexpr size_t WS_QR = WS_R + 170 * MiB;
constexpr size_t WS_MIX = WS_R + 202 * MiB;
constexpr size_t WS_HID = WS_R;
constexpr size_t WS_YB = WS_R + 76 * MiB;
constexpr size_t WS_END = WS_R + 270 * MiB;
constexpr size_t TK_E = 0, TK_POS = TK_E + (size_t)MT * 2 * 4, TK_GATE = TK_POS + (size_t)MT * 2 * 4, TK_SLOT = TK_GATE + (size_t)MT * 2 * 4;
constexpr size_t TK_STOK = TK_SLOT + (size_t)MT * 2 * 4, TK_SGATE = TK_STOK + (size_t)NSLOT * 4, TK_TILEE = TK_SGATE + (size_t)NSLOT * 4, TK_HIST = TK_TILEE + 4096, TK_END = TK_HIST + 256 * 32 * 4;
static_assert(TK_END <= 3 * MiB, "routing tables");
constexpr int CW_TMO = 0;
constexpr int CW_BAR = 4096;
constexpr int CW_CNT = 16384;
constexpr int CW_NTILES = 16384 + 1024;

constexpr int LDS_BYTES = 163840;
constexpr int MISC_OFF = 162816;

#define GAS __attribute__((address_space(1)))
#define LAS __attribute__((address_space(3)))
typedef unsigned short bf16;
typedef unsigned v4u __attribute__((ext_vector_type(4)));
typedef unsigned v2u __attribute__((ext_vector_type(2)));
typedef float f32x4 __attribute__((ext_vector_type(4)));
typedef float f32x2 __attribute__((ext_vector_type(2)));
typedef float f32x16 __attribute__((ext_vector_type(16)));
typedef short bf16x8 __attribute__((ext_vector_type(8)));
typedef short s16x4 __attribute__((ext_vector_type(4)));
typedef GAS unsigned gu32;
#define RLX_AGENT __ATOMIC_RELAXED, __HIP_MEMORY_SCOPE_AGENT
#define LDS_WAIT() asm volatile("s_waitcnt lgkmcnt(0)" ::: "memory")
#define VM_WAIT() asm volatile("s_waitcnt vmcnt(0)" ::: "memory")
__device__ __forceinline__ unsigned f2bf(float f) { unsigned u = __builtin_bit_cast(unsigned, f); return (u + 0x7fffu + ((u >> 16) & 1u)) >> 16; }
__device__ __forceinline__ unsigned pk2(float lo, float hi) { return pg8::cvt_pk_bf16(lo, hi); }
__device__ __forceinline__ float bf2f(unsigned short h) { return __builtin_bit_cast(float, (unsigned)h << 16); }
__device__ __forceinline__ float bflo(unsigned w) { return __builtin_bit_cast(float, w << 16); }
__device__ __forceinline__ float bfhi(unsigned w) { return __builtin_bit_cast(float, w & 0xffff0000u); }
__device__ __forceinline__ float fexp(float x) { return __builtin_amdgcn_exp2f(x * 1.4426950408889634f); }
__device__ __forceinline__ float fsigmoid(float x) { return __builtin_amdgcn_rcpf(1.f + fexp(-x)); }
__device__ __forceinline__ float fsilu(float x) { return x * fsigmoid(x); }
__device__ __forceinline__ float fgelu_tanh(float x) { const float u = 0.7978845608028654f * (x + 0.044715f * x * x * x); return x * fsigmoid(2.f * u); }
template <int M> __device__ __forceinline__ float xor_add(float v) {
    if constexpr (M < 32) return v + __builtin_bit_cast(float, __builtin_amdgcn_ds_swizzle(__builtin_bit_cast(int, v), (M << 10) | 0x1f));
    else { auto rr = __builtin_amdgcn_permlane32_swap(__float_as_uint(v), __float_as_uint(v), false, false); const unsigned a = rr[0], b = rr[1]; return __uint_as_float(a) + __uint_as_float(b); }
}
__device__ __forceinline__ float wave_sum(float v) { v = xor_add<1>(v); v = xor_add<2>(v); v = xor_add<4>(v); v = xor_add<8>(v); v = xor_add<16>(v); v = xor_add<32>(v); return v; }
#define XB_TMO      128
#define XB_XCNT(j)  (256  + 64 * (j))
#define XB_XSUB(j)  (1280 + 64 * (j))
#define XB_XGEN(j)  (2304 + 64 * (j))
#define XB_TOP      3328
#define XB_TOPGEN   3392
#define XCD_BAR_WORDS 3456
#define XB_SPIN_CAP (1u << 18)

__device__ __forceinline__ unsigned xb_ld(unsigned* p)              { return __hip_atomic_load(p, __ATOMIC_RELAXED, __HIP_MEMORY_SCOPE_AGENT); }
__device__ __forceinline__ unsigned xb_add(unsigned* p, unsigned v) { return __hip_atomic_fetch_add(p, v, __ATOMIC_RELAXED, __HIP_MEMORY_SCOPE_AGENT); }
__device__ __forceinline__ unsigned xb_xcc_id() { return (unsigned)__builtin_amdgcn_s_getreg((3 << 11) | 20) & 0xFu; }
#define XB_SPIN(cond, bar) do { unsigned _sp = 0; while (cond) { __builtin_amdgcn_s_sleep(1); \
    if ((++_sp & 255u) == 0u) { if (xb_ld(&(bar)[XB_TMO])) break; if (_sp > XB_SPIN_CAP) { atomicAdd(&(bar)[XB_TMO], 1u); break; } } } } while (0)

struct XcdBarrier {
    unsigned* bar; unsigned x;
    volatile LAS unsigned* st;
};

__device__ __forceinline__ XcdBarrier xcd_barrier_post(unsigned* bar, volatile LAS unsigned* st, int tid) {
    XcdBarrier b; b.bar = bar; b.x = xb_xcc_id(); b.st = st;
    if (tid == 0) (void)xb_add(&bar[XB_XCNT(b.x)], 1u);
    return b;
}
__device__ __forceinline__ void xcd_barrier_complete(unsigned* bar, unsigned x, unsigned& nloc, unsigned& nx) {
    const unsigned G = gridDim.x * gridDim.y * gridDim.z;
    unsigned sum, cnt, mine, sp = 0u;
    for (;;) {
        sum = 0u; cnt = 0u; mine = 0u;
#pragma unroll
        for (unsigned j = 0; j < 16; ++j) { const unsigned c = xb_ld(&bar[XB_XCNT(j)]); sum += c; cnt += (c > 0u) ? 1u : 0u; mine = (j == x) ? c : mine; }
        if (sum == G) break;
        __builtin_amdgcn_s_sleep(1);
        if ((++sp & 255u) == 0u) { if (xb_ld(&bar[XB_TMO])) break; if (sp > XB_SPIN_CAP) { atomicAdd(&bar[XB_TMO], 1u); break; } }
    }
    nloc = mine > 0u ? mine : 1u; nx = cnt > 0u ? cnt : 1u;
}

__device__ __forceinline__ void xcd_barrier(const XcdBarrier& b, int tid) {
    asm volatile("s_waitcnt vmcnt(0)" ::: "memory");
    __syncthreads();
    if (tid == 0) {
        unsigned* bar = b.bar;
        __builtin_amdgcn_s_waitcnt(0);
        unsigned nloc = b.st[0], nx = b.st[1];
        if (nloc == 0u) { xcd_barrier_complete(bar, b.x, nloc, nx); b.st[0] = nloc; b.st[1] = nx; }
        const unsigned old = xb_add(&bar[XB_XSUB(b.x)], 1u);
        const unsigned gen = old / nloc;
        if (old + 1u == (gen + 1u) * nloc) {
            __builtin_amdgcn_fence(__ATOMIC_RELEASE, "agent");
            asm volatile("s_waitcnt vmcnt(0)" ::: "memory");
            const unsigned og = xb_add(&bar[XB_TOP], 1u);
            const unsigned tg = og / nx;
            if (og + 1u == (tg + 1u) * nx) xb_add(&bar[XB_TOPGEN], 1u);
            else XB_SPIN(xb_ld(&bar[XB_TOPGEN]) == tg, bar);
            __builtin_amdgcn_fence(__ATOMIC_ACQUIRE, "agent");
            xb_add(&bar[XB_XGEN(b.x)], 1u);
            asm volatile("s_waitcnt vmcnt(0)" ::: "memory");
        } else {
            XB_SPIN(xb_ld(&bar[XB_XGEN(b.x)]) == gen, bar);
            __builtin_amdgcn_fence(__ATOMIC_ACQUIRE, "agent");
            asm volatile("s_waitcnt vmcnt(0)" ::: "memory");
        }
    }
    __syncthreads();
}

struct Args { const float* in[43]; float* out; unsigned char* ws; int ph_lo, ph_hi; };
enum InIdx { I_X = 0, I_C, I_CTX, I_CCTX, I_WMOD, I_BMOD, I_N1G, I_N2G, I_FING, I_WIN, I_WOUT, I_HYCW, I_HYCB, I_HYW1, I_HYB1, I_HYW2, I_HYB2, I_HYW3, I_HYFREQ, I_HYSKIP, I_HYNG,
             I_S5ARE, I_S5AIM, I_S5LDT, I_S5BRE, I_S5BIM, I_S5CRE, I_S5CIM, I_S5D, I_S5GLU, I_S5NG, I_LQ1, I_LK1, I_LQ2, I_LK2, I_SUBLN, I_MWG, I_MBG, I_MWE, I_MBE, I_MW1, I_MW3, I_MW2 };
struct Frame {
    LAS unsigned char* lds;
    float* out; unsigned char* ws; gu32* ctl;
    int tid, lane, wave, vcu, G, bx;
};
#define WSP(T, off) ((T*)(F.ws + (off)))
__device__ __forceinline__ const float* inptr(int idx) { const unsigned long ka = (unsigned long)__builtin_amdgcn_kernarg_segment_ptr(); const float* p;
    asm volatile("s_load_dwordx2 %0, %1, %2\n\ts_waitcnt lgkmcnt(0)" : "=s"(p) : "s"(ka), "n"(idx * 8)); return p; }

template <class RowMap>
__device__ __forceinline__ void transpose_item(const float* W, int K, int N, bf16* WT, LAS float* scr, int item, int lane, const RowMap& rowmap) {
    const int nblk = N / 64, kb = item / nblk, nb = item % nblk, k0 = 64 * kb, n0 = 64 * nb;
    f32x4 v[16];
#pragma unroll
    for (int i = 0; i < 16; ++i) v[i] = *(const f32x4*)(W + (size_t)(k0 + 4 * i + (lane >> 4)) * N + n0 + 4 * (lane & 15));
#pragma unroll
    for (int i = 0; i < 16; ++i) { LAS float* d = scr + (4 * i + (lane >> 4)) * 65 + 4 * (lane & 15); d[0] = v[i].x; d[1] = v[i].y; d[2] = v[i].z; d[3] = v[i].w; }
    LDS_WAIT(); asm volatile("" ::: "memory");
    const int c = lane & 7;
#pragma unroll
    for (int j = 0; j < 8; ++j) { const int n = (lane >> 3) + 8 * j; const LAS float* s = scr + (8 * c) * 65 + n;
        v4u o; o.x = pk2(s[0 * 65], s[1 * 65]); o.y = pk2(s[2 * 65], s[3 * 65]); o.z = pk2(s[4 * 65], s[5 * 65]); o.w = pk2(s[6 * 65], s[7 * 65]);
        *(GAS v4u*)(WT + (size_t)rowmap(n0 + n) * K + k0 + 8 * c) = o; }
    LDS_WAIT(); asm volatile("" ::: "memory");
}
struct RowId { __device__ __forceinline__ int operator()(int n) const { return n; } };
struct RowWin {
    __device__ __forceinline__ int operator()(int n) const { if (n < C_Q || n >= C_V) return n; const int d = n & 63, j = d & 31, s = d >> 5; return (n - d) + 2 * j + s; } };
struct RowW13 { int off; __device__ __forceinline__ int operator()(int j) const { return (j >> 7) * 256 + off + (j & 127); } };

__device__ __forceinline__ void p0_modv(Frame& F) {
    const float* const in_BMOD = inptr(I_BMOD);
    const float* const in_C = inptr(I_C);
    const float* const in_CCTX = inptr(I_CCTX);
    const float* const in_WMOD = inptr(I_WMOD);
    LAS float* sc = (LAS float*)F.lds;
    LAS float* red = (LAS float*)(F.lds + 36864);
    for (int i = F.tid; i < 9 * 1024; i += NTHR) { const int bi = i >> 10, k = i & 1023; const float v = bi < 8 ? in_C[bi * 1024 + k] : in_CCTX[k]; sc[i] = fsilu(v); }
    __syncthreads();
    for (int unit = F.vcu; unit < DEPTH * 48; unit += F.G) {
        const int l = unit / 48, cb = unit % 48, c4 = F.tid & 31, kk = F.tid >> 5;
        f32x4 acc[9];
#pragma unroll
        for (int b = 0; b < 9; ++b) acc[b] = (f32x4){0.f, 0.f, 0.f, 0.f};
        const float* wb = in_WMOD + (size_t)l * DM * NMOD + cb * 128 + c4 * 4;
#pragma unroll 4
        for (int i = 0; i < 64; ++i) { const int k = kk + 16 * i; const f32x4 w = *(const f32x4*)(wb + (size_t)k * NMOD);
#pragma unroll
            for (int b = 0; b < 9; ++b) acc[b] += sc[b * 1024 + k] * w; }
#pragma unroll
        for (int b = 0; b < 9; ++b) *(LAS f32x4*)(red + (kk * 9 + b) * 128 + c4 * 4) = acc[b];
        __syncthreads();
        for (int o = F.tid; o < 9 * 128; o += NTHR) { const int b = o >> 7, cc = o & 127; float s = in_BMOD[l * NMOD + cb * 128 + cc];
#pragma unroll
            for (int q = 0; q < 16; ++q) s += red[(q * 9 + b) * 128 + cc];
            WSP(float, WS_MODV)[(size_t)(l * 9 + b) * NMOD + cb * 128 + cc] = s; }
        __syncthreads();
    }
    __syncthreads();
}
__device__ __forceinline__ void p0_weights(Frame& F) {
    const float* const in_S5GLU = inptr(I_S5GLU);
    const float* const in_WIN = inptr(I_WIN);
    const float* const in_WOUT = inptr(I_WOUT);
    LAS float* scr = (LAS float*)(F.lds + F.wave * 16640);
    const int gw = F.vcu * NWAVES + F.wave, NGW = F.G * NWAVES;
    constexpr int I_IN = (DM / 64) * (INC / 64), I_OUT = (DM / 64) * (DM / 64), I_GLU = (256 / 64) * (256 / 64);
    constexpr int NIT = DEPTH * (I_IN + I_OUT + I_GLU);
    for (int it = gw; it < NIT; it += NGW) {
        int r = it; const int l = r / (I_IN + I_OUT + I_GLU); r -= l * (I_IN + I_OUT + I_GLU);
        if (r < I_IN) { transpose_item(in_WIN + (size_t)l * DM * INC, DM, INC, WSP(bf16, WS_WINT) + (size_t)l * INC * DM, scr, r, F.lane, RowWin{}); continue; } r -= I_IN;
        if (r < I_OUT) { transpose_item(in_WOUT + (size_t)l * DM * DM, DM, DM, WSP(bf16, WS_WOUTT) + (size_t)l * DM * DM, scr, r, F.lane, RowId{}); continue; } r -= I_OUT;
        transpose_item(in_S5GLU + (size_t)l * 65536, 256, 256, WSP(bf16, WS_GLUT) + (size_t)l * 65536, scr, r, F.lane, RowId{});
    }
}
__device__ __forceinline__ void moe_weights(Frame& F, int l) {
    const float* const in_MW1 = inptr(I_MW1);
    const float* const in_MW2 = inptr(I_MW2);
    const float* const in_MW3 = inptr(I_MW3);
    LAS float* scr = (LAS float*)(F.lds + F.wave * 16640);
    const int gw = F.vcu * NWAVES + F.wave, NGW = F.G * NWAVES;
    constexpr int I_1 = (DM / 64) * (EHID / 64), I_2 = (EHID / 64) * (DM / 64);
    for (int it = gw; it < NEXP * (2 * I_1 + I_2); it += NGW) {
        const int e = it / (2 * I_1 + I_2); int r = it - e * (2 * I_1 + I_2);
        const size_t eo = (size_t)(l * NEXP + e) * DM * EHID;
        if (r < I_1) { transpose_item(in_MW1 + eo, DM, EHID, WSP(bf16, WS_MOEW13) + (size_t)e * 1024 * 1024, scr, r, F.lane, RowW13{0}); continue; } r -= I_1;
        if (r < I_1) { transpose_item(in_MW3 + eo, DM, EHID, WSP(bf16, WS_MOEW13) + (size_t)e * 1024 * 1024, scr, r, F.lane, RowW13{128}); continue; } r -= I_1;
        transpose_item(in_MW2 + eo, EHID, DM, WSP(bf16, WS_MOEW2) + (size_t)e * 1024 * 512, scr, r, F.lane, RowId{});
    }
}
__device__ __forceinline__ void p0_h2(Frame& F) {
    const float* const in_HYB1 = inptr(I_HYB1);
    const float* const in_HYB2 = inptr(I_HYB2);
    const float* const in_HYFREQ = inptr(I_HYFREQ);
    const float* const in_HYW1 = inptr(I_HYW1);
    const float* const in_HYW2 = inptr(I_HYW2);
    LAS float* feat = (LAS float*)F.lds;
    LAS float* h1 = feat + 8 * 33;
    constexpr int UPL = (SEQ + CTXL) / 8;
    for (int unit = F.vcu; unit < DEPTH * UPL; unit += F.G) {
        const int l = unit / UPL, ub = unit % UPL; const bool isc = ub >= SEQ / 8; const int pos0 = isc ? (ub - SEQ / 8) * 8 : ub * 8; const float invL = isc ? 1.f / CTXL : 1.f / SEQ;
        if (F.tid < 8 * 33) { const int p = F.tid / 33, j = F.tid % 33; const float t = (float)(pos0 + p) * invL; float v;
            if (j == 0) v = t; else { const int m = j <= 16 ? j : j - 16; const float ang = 6.283185307179586f * t * (float)m; v = j <= 16 ? cosf(ang) : sinf(ang); }
            feat[F.tid] = v; }
        __syncthreads();
        const int p = F.tid >> 6, k = F.tid & 63;
        { float s = in_HYB1[l * 64 + k]; const float* w1 = in_HYW1 + (size_t)l * 33 * 64 + k;
#pragma unroll
          for (int j = 0; j < 33; ++j) s += feat[p * 33 + j] * w1[j * 64];
          h1[p * 64 + k] = sinf(in_HYFREQ[l * 64 + k] * s); }
        __syncthreads();
        { float s = in_HYB2[l * 64 + k]; const float* w2 = in_HYW2 + (size_t)l * 64 * 64 + k;
#pragma unroll 8
          for (int j = 0; j < 64; ++j) s += h1[p * 64 + j] * w2[j * 64];
          const float v = sinf(in_HYFREQ[l * 64 + k] * s);
          if (isc) WSP(float, WS_H2C)[((size_t)l * CTXL + pos0 + p) * 64 + k] = v; else WSP(float, WS_H2T)[((size_t)l * SEQ + pos0 + p) * 64 + k] = v; }
        __syncthreads();
    }
}
__device__ __forceinline__ void p0_misc(Frame& F) {
    const float* const in_MWE = inptr(I_MWE);
    const float* const in_MWG = inptr(I_MWG);
    const float* const in_LK1 = inptr(I_LK1);
    const float* const in_LK2 = inptr(I_LK2);
    const float* const in_LQ1 = inptr(I_LQ1);
    const float* const in_LQ2 = inptr(I_LQ2);
    for (int i = F.vcu * NTHR + F.tid; i < SEQ * 32; i += F.G * NTHR) { const int t = i >> 5, j = i & 31; const float inv = powf(10000.f, -(float)(j & 15) / 16.f);
        const float ang = (float)(j < 16 ? (t >> 6) : (t & 63)) * inv; WSP(f32x2, WS_ROPE)[i] = (f32x2){cosf(ang), sinf(ang)}; }
    for (int i = F.vcu * NTHR + F.tid; i < DEPTH * 48 * 1024; i += F.G * NTHR) { const int l = i / (48 * 1024), n = (i >> 10) % 48, k = i & 1023;
        const float w = n < 32 ? in_MWE[((size_t)l * DM + k) * 32 + n] : n < 36 ? in_MWG[((size_t)l * DM + k) * 4 + (n - 32)] : 0.f;
        const unsigned hi = f2bf(w); const float lo = w - __builtin_bit_cast(float, hi << 16);
        bf16* dst = WSP(bf16, WS_WGE) + (size_t)l * 2 * 48 * 1024 + (size_t)n * 1024 + k; dst[0] = (bf16)hi; dst[48 * 1024] = (bf16)f2bf(lo); }
    if (F.bx == 0) {
        if (F.tid < DEPTH) { const int l = F.tid; float s1 = 0.f, s2 = 0.f;
            for (int d = 0; d < 64; ++d) { s1 += in_LQ1[l * 64 + d] * in_LK1[l * 64 + d]; s2 += in_LQ2[l * 64 + d] * in_LK2[l * 64 + d]; }
            const float li = 0.8f - 0.6f * expf(-0.3f * (float)l);
            WSP(float, WS_MISC)[l] = expf(s1) - expf(s2) + li; WSP(float, WS_MISC)[4 + l] = 1.f - li; }
        for (int i = F.tid; i < DM / 2; i += NTHR) WSP(unsigned, WS_H)[(size_t)MT * (DM / 2) + i] = 0u;
    }
}
__device__ __forceinline__ void p0_s5(Frame& F) {
    const float* const in_S5AIM = inptr(I_S5AIM);
    const float* const in_S5ARE = inptr(I_S5ARE);
    const float* const in_S5BIM = inptr(I_S5BIM);
    const float* const in_S5BRE = inptr(I_S5BRE);
    const float* const in_S5CIM = inptr(I_S5CIM);
    const float* const in_S5CRE = inptr(I_S5CRE);
    const float* const in_S5D = inptr(I_S5D);
    const float* const in_S5LDT = inptr(I_S5LDT);
    LAS f32x2* ap = (LAS f32x2*)F.lds;
    LAS f32x2* bb = ap + 2 * 33 * 64;
    LAS f32x2* cc = bb + 2 * 64 * 16;
    LAS float* kt = (LAS float*)(cc + 2 * 16 * 64);
    for (int unit = F.vcu; unit < DEPTH * 16; unit += F.G) {
        const int l = unit >> 4, g = unit & 15;
        for (int i = F.tid; i < 2 * 33 * 64; i += NTHR) { const int d = i / (33 * 64), tau = (i / 64) % 33, p = i & 63; const int pi = ((l * 2 + d) * 16 + g) * 64 + p;
            const float dt = expf(in_S5LDT[(l * 2 + d) * 16 + g]); const float xr = (float)tau * dt * in_S5ARE[pi], xi = (float)tau * dt * in_S5AIM[pi];
            const float m = expf(xr); ap[i] = (f32x2){m * cosf(xi), m * sinf(xi)}; }
        for (int i = F.tid; i < 2 * 64 * 16; i += NTHR) { const int d = i >> 10, p = (i >> 4) & 63, h = i & 15; const int pi = ((l * 2 + d) * 16 + g) * 64 + p;
            const float dt = expf(in_S5LDT[(l * 2 + d) * 16 + g]); const float ar = in_S5ARE[pi], ai = in_S5AIM[pi];
            const float m = expf(dt * ar); const float er = m * cosf(dt * ai) - 1.f, ei = m * sinf(dt * ai);
            const float den = 1.f / (ar * ar + ai * ai); const float cr = (er * ar + ei * ai) * den, ci = (ei * ar - er * ai) * den;
            const float br = in_S5BRE[(size_t)pi * 16 + h], bi = in_S5BIM[(size_t)pi * 16 + h];
            bb[i] = (f32x2){cr * br - ci * bi, cr * bi + ci * br}; }
        for (int i = F.tid; i < 2 * 16 * 64; i += NTHR) { const int d = i >> 10, h = (i >> 6) & 15, p = i & 63; const size_t ci = ((size_t)((l * 2 + d) * 16 + g) * 16 + h) * 64 + p;
            cc[i] = (f32x2){in_S5CRE[ci], in_S5CIM[ci]}; }
        __syncthreads();
        for (int i = F.tid; i < 2 * 32 * 256; i += NTHR) { const int d = i >> 13, tau = (i >> 8) & 31, h = (i >> 4) & 15, h2 = i & 15; float s = 0.f;
            for (int p = 0; p < 64; ++p) { const f32x2 c = cc[(d * 16 + h) * 64 + p], a = ap[(d * 33 + tau) * 64 + p], b = bb[(d * 64 + p) * 16 + h2];
                const float tr = c.x * a.x - c.y * a.y, ti = c.x * a.y + c.y * a.x; s += tr * b.x - ti * b.y; }
            kt[i] = s; }
        __syncthreads();
        bf16* MB = WSP(bf16, WS_S5MB) + (size_t)(l * 16 + g) * 768 * 512;
        bf16* CS = WSP(bf16, WS_S5CS) + (size_t)(l * 16 + g) * 512 * 256;
        for (int i = F.tid; i < 512 * 64; i += NTHR) { const int n = i >> 6, k8 = (i & 63) * 8, t = n >> 4, h = n & 15, s = k8 >> 4, h0 = k8 & 15; float v[8];
#pragma unroll
            for (int j = 0; j < 8; ++j) { float x = 0.f; if (t >= s) x += kt[((0 * 32 + (t - s)) * 16 + h) * 16 + h0 + j]; if (s >= t) x += kt[((1 * 32 + (s - t)) * 16 + h) * 16 + h0 + j];
                if (t == s && h == h0 + j) x += in_S5D[l * 256 + g * 16 + h]; v[j] = x; }
            *(GAS v4u*)(MB + (size_t)n * 512 + k8) = (v4u){pk2(v[0], v[1]), pk2(v[2], v[3]), pk2(v[4], v[5]), pk2(v[6], v[7])}; }
        for (int i = F.tid; i < 256 * 64; i += NTHR) { const int n = i >> 6, k8 = (i & 63) * 8, d = n >> 7, im = (n >> 6) & 1, p = n & 63, s = k8 >> 4, h0 = k8 & 15; float v[8];
            const f32x2 a = ap[(d * 33 + (d == 0 ? 31 - s : s)) * 64 + p];
#pragma unroll
            for (int j = 0; j < 8; ++j) { const f32x2 b = bb[(d * 64 + p) * 16 + h0 + j]; v[j] = im ? (a.x * b.y + a.y * b.x) : (a.x * b.x - a.y * b.y); }
            *(GAS v4u*)(MB + (size_t)(512 + n) * 512 + k8) = (v4u){pk2(v[0], v[1]), pk2(v[2], v[3]), pk2(v[4], v[5]), pk2(v[6], v[7])}; }
        for (int i = F.tid; i < 512 * 32; i += NTHR) { const int n = i >> 5, k8 = (i & 31) * 8, t = n >> 4, h = n & 15, d = k8 >> 7, im = (k8 >> 6) & 1, p0 = k8 & 63; float v[8];
#pragma unroll
            for (int j = 0; j < 8; ++j) { const f32x2 c = cc[(d * 16 + h) * 64 + p0 + j], a = ap[(d * 33 + (d == 0 ? t + 1 : 32 - t)) * 64 + p0 + j];
                v[j] = im ? -(c.x * a.y + c.y * a.x) : (c.x * a.x - c.y * a.y); }
            *(GAS v4u*)(CS + (size_t)n * 256 + k8) = (v4u){pk2(v[0], v[1]), pk2(v[2], v[3]), pk2(v[4], v[5]), pk2(v[6], v[7])}; }
        __syncthreads();
    }
}

__device__ __forceinline__ f32x2 cmul(f32x2 a, f32x2 b) { return (f32x2){a.x * b.x - a.y * b.y, a.x * b.y + a.y * b.x}; }
__device__ __forceinline__ f32x2 twid(int p, float invB) { const float x = (float)p * invB; return (f32x2){__builtin_amdgcn_cosf(x), -__builtin_amdgcn_sinf(x)}; }
template <bool INV> __device__ __forceinline__ void bfly(f32x2& a, f32x2& b, f32x2 w) {
    if (!INV) { const f32x2 s = a + b, d = a - b; a = s; b = cmul(d, w); }
    else { const f32x2 t = cmul(b, (f32x2){w.x, -w.y}); const f32x2 s = a + t, d = a - t; a = s; b = d; }
}
template <bool INV> __device__ __forceinline__ void fft_r8(LAS f32x2* buf, int B, int tid) {
    const int S = B >> 3; const float iB = 1.f / (float)B;
#pragma unroll 1
    for (int gi = tid; gi < 1024; gi += NTHR) {
        const int blk = gi / S, j = gi - blk * S, base = blk * B + j;
        f32x2 x[8];
#pragma unroll
        for (int k = 0; k < 8; ++k) x[k] = buf[base + k * S];
        if (!INV) {
#pragma unroll
            for (int k = 0; k < 4; ++k) bfly<false>(x[k], x[k + 4], twid(j + k * S, iB));
#pragma unroll
            for (int hh = 0; hh < 8; hh += 4)
#pragma unroll
                for (int k = 0; k < 2; ++k) bfly<false>(x[hh + k], x[hh + k + 2], twid(j + k * S, 2.f * iB));
            const f32x2 w = twid(j, 4.f * iB);
#pragma unroll
            for (int q = 0; q < 8; q += 2) bfly<false>(x[q], x[q + 1], w);
        } else {
            const f32x2 w = twid(j, 4.f * iB);
#pragma unroll
            for (int q = 0; q < 8; q += 2) bfly<true>(x[q], x[q + 1], w);
#pragma unroll
            for (int hh = 0; hh < 8; hh += 4)
#pragma unroll
                for (int k = 0; k < 2; ++k) bfly<true>(x[hh + k], x[hh + k + 2], twid(j + k * S, 2.f * iB));
#pragma unroll
            for (int k = 0; k < 4; ++k) bfly<true>(x[k], x[k + 4], twid(j + k * S, iB));
        }
#pragma unroll
        for (int k = 0; k < 8; ++k) buf[base + k * S] = x[k];
    }
    __syncthreads();
}
__device__ __forceinline__ void fft_r2(LAS f32x2* buf, int tid) {
    for (int i = tid; i < 4096; i += NTHR) { const f32x2 a = buf[2 * i], b = buf[2 * i + 1]; buf[2 * i] = a + b; buf[2 * i + 1] = a - b; }
    __syncthreads();
}
__device__ __forceinline__ void fft_fwd(LAS f32x2* buf, int tid) { fft_r8<false>(buf, 8192, tid); fft_r8<false>(buf, 1024, tid); fft_r8<false>(buf, 128, tid); fft_r8<false>(buf, 16, tid); fft_r2(buf, tid); }
__device__ __forceinline__ void fft_inv(LAS f32x2* buf, int tid) { fft_r2(buf, tid); fft_r8<true>(buf, 16, tid); fft_r8<true>(buf, 128, tid); fft_r8<true>(buf, 1024, tid); fft_r8<true>(buf, 8192, tid); }

constexpr float HY_DMIN = 3.0701134573253946f, HY_DMAX = 15.350567286626973f;
__device__ __forceinline__ float block_sum(float v, LAS float* red, int tid) {
    v = wave_sum(v); __syncthreads(); if ((tid & 63) == 0) red[tid >> 6] = v; __syncthreads();
    float s = 0.f;
#pragma unroll
    for (int w = 0; w < NWAVES; ++w) s += red[w];
    return s;
}
__device__ __forceinline__ void p0_filters(Frame& F) {
    const float* const in_HYSKIP = inptr(I_HYSKIP);
    const float* const in_HYW3 = inptr(I_HYW3);
    LAS f32x2* buf = (LAS f32x2*)F.lds; LAS float* w3s = (LAS float*)(F.lds + 65536); LAS float* red = w3s + 128;
    for (int unit = F.vcu; unit < DEPTH * 256; unit += F.G) {
        const int l = unit >> 8, c = unit & 255;
        if (F.tid < 128) w3s[F.tid] = in_HYW3[(size_t)l * 64 * 512 + (F.tid & 63) * 512 + (F.tid >> 6) * 256 + c];
        __syncthreads();
        const float decay = HY_DMIN + (HY_DMAX - HY_DMIN) * (float)c / 255.f;
        float asum = 0.f; float vals[16];
#pragma unroll 1
        for (int i = 0; i < 16; ++i) { const int n = F.tid + NTHR * i; float v = 0.f;
            if (n != SEQ) { const int pos = n < SEQ ? n : 2 * SEQ - n; const LAS float* w = w3s + (n < SEQ ? 0 : 64); const f32x4* hp = (const f32x4*)(WSP(float, WS_H2T) + ((size_t)l * SEQ + pos) * 64);
                float s = 0.f;
#pragma unroll
                for (int q = 0; q < 16; ++q) { const f32x4 h = hp[q]; s += h.x * w[4 * q] + h.y * w[4 * q + 1] + h.z * w[4 * q + 2] + h.w * w[4 * q + 3]; }
                v = s * expf(-((float)pos / (float)SEQ) * decay); }
            buf[n] = (f32x2){v, 0.f}; asum += fabsf(v); }
        (void)vals;
        const float tot = block_sum(asum, red, F.tid); const float nrm = 1.f / (tot + EPSF);
        for (int i = 0; i < 16; ++i) { const int n = F.tid + NTHR * i; f32x2 v = buf[n]; v.x = v.x * nrm + (n == 0 ? in_HYSKIP[l * 256 + c] : 0.f); buf[n] = v; }
        __syncthreads();
        fft_fwd(buf, F.tid);
        f32x2* dst = WSP(f32x2, WS_FSPEC) + (size_t)unit * 8192;
        for (int i = F.tid; i < 8192; i += NTHR) dst[i] = buf[i] * (1.f / 8192.f);
        __syncthreads();
    }
    LAS float* red2 = (LAS float*)(F.lds + 1024);
    LAS float* w3c = (LAS float*)F.lds;
    for (int unit = F.vcu; unit < DEPTH * 256; unit += F.G) {
        const int l = unit >> 8, c = unit & 255, n = F.tid;
        if (F.tid < 128) w3c[F.tid] = in_HYW3[(size_t)l * 64 * 512 + (F.tid & 63) * 512 + (F.tid >> 6) * 256 + c];
        __syncthreads();
        const float decay = HY_DMIN + (HY_DMAX - HY_DMIN) * (float)c / 255.f; float v = 0.f;
        if (n != CTXL) { const int pos = n < CTXL ? n : 2 * CTXL - n; const LAS float* w = w3c + (n < CTXL ? 0 : 64); const float* hp = WSP(float, WS_H2C) + ((size_t)l * CTXL + pos) * 64; float s = 0.f;
            for (int q = 0; q < 64; ++q) s += hp[q] * w[q];
            v = s * expf(-((float)pos / (float)CTXL) * decay); }
        const float tot = block_sum(fabsf(v), red2, F.tid);
        WSP(float, WS_FC)[(size_t)unit * 512 + n] = v / (tot + EPSF) + (n == 0 ? in_HYSKIP[l * 256 + c] : 0.f);
        __syncthreads();
    }
}
__device__ __forceinline__ float sconv(const bf16* P, int r0, int len, int t, int col, float w0, float w1, float w2, float bias) {
    const bf16* p = P + (size_t)(r0 + t) * INC + col;
    const float a = t > 0 ? bf2f(p[-INC]) : 0.f, b = bf2f(p[0]), c = t + 1 < len ? bf2f(p[INC]) : 0.f;
    return a * w0 + b * w1 + c * w2 + bias;
}
__device__ __forceinline__ void hyena_unit(Frame& F, int l, int unit) {
    const float* const in_HYCB = inptr(I_HYCB);
    const float* const in_HYCW = inptr(I_HYCW);
    LAS f32x2* buf = (LAS f32x2*)F.lds;
    const int c = unit >> 2, bp = unit & 3; const bf16* P = WSP(bf16, WS_P);
    const float* cw = in_HYCW + (size_t)l * 3 * 768; const float* cb = in_HYCB + (size_t)l * 768;
    const float a0 = cw[256 + c], a1 = cw[768 + 256 + c], a2 = cw[1536 + 256 + c], ab = cb[256 + c];
    const float v0 = cw[512 + c], v1 = cw[768 + 512 + c], v2 = cw[1536 + 512 + c], vb = cb[512 + c];
    for (int i = 0; i < 8; ++i) { const int t = F.tid + NTHR * i; float z[2];
#pragma unroll
        for (int q = 0; q < 2; ++q) { const int r0 = (2 * bp + q) * SEQ; z[q] = sconv(P, r0, SEQ, t, 256 + c, a0, a1, a2, ab) * sconv(P, r0, SEQ, t, 512 + c, v0, v1, v2, vb); }
        buf[t] = (f32x2){z[0], z[1]}; buf[SEQ + t] = (f32x2){0.f, 0.f}; }
    __syncthreads();
    fft_fwd(buf, F.tid);
    const f32x2* fs = WSP(f32x2, WS_FSPEC) + (size_t)(l * 256 + c) * 8192;
    for (int i = F.tid; i < 8192; i += NTHR) buf[i] = cmul(buf[i], fs[i]);
    __syncthreads();
    fft_inv(buf, F.tid);
    float* o0 = WSP(float, WS_HYW) + ((size_t)(2 * bp) * 256 + c) * SEQ; float* o1 = o0 + (size_t)256 * SEQ;
    for (int t = F.tid; t < SEQ; t += NTHR) { const f32x2 v = buf[t]; o0[t] = v.x; o1[t] = v.y; }
    __syncthreads();
}
__device__ __forceinline__ void hyena_ctx_unit(Frame& F, int l, int c) {
    const float* const in_HYCB = inptr(I_HYCB);
    const float* const in_HYCW = inptr(I_HYCW);
    LAS float* z = (LAS float*)F.lds; LAS float* fc = z + NB * CTXL; const bf16* P = WSP(bf16, WS_P);
    const float* cw = in_HYCW + (size_t)l * 3 * 768; const float* cb = in_HYCB + (size_t)l * 768;
    const float a0 = cw[256 + c], a1 = cw[768 + 256 + c], a2 = cw[1536 + 256 + c], ab = cb[256 + c];
    const float v0 = cw[512 + c], v1 = cw[768 + 512 + c], v2 = cw[1536 + 512 + c], vb = cb[512 + c];
    fc[F.tid] = WSP(float, WS_FC)[(size_t)(l * 256 + c) * 512 + F.tid];
    for (int i = F.tid; i < NB * CTXL; i += NTHR) { const int b = i >> 8, t = i & 255; const int r0 = ML + b * CTXL;
        z[i] = sconv(P, r0, CTXL, t, 256 + c, a0, a1, a2, ab) * sconv(P, r0, CTXL, t, 512 + c, v0, v1, v2, vb); }
    __syncthreads();
    for (int i = F.tid; i < NB * CTXL; i += NTHR) { const int b = i >> 8, t = i & 255; float s = 0.f;
        for (int k = 0; k < CTXL; ++k) s += fc[(t - k) & 511] * z[b * CTXL + k];
        WSP(float, WS_HYWC)[((size_t)b * 256 + c) * CTXL + t] = s; }
    __syncthreads();
}
__device__ __forceinline__ void hyena_fin_unit(Frame& F, int l, int unit) {
    const float* const in_HYCB = inptr(I_HYCB);
    const float* const in_HYCW = inptr(I_HYCW);
    const float* const in_HYNG = inptr(I_HYNG);
    LAS float* wt = (LAS float*)F.lds;
    const int r0 = unit * 64; const bool isc = r0 >= ML; const int b = isc ? (r0 - ML) / CTXL : r0 / SEQ; const int len = isc ? CTXL : SEQ;
    const int seq0 = isc ? ML + b * CTXL : b * SEQ, t0 = r0 - seq0;
    const float* src = isc ? WSP(float, WS_HYWC) + (size_t)b * 256 * CTXL : WSP(float, WS_HYW) + (size_t)b * 256 * SEQ;
    for (int i = F.tid; i < 256 * 16; i += NTHR) { const int c = i >> 4, q = i & 15; const f32x4 v = *(const f32x4*)(src + (size_t)c * len + t0 + 4 * q);
        wt[c * 65 + 4 * q] = v.x; wt[c * 65 + 4 * q + 1] = v.y; wt[c * 65 + 4 * q + 2] = v.z; wt[c * 65 + 4 * q + 3] = v.w; }
    __syncthreads();
    const bf16* P = WSP(bf16, WS_P); const float* cw = in_HYCW + (size_t)l * 3 * 768; const float* cb = in_HYCB + (size_t)l * 768;
    for (int tt = 0; tt < 8; ++tt) { const int tl = F.wave * 8 + tt, t = t0 + tl; float v[4]; float ss = 0.f;
#pragma unroll
        for (int j = 0; j < 4; ++j) { const int c = F.lane + 64 * j; const float x0 = sconv(P, seq0, len, t, c, cw[c], cw[768 + c], cw[1536 + c], cb[c]); v[j] = x0 * wt[c * 65 + tl]; ss += v[j] * v[j]; }
        const float rs = rsqrtf(wave_sum(ss) * (1.f / 256.f) + EPSF);
#pragma unroll
        for (int j = 0; j < 4; ++j) { const int c = F.lane + 64 * j; WSP(bf16, WS_MIX)[(size_t)(r0 + tl) * DM + c] = (bf16)f2bf(v[j] * rs * in_HYNG[l * 256 + c]); }
    }
    __syncthreads();
}

__device__ __forceinline__ void n1_phase(Frame& F, int l) {
    const float* const in_CTX = inptr(I_CTX);
    const float* const in_FING = inptr(I_FING);
    const float* const in_N1G = inptr(I_N1G);
    const float* const in_X = inptr(I_X);
    const int gw = F.vcu * NWAVES + F.wave, NGW = F.G * NWAVES;
    const int nblk = (l == DEPTH ? ML : MT) / 4;
    constexpr int NR = 4;
    for (int blk = gw; blk < nblk; blk += NGW) {
        const int r0 = blk * NR; const int bi = r0 < ML ? r0 >> 12 : 8;
        f32x4 v[NR][4];
        if (l == 0) {
#pragma unroll
            for (int k = 0; k < NR; ++k) { const int r = r0 + k; const float* src = r < ML ? in_X + (size_t)r * DM : in_CTX + (size_t)(r - ML) * DM;
#pragma unroll
                for (int j = 0; j < 4; ++j) v[k][j] = *(const f32x4*)(src + 4 * F.lane + 256 * j); }
        } else {
            const int* ts = (const int*)(F.ws + WS_TOK + TK_SLOT) + 2 * r0; int sl[2 * NR];
#pragma unroll
            for (int k = 0; k < 2 * NR; ++k) sl[k] = ts[k];
            const float* g2 = WSP(float, WS_MODV) + (size_t)((l - 1) * 9 + bi) * NMOD + 5 * DM;
            v2u ya[NR][4], yb[NR][4];
#pragma unroll
            for (int k = 0; k < NR; ++k) { const float* src = WSP(float, WS_X) + (size_t)(r0 + k) * DM; const bf16* pa = WSP(bf16, WS_YB) + (size_t)sl[2 * k] * DM; const bf16* pb = WSP(bf16, WS_YB) + (size_t)sl[2 * k + 1] * DM;
#pragma unroll
                for (int j = 0; j < 4; ++j) { const int c = 4 * F.lane + 256 * j; v[k][j] = *(const f32x4*)(src + c); ya[k][j] = *(const v2u*)(pa + c); yb[k][j] = *(const v2u*)(pb + c); } }
#pragma unroll
            for (int j = 0; j < 4; ++j) { const f32x4 g = *(const f32x4*)(g2 + 4 * F.lane + 256 * j);
#pragma unroll
                for (int k = 0; k < NR; ++k) { const v2u a = ya[k][j], b = yb[k][j];
                    v[k][j] = v[k][j] + g * (f32x4){bflo(a.x) + bflo(b.x), bfhi(a.x) + bfhi(b.x), bflo(a.y) + bflo(b.y), bfhi(a.y) + bfhi(b.y)}; } }
        }
        float rs[NR];
#pragma unroll
        for (int k = 0; k < NR; ++k) { float ss = 0.f;
#pragma unroll
            for (int j = 0; j < 4; ++j) ss += v[k][j].x * v[k][j].x + v[k][j].y * v[k][j].y + v[k][j].z * v[k][j].z + v[k][j].w * v[k][j].w;
            rs[k] = ss; }
#pragma unroll
        for (int k = 0; k < NR; ++k) rs[k] = rsqrtf(wave_sum(rs[k]) * (1.f / DM) + EPSF);
        if (l == DEPTH) {
#pragma unroll
            for (int j = 0; j < 4; ++j) { const int c = 4 * F.lane + 256 * j; const f32x4 fg = *(const f32x4*)(in_FING + c);
#pragma unroll
                for (int k = 0; k < NR; ++k) *(f32x4*)(F.out + (size_t)(r0 + k) * DM + c) = v[k][j] * rs[k] * fg; }
        } else {
            const float* mv = WSP(float, WS_MODV) + (size_t)(l * 9 + bi) * NMOD; const float* ng = in_N1G + l * DM;
#pragma unroll
            for (int j = 0; j < 4; ++j) { const int c = 4 * F.lane + 256 * j; const f32x4 am = *(const f32x4*)(ng + c) * (1.f + *(const f32x4*)(mv + DM + c)), sh = *(const f32x4*)(mv + c);
#pragma unroll
                for (int k = 0; k < NR; ++k) { *(f32x4*)(WSP(float, WS_X) + (size_t)(r0 + k) * DM + c) = v[k][j];
                    const f32x4 h = v[k][j] * rs[k] * am + sh;
                    *(v2u*)(WSP(bf16, WS_H) + (size_t)(r0 + k) * DM + c) = (v2u){pk2(h.x, h.y), pk2(h.z, h.w)}; } }
        }
    }
}
__device__ __forceinline__ void n2r_phase(Frame& F, int l) {
    const float* const in_MBE = inptr(I_MBE);
    const float* const in_MBG = inptr(I_MBG);
    const float* const in_N2G = inptr(I_N2G);
    const int rr = F.lane & 15, q = F.lane >> 4, w = F.wave;
    LAS int* lhist = (LAS int*)F.lds;
    LAS float* rsb = (LAS float*)(F.lds + 128);
    LAS float* modA = (LAS float*)(F.lds + 256);
    LAS float* modS = modA + 1024;
    LAS float* part = modS + 1024;
    if (F.tid < 32) lhist[F.tid] = 0;
    const bf16* wge = WSP(bf16, WS_WGE) + (size_t)l * 2 * 48 * 1024 + (size_t)rr * 1024 + 128 * w + 8 * q;
    bf16x8 wf[4][3][2];
#pragma unroll
    for (int c = 0; c < 4; ++c)
#pragma unroll
        for (int t = 0; t < 3; ++t)
#pragma unroll
            for (int hl = 0; hl < 2; ++hl) wf[c][t][hl] = *(const bf16x8*)(wge + (size_t)(hl * 48 + t * 16) * 1024 + 32 * c);
    const float* ng = in_N2G + l * DM;
#pragma unroll 1
    for (int it = 0; ; ++it) {
        const int grp = F.vcu + it * F.G; if (grp >= MT / 16) break;
        const int r0 = grp * 16, r = r0 + rr, par = it & 1; const int bi = r0 < ML ? r0 >> 12 : 8;
        const float* mv = WSP(float, WS_MODV) + (size_t)(l * 9 + bi) * NMOD;
        const float* xr = WSP(float, WS_X) + (size_t)r * DM + 128 * w + 8 * q; f32x4 xa[4], xb[4];
#pragma unroll
        for (int c = 0; c < 4; ++c) { xa[c] = *(const f32x4*)(xr + 32 * c); xb[c] = *(const f32x4*)(xr + 32 * c + 4); }
        { float s2[2];
#pragma unroll
          for (int k = 0; k < 2; ++k) { const float* xs = WSP(float, WS_X) + (size_t)(r0 + 2 * w + k) * DM + 4 * F.lane; float ss = 0.f;
#pragma unroll
              for (int j = 0; j < 4; ++j) { const f32x4 x = *(const f32x4*)(xs + 256 * j); ss += x.x * x.x + x.y * x.y + x.z * x.z + x.w * x.w; }
              s2[k] = ss; }
          if (F.tid < 256) { const int c = 4 * F.tid; *(LAS f32x4*)(modA + c) = *(const f32x4*)(ng + c) * (1.f + *(const f32x4*)(mv + 4 * DM + c)); *(LAS f32x4*)(modS + c) = *(const f32x4*)(mv + 3 * DM + c); }
#pragma unroll
          for (int k = 0; k < 2; ++k) { const float t = wave_sum(s2[k]); if (F.lane == 0) rsb[2 * w + k] = rsqrtf(t * (1.f / DM) + EPSF); } }
        __syncthreads();
        const float rs = rsb[rr];
        f32x4 d0 = {0.f, 0.f, 0.f, 0.f}, d1 = d0, d2 = d0;
        bf16* hrow = WSP(bf16, WS_H) + (size_t)r * DM + 128 * w + 8 * q;
#pragma unroll
        for (int c = 0; c < 4; ++c) { const int col = 128 * w + 32 * c + 8 * q;
            const f32x4 h0 = xa[c] * rs * *(LAS f32x4*)(modA + col) + *(LAS f32x4*)(modS + col);
            const f32x4 h1 = xb[c] * rs * *(LAS f32x4*)(modA + col + 4) + *(LAS f32x4*)(modS + col + 4);
            const v4u hh = {pk2(h0.x, h0.y), pk2(h0.z, h0.w), pk2(h1.x, h1.y), pk2(h1.z, h1.w)};
            *(GAS v4u*)(hrow + 32 * c) = hh;
            const v4u hl = {pk2(h0.x - bflo(hh.x), h0.y - bfhi(hh.x)), pk2(h0.z - bflo(hh.y), h0.w - bfhi(hh.y)), pk2(h1.x - bflo(hh.z), h1.y - bfhi(hh.z)), pk2(h1.z - bflo(hh.w), h1.w - bfhi(hh.w))};
            const bf16x8 bh = __builtin_bit_cast(bf16x8, hh), bl = __builtin_bit_cast(bf16x8, hl);
            d0 = __builtin_amdgcn_mfma_f32_16x16x32_bf16(wf[c][0][0], bh, d0, 0, 0, 0); d1 = __builtin_amdgcn_mfma_f32_16x16x32_bf16(wf[c][1][0], bh, d1, 0, 0, 0); d2 = __builtin_amdgcn_mfma_f32_16x16x32_bf16(wf[c][2][0], bh, d2, 0, 0, 0);
            d0 = __builtin_amdgcn_mfma_f32_16x16x32_bf16(wf[c][0][0], bl, d0, 0, 0, 0); d1 = __builtin_amdgcn_mfma_f32_16x16x32_bf16(wf[c][1][0], bl, d1, 0, 0, 0); d2 = __builtin_amdgcn_mfma_f32_16x16x32_bf16(wf[c][2][0], bl, d2, 0, 0, 0);
            d0 = __builtin_amdgcn_mfma_f32_16x16x32_bf16(wf[c][0][1], bh, d0, 0, 0, 0); d1 = __builtin_amdgcn_mfma_f32_16x16x32_bf16(wf[c][1][1], bh, d1, 0, 0, 0); d2 = __builtin_amdgcn_mfma_f32_16x16x32_bf16(wf[c][2][1], bh, d2, 0, 0, 0); }
        { LAS float* pp = part + ((par * 8 + w) * 12) * 64 + F.lane;
          pp[0] = d0.x; pp[64] = d0.y; pp[128] = d0.z; pp[192] = d0.w; pp[256] = d1.x; pp[320] = d1.y; pp[384] = d1.z; pp[448] = d1.w; pp[512] = d2.x; pp[576] = d2.y; pp[640] = d2.z; pp[704] = d2.w; }
        __syncthreads();
        if (w == 0) {
            float dd[12];
#pragma unroll
            for (int i = 0; i < 12; ++i) { float s = 0.f;
#pragma unroll
                for (int ww = 0; ww < 8; ++ww) s += part[((par * 8 + ww) * 12 + i) * 64 + F.lane];
                dd[i] = s; }
            int G = 0; float pg = 0.f;
            { const float g0 = dd[8] + in_MBG[l * 4], g1 = dd[9] + in_MBG[l * 4 + 1], g2 = dd[10] + in_MBG[l * 4 + 2], g3 = dd[11] + in_MBG[l * 4 + 3]; float m = g0; G = 0;
              if (g1 > m) { m = g1; G = 1; } if (g2 > m) { m = g2; G = 2; } if (g3 > m) { m = g3; G = 3; }
              pg = 1.f / (fexp(g0 - m) + fexp(g1 - m) + fexp(g2 - m) + fexp(g3 - m)); }
            G = __builtin_amdgcn_ds_bpermute(rr << 2, G);
            const bool hiT = (G >> 1) != 0;
            float ev[8];
#pragma unroll
            for (int j = 0; j < 8; ++j) { const int src = rr + 16 * (2 * (G & 1) + (j >> 2)); const float x = hiT ? dd[4 + (j & 3)] : dd[j & 3];
                ev[j] = __builtin_bit_cast(float, __builtin_amdgcn_ds_bpermute(src << 2, __builtin_bit_cast(int, x))); }
            if (q == 0) {
#pragma unroll
                for (int j = 0; j < 8; ++j) ev[j] += in_MBE[l * 32 + G * 8 + j];
                int ia = 0; float ma = ev[0];
#pragma unroll
                for (int j = 1; j < 8; ++j) if (ev[j] > ma) { ma = ev[j]; ia = j; }
                int ib = -1; float mb = -3.0e38f;
#pragma unroll
                for (int j = 0; j < 8; ++j) if (j != ia && ev[j] > mb) { mb = ev[j]; ib = j; }
                const float eb = fexp(mb - ma); const float ga = pg / (1.f + eb), gb = pg * eb / (1.f + eb);
                const int ea = G * 8 + ia, eb_ = G * 8 + ib;
                const int pa = __hip_atomic_fetch_add(lhist + ea, 1, __ATOMIC_RELAXED, __HIP_MEMORY_SCOPE_WORKGROUP), pb = __hip_atomic_fetch_add(lhist + eb_, 1, __ATOMIC_RELAXED, __HIP_MEMORY_SCOPE_WORKGROUP);
                int* te = (int*)(F.ws + WS_TOK + TK_E) + 2 * r; int* tp = (int*)(F.ws + WS_TOK + TK_POS) + 2 * r; float* tg = (float*)(F.ws + WS_TOK + TK_GATE) + 2 * r;
                te[0] = ea; te[1] = eb_; tp[0] = pa; tp[1] = pb; tg[0] = ga; tg[1] = gb;
            }
        }
    }
    __syncthreads();
    if (F.tid < 32) ((int*)(F.ws + WS_TOK + TK_HIST))[F.vcu * 32 + F.tid] = lhist[F.tid];
    __syncthreads();
}
__device__ __forceinline__ void assign_phase(Frame& F, int l) {
    LAS int* base = (LAS int*)F.lds;
    LAS int* ps = base + 256 * 32;
    const int* hist = (const int*)(F.ws + WS_TOK + TK_HIST);
    if (F.tid < 32) { int c = 0; for (int w = 0; w < F.G; ++w) c += hist[w * 32 + F.tid]; ps[32 + F.tid] = c; }
    __syncthreads();
    if (F.tid == 0) { int acc = 0; for (int e = 0; e < NEXP; ++e) { ps[e] = acc; acc += (ps[32 + e] + 255) / 256 * 256; } ps[64] = acc; }
    __syncthreads();
    if (F.tid < 32) { int acc = ps[F.tid]; for (int w = 0; w < F.G; ++w) { base[w * 32 + F.tid] = acc; acc += hist[w * 32 + F.tid]; } }
    __syncthreads();
    int* stok = (int*)(F.ws + WS_TOK + TK_STOK); float* sgate = (float*)(F.ws + WS_TOK + TK_SGATE); int* tslot = (int*)(F.ws + WS_TOK + TK_SLOT);
    const int* te = (const int*)(F.ws + WS_TOK + TK_E); const int* tp = (const int*)(F.ws + WS_TOK + TK_POS); const float* tg = (const float*)(F.ws + WS_TOK + TK_GATE);
    for (int i = F.vcu * NTHR + F.tid; i < MT * 2; i += F.G * NTHR) { const int r = i >> 1, w = (r >> 4) % F.G;
        const int dest = base[w * 32 + te[i]] + tp[i]; stok[dest] = r; sgate[dest] = tg[i]; tslot[i] = dest; }
    for (int i = F.vcu * NTHR + F.tid; i < NEXP * 256; i += F.G * NTHR) { const int e = i >> 8, j = i & 255, c = ps[32 + e], rem = c & 255;
        if (rem != 0 && j >= rem) { const int dest = ps[e] + (c & ~255) + j; stok[dest] = MT; sgate[dest] = 0.f; } }
    if (F.bx == 0) { int* tile_e = (int*)(F.ws + WS_TOK + TK_TILEE); const int nt = ps[64] / 256;
        for (int t = F.tid; t < nt; t += NTHR) { int e = 0; for (int k = 1; k < NEXP; ++k) if (t * 256 >= ps[k]) e = k; tile_e[t] = e; }
        if (F.tid == 0) __hip_atomic_store(F.ctl + CW_NTILES + l, (unsigned)nt, RLX_AGENT); }
    __syncthreads();
}
__device__ __forceinline__ void s5_scan_phase(Frame& F, int l) {
    const float* const in_S5AIM = inptr(I_S5AIM);
    const float* const in_S5ARE = inptr(I_S5ARE);
    const float* const in_S5LDT = inptr(I_S5LDT);
    const int item = F.vcu * NTHR + F.tid; if (item >= NB * 16 * 2 * 64) return;
    const int p = item & 63, d = (item >> 6) & 1, g = (item >> 7) & 15, b = item >> 11;
    const int pi = ((l * 2 + d) * 16 + g) * 64 + p; const float dt = expf(in_S5LDT[(l * 2 + d) * 16 + g]);
    const float m = expf(32.f * dt * in_S5ARE[pi]), ang = 32.f * dt * in_S5AIM[pi]; const float ar = m * cosf(ang), ai = m * sinf(ang);
    const float* ST = WSP(float, WS_ST) + (size_t)g * S5RP * 256 + d * 128 + p; bf16* HIN = WSP(bf16, WS_HIN) + (size_t)g * S5RP * 256 + d * 128 + p;
    float hr = 0.f, hi = 0.f;
#pragma unroll 1
    for (int s0 = 0; s0 < 136; s0 += 8) {
        float sr[8], si[8]; int rows[8];
#pragma unroll
        for (int k = 0; k < 8; ++k) { const int step = s0 + k; int row;
            if (d == 0) row = step < 8 ? 1024 + b * 8 + step : b * 128 + (step - 8);
            else row = step < 8 ? 1024 + b * 8 + (7 - step) : b * 128 + (135 - step);
            rows[k] = row; sr[k] = ST[(size_t)row * 256]; si[k] = ST[(size_t)row * 256 + 64]; }
#pragma unroll
        for (int k = 0; k < 8; ++k) { HIN[(size_t)rows[k] * 256] = (bf16)f2bf(hr); HIN[(size_t)rows[k] * 256 + 64] = (bf16)f2bf(hi);
            const float nr = ar * hr - ai * hi + sr[k], ni = ar * hi + ai * hr + si[k]; hr = nr; hi = ni; }
    }
}

struct ListOrder {
    int n, per, ncol, rowmul, colmul, G, c;
    __device__ __forceinline__ bool next(int i, pg8::Unit& u) const { const int L = i * G + c; if (L >= n) return false; const int a = L / per, r = L - a * per; u.pm = rowmul * a + r / ncol; u.pn = colmul * a + r % ncol; return true; }
    __device__ __forceinline__ void a_ready(const pg8::Unit&) const {}
    __device__ __forceinline__ void done(const pg8::Unit&) const {}
};
struct MoeOrder {
    const int* tile_e; int ntiles, G, c;
    __device__ __forceinline__ bool next(int i, pg8::Unit& u) const { const int L = i * G + c; if (L >= ntiles * 4) return false; const int t = L >> 2; u.pm = t; u.pn = tile_e[t] * 4 + (L & 3); return true; }
    __device__ __forceinline__ void a_ready(const pg8::Unit&) const {}
    __device__ __forceinline__ void done(const pg8::Unit&) const {}
};
using pg8::Unit; using pg8::HALF; using pg8::BM;
#define EPI_ROWS_BEGIN  _Pragma("unroll") for (int ai = 0; ai < 2; ++ai) _Pragma("unroll") for (int m = 0; m < 4; ++m) { const int row = u.pm * BM + ai * HALF + wr * 64 + m * 16 + fr;
#define EPI_ROWS_END asm volatile("" ::: "memory"); }
__device__ __forceinline__ v4u pack8(const f32x4 a, const f32x4 b) { return (v4u){pk2(a.x, a.y), pk2(a.z, a.w), pk2(b.x, b.y), pk2(b.z, b.w)}; }
struct EpiG1 {
    static constexpr bool PERM = true, AFTER_DRAIN = false;
    bf16* P; bf16* QR; bf16* U5; const f32x2* rope;
    __device__ __forceinline__ void operator()(const f32x4 (&acc)[2][2][4][2], const Unit& u, int wr, int wc, int fr, int fq) const {
        const int pn = u.pn; const bool lat = u.pm < ML / BM;
        EPI_ROWS_BEGIN
#pragma unroll
            for (int bj = 0; bj < 2; ++bj) { const int cl = bj * HALF + wc * 32 + 8 * fq, col = pn * BM + cl; const f32x4 v0 = acc[ai][bj][m][0], v1 = acc[ai][bj][m][1];
                if (pn == 3) { const int g = cl >> 4, h0 = cl & 15; *(GAS v4u*)(U5 + ((size_t)g * S5RP + (row >> 5)) * 512 + (row & 31) * 16 + h0) = pack8(v0, v1); }
                else if (pn >= 4 && pn < 8) {
                    const bool isq = pn < 6;
                    if (isq || !lat) *(GAS v4u*)(P + (size_t)row * INC + col) = pack8(v0, v1);
                    if (lat) { const int j0 = (cl & 63) >> 1; const f32x4* rp = (const f32x4*)(rope + (size_t)(row & (SEQ - 1)) * 32 + j0); const f32x4 c0 = rp[0], c1 = rp[1];
                        const f32x4 r0 = {v0.x * c0.x - v0.y * c0.y, v0.x * c0.y + v0.y * c0.x, v0.z * c0.z - v0.w * c0.w, v0.z * c0.w + v0.w * c0.z};
                        const f32x4 r1 = {v1.x * c1.x - v1.y * c1.y, v1.x * c1.y + v1.y * c1.x, v1.z * c1.z - v1.w * c1.w, v1.z * c1.w + v1.w * c1.z};
                        if (isq) *(GAS v4u*)(QR + (size_t)row * 512 + (col - C_Q)) = pack8(r0, r1); else *(GAS v4u*)(P + (size_t)row * INC + col) = pack8(r0, r1); }
                } else *(GAS v4u*)(P + (size_t)row * INC + col) = pack8(v0, v1);
            }
        EPI_ROWS_END
    }
};
struct EpiG2 {
    static constexpr bool PERM = false, AFTER_DRAIN = false;
    float* X; const float* modv_l;
    __device__ __forceinline__ void operator()(const f32x4 (&acc)[2][2][4][2], const Unit& u, int wr, int wc, int fr, int fq) const {
        const int bi = u.pm < ML / BM ? u.pm >> 4 : 8; const float* g1 = modv_l + (size_t)bi * NMOD + 2 * DM; const int col0 = u.pn * BM + wc * 32 + 4 * fq;
        f32x4 gv[2][2];
#pragma unroll
        for (int bj = 0; bj < 2; ++bj)
#pragma unroll
            for (int n = 0; n < 2; ++n) gv[bj][n] = *(const f32x4*)(g1 + col0 + bj * HALF + n * 16);
        EPI_ROWS_BEGIN
            float* xr = X + (size_t)row * DM + col0;
#pragma unroll
            for (int bj = 0; bj < 2; ++bj)
#pragma unroll
                for (int n = 0; n < 2; ++n) { f32x4* p = (f32x4*)(xr + bj * HALF + n * 16); *p = *p + gv[bj][n] * acc[ai][bj][m][n]; }
        EPI_ROWS_END
    }
};
struct EpiUp {
    static constexpr bool PERM = true, AFTER_DRAIN = false;
    bf16* HID;
    __device__ __forceinline__ void operator()(const f32x4 (&acc)[2][2][4][2], const Unit& u, int wr, int wc, int fr, int fq) const {
        const int col = (u.pn & 3) * 128 + wc * 32 + 8 * fq;
        EPI_ROWS_BEGIN
            f32x4 o[2];
#pragma unroll
            for (int n = 0; n < 2; ++n) { const f32x4 a = acc[ai][0][m][n], b = acc[ai][1][m][n]; o[n] = (f32x4){fsilu(a.x) * b.x, fsilu(a.y) * b.y, fsilu(a.z) * b.z, fsilu(a.w) * b.w}; }
            *(GAS v4u*)(HID + (size_t)row * EHID + col) = pack8(o[0], o[1]);
        EPI_ROWS_END
    }
};
struct EpiDown {
    static constexpr bool PERM = true, AFTER_DRAIN = false;
    bf16* YB; const float* sgate;
    __device__ __forceinline__ void operator()(const f32x4 (&acc)[2][2][4][2], const Unit& u, int wr, int wc, int fr, int fq) const {
        EPI_ROWS_BEGIN
            const float gt = sgate[row];
#pragma unroll
            for (int bj = 0; bj < 2; ++bj) *(GAS v4u*)(YB + (size_t)row * DM + (u.pn & 3) * BM + bj * HALF + wc * 32 + 8 * fq) = pack8(acc[ai][bj][m][0] * gt, acc[ai][bj][m][1] * gt);
        EPI_ROWS_END
    }
};
struct EpiS5i {
    static constexpr bool PERM = true, AFTER_DRAIN = false;
    float* YI; float* ST;
    __device__ __forceinline__ void operator()(const f32x4 (&acc)[2][2][4][2], const Unit& u, int wr, int wc, int fr, int fq) const {
        const int g = u.pm / 5, i5 = u.pm - 5 * g, j = u.pn - 3 * g;
        EPI_ROWS_BEGIN
            const int cr = row - g * S5RP; (void)i5;
#pragma unroll
            for (int bj = 0; bj < 2; ++bj) { const int cl = bj * HALF + wc * 32 + 8 * fq; float* dst;
                if (j < 2) { const int n = j * BM + cl; dst = YI + ((size_t)cr * 32 + (n >> 4)) * 256 + g * 16 + (n & 15); } else dst = ST + ((size_t)g * S5RP + cr) * 256 + cl;
                *(f32x4*)dst = acc[ai][bj][m][0]; *(f32x4*)(dst + 4) = acc[ai][bj][m][1]; }
        EPI_ROWS_END
    }
};
struct EpiS5c {
    static constexpr bool PERM = true, AFTER_DRAIN = false;
    const float* YI; bf16* GY;
    __device__ __forceinline__ void operator()(const f32x4 (&acc)[2][2][4][2], const Unit& u, int wr, int wc, int fr, int fq) const {
        const int g = u.pm / 5, j = u.pn - 2 * g;
        EPI_ROWS_BEGIN
            const int cr = row - g * S5RP;
#pragma unroll
            for (int bj = 0; bj < 2; ++bj) { const int n = j * BM + bj * HALF + wc * 32 + 8 * fq; const size_t o = ((size_t)cr * 32 + (n >> 4)) * 256 + g * 16 + (n & 15);
                const f32x4 y0 = acc[ai][bj][m][0] + *(const f32x4*)(YI + o), y1 = acc[ai][bj][m][1] + *(const f32x4*)(YI + o + 4);
                *(GAS v4u*)(GY + o) = pack8((f32x4){fgelu_tanh(y0.x), fgelu_tanh(y0.y), fgelu_tanh(y0.z), fgelu_tanh(y0.w)}, (f32x4){fgelu_tanh(y1.x), fgelu_tanh(y1.y), fgelu_tanh(y1.z), fgelu_tanh(y1.w)}); }
        EPI_ROWS_END
    }
};
struct EpiGlu {
    static constexpr bool PERM = true, AFTER_DRAIN = true;
    const bf16* GY; bf16* MIX; const float* ng;
    __device__ __forceinline__ void fused(f32x4 (&acc)[2][2][4][2], const Unit& u, int wr, int wc, int fr, int fq, PG8_LAS unsigned char* lds, int wid, int lane) const {
        PG8_LAS float* part = (PG8_LAS float*)lds;
        EPI_ROWS_BEGIN
            float ss = 0.f;
#pragma unroll
            for (int bj = 0; bj < 2; ++bj) { const int col = bj * HALF + wc * 32 + 8 * fq; const v4u gw = *(const GAS v4u*)(GY + (size_t)row * 256 + col);
                const f32x4 g0 = {bflo(gw.x), bfhi(gw.x), bflo(gw.y), bfhi(gw.y)}, g1 = {bflo(gw.z), bfhi(gw.z), bflo(gw.w), bfhi(gw.w)};
                f32x4& a0 = acc[ai][bj][m][0]; f32x4& a1 = acc[ai][bj][m][1];
                a0 = (f32x4){g0.x * fsigmoid(a0.x), g0.y * fsigmoid(a0.y), g0.z * fsigmoid(a0.z), g0.w * fsigmoid(a0.w)};
                a1 = (f32x4){g1.x * fsigmoid(a1.x), g1.y * fsigmoid(a1.y), g1.z * fsigmoid(a1.z), g1.w * fsigmoid(a1.w)};
                ss += a0.x * a0.x + a0.y * a0.y + a0.z * a0.z + a0.w * a0.w + a1.x * a1.x + a1.y * a1.y + a1.z * a1.z + a1.w * a1.w; }
            ss = xor_add<16>(ss); ss = xor_add<32>(ss);
            if (fq == 0) part[(ai * HALF + wr * 64 + m * 16 + fr) * 4 + wc] = ss;
        EPI_ROWS_END
        asm volatile("s_waitcnt lgkmcnt(0)" ::: "memory"); __builtin_amdgcn_s_barrier(); asm volatile("" ::: "memory");
        EPI_ROWS_BEGIN
            const int lr = ai * HALF + wr * 64 + m * 16 + fr; const f32x4 pp = *(PG8_LAS f32x4*)(part + lr * 4); const float rs = rsqrtf((pp.x + pp.y + pp.z + pp.w) * (1.f / 256.f) + EPSF);
#pragma unroll
            for (int bj = 0; bj < 2; ++bj) { const int col = bj * HALF + wc * 32 + 8 * fq; const f32x4 n0 = *(const f32x4*)(ng + col), n1 = *(const f32x4*)(ng + col + 4);
                *(GAS v4u*)(MIX + (size_t)row * DM + 256 + col) = pack8(acc[ai][bj][m][0] * rs * n0, acc[ai][bj][m][1] * rs * n1); }
        EPI_ROWS_END
        asm volatile("s_waitcnt lgkmcnt(0)" ::: "memory"); __builtin_amdgcn_s_barrier(); asm volatile("" ::: "memory");
    }
};

namespace att {
constexpr int KVBLK = 64, QBLK = 32;
constexpr int SHM_V = KVBLK * 128 * 2, SHM_K = KVBLK * 128 * 2;
constexpr float SCALE = 0.125f, THR = 8.f;
#define KSWZ(row, colB) ((row) * 256 + ((colB) ^ (((row) & 7) << 4)))
#define SBAR() __builtin_amdgcn_sched_barrier(0)
__device__ __forceinline__ int crow(int r, int hi) { return (r & 3) + 8 * (r >> 2) + 4 * hi; }
__device__ __forceinline__ unsigned cvtpk(float lo, float hi) { unsigned r; asm volatile("v_cvt_pk_bf16_f32 %0, %1, %2" : "=v"(r) : "v"(lo), "v"(hi)); return r; }
__device__ __forceinline__ void partialSM(f32x16& p0, f32x16& p1, float& m_reg, float& mn, float& alpha) {
  constexpr float C = SCALE * 1.4426950408889634f;
  float pmax = p0[0];
#pragma unroll
  for (int r = 1; r < 16; ++r) pmax = fmaxf(pmax, p0[r]);
#pragma unroll
  for (int r = 0; r < 16; ++r) pmax = fmaxf(pmax, p1[r]);
  { auto rr = __builtin_amdgcn_permlane32_swap(__float_as_uint(pmax), __float_as_uint(pmax), false, false);
    pmax = fmaxf(__uint_as_float(rr[0]), __uint_as_float(rr[1])); }
  if (__builtin_expect(__all(pmax - m_reg <= THR / SCALE), 1)) { mn = m_reg; alpha = 1.f; }
  else { mn = fmaxf(m_reg, pmax); alpha = __builtin_amdgcn_exp2f((m_reg - mn) * C); m_reg = mn; }
  float mnC = -mn * C;
#pragma unroll
  for (int r = 0; r < 16; ++r) p0[r] = fmaf(p0[r], C, mnC);
#pragma unroll
  for (int r = 0; r < 16; ++r) p1[r] = fmaf(p1[r], C, mnC);
#pragma unroll
  for (int r = 0; r < 16; ++r) p0[r] = __builtin_amdgcn_exp2f(p0[r]);
}
__device__ __forceinline__ void finishSM(f32x16& p0, f32x16& p1, float alpha, float& l_reg, bf16x8& pa0, bf16x8& pa1, bf16x8& pa2, bf16x8& pa3) {
#pragma unroll
  for (int r = 0; r < 16; ++r) p1[r] = __builtin_amdgcn_exp2f(p1[r]);
  float ps = 0;
#pragma unroll
  for (int r = 0; r < 16; ++r) ps += p0[r];
#pragma unroll
  for (int r = 0; r < 16; ++r) ps += p1[r];
  { auto rr = __builtin_amdgcn_permlane32_swap(__float_as_uint(ps), __float_as_uint(ps), false, false);
    ps = __uint_as_float(rr[0]) + __uint_as_float(rr[1]); }
  l_reg = l_reg * alpha + ps;
#define PK4(P, BASE, OUT) do { unsigned a0 = cvtpk(P[BASE + 0], P[BASE + 1]), a1 = cvtpk(P[BASE + 2], P[BASE + 3]);   \
    unsigned b0 = cvtpk(P[BASE + 4], P[BASE + 5]), b1 = cvtpk(P[BASE + 6], P[BASE + 7]);                              \
    auto r0 = __builtin_amdgcn_permlane32_swap(a0, b0, false, false); auto r1 = __builtin_amdgcn_permlane32_swap(a1, b1, false, false); \
    v4u w = {r0[0], r1[0], r0[1], r1[1]}; OUT = __builtin_bit_cast(bf16x8, w); } while (0)
  PK4(p0, 0, pa0); PK4(p0, 8, pa1); PK4(p1, 0, pa2); PK4(p1, 8, pa3);
#undef PK4
}
__device__ __forceinline__ void qkt(f32x16& p0, f32x16& p1, const LAS char* Ks, const bf16x8* qr, int r32, int hi, int sub) {
  p0 = f32x16{}; p1 = f32x16{};
#pragma unroll
  for (int d0 = 0; d0 < 4; ++d0) { const int cb = sub * 128 + (d0 * 16 + hi * 8) * 2;
    const bf16x8 b0 = *(const LAS bf16x8*)(Ks + KSWZ(r32, cb));
    const bf16x8 b1 = *(const LAS bf16x8*)(Ks + KSWZ(32 + r32, cb));
    p0 = __builtin_amdgcn_mfma_f32_32x32x16_bf16(b0, qr[d0], p0, 0, 0, 0);
    p1 = __builtin_amdgcn_mfma_f32_32x32x16_bf16(b1, qr[d0], p1, 0, 0, 0); }
}
__device__ __forceinline__ int v_st(int k, int c) { const int kk = (k & ~0xC) | ((k & 4) << 1) | ((k & 8) >> 1); return ((kk >> 3) * 4 + (c >> 5)) * 512 + ((kk & 7) * 32 + (c & 31)) * 2; }
__device__ __forceinline__ int v_rd_base(int lane) { return ((lane & 3) << 3) | (((lane >> 2) & 3) << 6) | (((lane >> 4) & 1) << 5) | (((lane >> 5) & 1) << 8); }
constexpr int v_rd_off(int d0, int ks, int half) { return d0 * 512 + ks * 4096 + half * 2048; }
template <int OFF> __device__ __forceinline__ s16x4 tr_read(int vb) { s16x4 r; asm volatile("ds_read_b64_tr_b16 %0, %1 offset:%2" : "=&v"(r) : "v"(vb), "i"(OFF) : "memory"); return r; }
template <int D0> __device__ __forceinline__ void pv_one(f32x16& od, int vb, bf16x8 pa0, bf16x8 pa1, bf16x8 pa2, bf16x8 pa3) {
  const s16x4 l0 = tr_read<v_rd_off(D0, 0, 0)>(vb), h0 = tr_read<v_rd_off(D0, 0, 1)>(vb), l1 = tr_read<v_rd_off(D0, 1, 0)>(vb), h1 = tr_read<v_rd_off(D0, 1, 1)>(vb);
  const s16x4 l2 = tr_read<v_rd_off(D0, 2, 0)>(vb), h2 = tr_read<v_rd_off(D0, 2, 1)>(vb), l3 = tr_read<v_rd_off(D0, 3, 0)>(vb), h3 = tr_read<v_rd_off(D0, 3, 1)>(vb);
  asm volatile("s_waitcnt lgkmcnt(0)" ::: "memory"); SBAR();
#define PK(L, H) (bf16x8){L[0], L[1], L[2], L[3], H[0], H[1], H[2], H[3]}
  od = __builtin_amdgcn_mfma_f32_32x32x16_bf16(pa0, PK(l0, h0), od, 0, 0, 0);
  od = __builtin_amdgcn_mfma_f32_32x32x16_bf16(pa1, PK(l1, h1), od, 0, 0, 0);
  od = __builtin_amdgcn_mfma_f32_32x32x16_bf16(pa2, PK(l2, h2), od, 0, 0, 0);
  od = __builtin_amdgcn_mfma_f32_32x32x16_bf16(pa3, PK(l3, h3), od, 0, 0, 0);
#undef PK
}
__device__ __forceinline__ void pv_d0(f32x16* o, int vb, bf16x8 pa0, bf16x8 pa1, bf16x8 pa2, bf16x8 pa3) {
  pv_one<0>(o[0], vb, pa0, pa1, pa2, pa3); pv_one<1>(o[1], vb, pa0, pa1, pa2, pa3); pv_one<2>(o[2], vb, pa0, pa1, pa2, pa3); pv_one<3>(o[3], vb, pa0, pa1, pa2, pa3);
}
__device__ __forceinline__ void attn_unit(LAS char* lds, const bf16* P, const bf16* QR, bf16* MIX, const float* subln, float lam, float oml, int unit, int tid_) {
  asm volatile("" : "+v"(tid_));
  const int tid = tid_, wid = tid >> 6, lane = tid & 63, r32 = lane & 31, hi = lane >> 5, sub = wid >> 2, wq = wid & 3;
  const bool isl = unit < 1024; int b, h, q0;
  if (isl) { const int bh = unit >> 5; b = bh >> 2; h = bh & 3; q0 = b * SEQ + (unit & 31) * 128; } else { const int u2 = unit - 1024, bh = u2 >> 1; b = bh >> 2; h = bh & 3; q0 = ML + b * CTXL + (u2 & 1) * 128; }
  const int NT = isl ? 68 : 4; const int crow0 = ML + b * CTXL, lrow0 = b * SEQ;
  LAS char* V_lds = lds; LAS char* K_lds = lds + 2 * SHM_V;
  LAS float* ws = (LAS float*)(lds + 2 * SHM_V + 2 * SHM_K) + wid * 64; LAS float* li_l = ws; LAS float* al_l = ws + 32;
  float m_reg = -1e30f, l_reg = 0; f32x16 o[4] = {}; bf16x8 qr[4];
  const int qrow = q0 + wq * QBLK + r32;
  { const bf16* Qw = P + (size_t)qrow * INC + C_Q + h * 128 + sub * 64 + hi * 8;
#pragma unroll
    for (int d0 = 0; d0 < 4; ++d0) qr[d0] = *(const bf16x8*)(Qw + d0 * 16); }
  const int sr = tid >> 4, sc = (tid & 15) * 8, vst0 = v_st(sr, sc), vst1 = v_st(32 + sr, sc);
  const int vb0 = (int)(unsigned long)V_lds + v_rd_base(lane);
  const bf16* Kc = P + C_K + h * 128 + sc; const bf16* Vc = P + C_V + h * 128 + sc;
  struct { bf16x8 vs0, vs1, ks0, ks1; } sr_[2];
#define TROW(j) (((j) < 4 ? crow0 + (j) * 64 : lrow0 + ((j) - 4) * 64) + sr)
#define SLOAD(i, j) do { const size_t _r = (size_t)TROW(j) * INC; sr_[i].vs0 = *(const bf16x8*)(Vc + _r); sr_[i].vs1 = *(const bf16x8*)(Vc + _r + (size_t)32 * INC); \
    sr_[i].ks0 = *(const bf16x8*)(Kc + _r); sr_[i].ks1 = *(const bf16x8*)(Kc + _r + (size_t)32 * INC); } while (0)
#define SWRITE(bb, i) do { *(LAS bf16x8*)(V_lds + (bb) * SHM_V + vst0) = sr_[i].vs0; *(LAS bf16x8*)(V_lds + (bb) * SHM_V + vst1) = sr_[i].vs1; const int kc = sc * 2; \
    *(LAS bf16x8*)(K_lds + (bb) * SHM_K + KSWZ(sr, kc)) = sr_[i].ks0; *(LAS bf16x8*)(K_lds + (bb) * SHM_K + KSWZ(32 + sr, kc)) = sr_[i].ks1; } while (0)
#define SWAIT() asm volatile("s_waitcnt vmcnt(4)" ::: "memory")
#define RESC(a) do { if (__any((a) < 1.f)) { if (hi == 0) al_l[r32] = (a); asm volatile("s_waitcnt lgkmcnt(0)" ::: "memory"); \
    _Pragma("unroll") for (int d = 0; d < 4; ++d) _Pragma("unroll") for (int r = 0; r < 16; ++r) o[d][r] *= al_l[crow(r, hi)]; } } while (0)
  f32x16 pA0, pA1, pB0, pB1; float mnA, mnB, alA, alB; bf16x8 pa0, pa1, pa2, pa3;
  SLOAD(0, 0); asm volatile("s_waitcnt vmcnt(0)" ::: "memory"); SWRITE(0, 0); __syncthreads();
  qkt(pA0, pA1, K_lds, qr, r32, hi, sub); partialSM(pA0, pA1, m_reg, mnA, alA);
  SLOAD(1, 1); if (2 < NT) SLOAD(0, 2);
  SWAIT(); SWRITE(1, 1); __syncthreads();
  for (int j = 1; j + 1 < NT; j += 2) {
    SBAR(); qkt(pB0, pB1, K_lds + SHM_K, qr, r32, hi, sub);
    finishSM(pA0, pA1, alA, l_reg, pa0, pa1, pa2, pa3); SBAR();
    SLOAD(1, j + 2); SBAR();
    pv_d0(o, vb0, pa0, pa1, pa2, pa3); partialSM(pB0, pB1, m_reg, mnB, alB);
    __syncthreads(); SWAIT(); SWRITE(0, 0);
    RESC(alB); __syncthreads();
    if (isl && j == 3) { const bf16* Qw = QR + (size_t)qrow * 512 + h * 128 + sub * 64 + hi * 8;
#pragma unroll
      for (int d0 = 0; d0 < 4; ++d0) qr[d0] = *(const bf16x8*)(Qw + d0 * 16); }
    SBAR(); qkt(pA0, pA1, K_lds, qr, r32, hi, sub);
    finishSM(pB0, pB1, alB, l_reg, pa0, pa1, pa2, pa3); SBAR();
    if (j + 3 < NT) SLOAD(0, j + 3); SBAR();
    pv_d0(o, vb0 + SHM_V, pa0, pa1, pa2, pa3); partialSM(pA0, pA1, m_reg, mnA, alA);
    __syncthreads(); SWAIT(); SWRITE(1, 1);
    RESC(alA); __syncthreads();
  }
  SBAR(); qkt(pB0, pB1, K_lds + SHM_K, qr, r32, hi, sub);
  finishSM(pA0, pA1, alA, l_reg, pa0, pa1, pa2, pa3); SBAR();
  pv_d0(o, vb0, pa0, pa1, pa2, pa3); partialSM(pB0, pB1, m_reg, mnB, alB);
  __syncthreads(); RESC(alB);
  finishSM(pB0, pB1, alB, l_reg, pa0, pa1, pa2, pa3); SBAR();
  pv_d0(o, vb0 + SHM_V, pa0, pa1, pa2, pa3);
  if (hi == 0) li_l[r32] = l_reg; asm volatile("s_waitcnt lgkmcnt(0)" ::: "memory");
  float rli[16];
#pragma unroll
  for (int r = 0; r < 16; ++r) rli[r] = __builtin_amdgcn_rcpf(li_l[crow(r, hi)]);
  __syncthreads();
  LAS float* ex = (LAS float*)lds + wq * 4096 + lane;
  if (sub == 1) {
#pragma unroll
    for (int d = 0; d < 4; ++d)
#pragma unroll
      for (int r = 0; r < 16; ++r) ex[(d * 16 + r) * 64] = o[d][r] * rli[r] * lam;
  }
  __syncthreads();
  if (sub == 0) {
    float ss[16];
#pragma unroll
    for (int r = 0; r < 16; ++r) { float s = 0.f;
#pragma unroll
      for (int d = 0; d < 4; ++d) { const float v = o[d][r] * rli[r] - ex[(d * 16 + r) * 64]; o[d][r] = v; s += v * v; }
      ss[r] = s; }
#pragma unroll
    for (int r = 0; r < 16; ++r) { float s = ss[r]; s = xor_add<1>(s); s = xor_add<2>(s); s = xor_add<4>(s); s = xor_add<8>(s); s = xor_add<16>(s); ss[r] = rsqrtf(s * (1.f / 128.f) + EPSF) * oml; }
    bf16* Ow = MIX + (size_t)(q0 + wq * QBLK) * DM + 512 + h * 128 + r32;
#pragma unroll
    for (int d = 0; d < 4; ++d) { const float gsc = subln[d * 32 + r32];
#pragma unroll
      for (int r = 0; r < 16; ++r) Ow[(size_t)crow(r, hi) * DM + d * 32] = (bf16)f2bf(o[d][r] * ss[r] * gsc); }
  }
  __syncthreads();
#undef TROW
#undef SLOAD
#undef SWRITE
#undef SWAIT
#undef RESC
}
#undef KSWZ
}

__global__ void __launch_bounds__(NTHR, 2) mega_fwd(Args args) {
    extern __shared__ __attribute__((aligned(16))) unsigned char lds_raw[];
    Frame F;
    F.lds = (LAS unsigned char*)lds_raw; F.out = args.out; F.ws = args.ws; F.ctl = (gu32*)(args.ws + WS_CTL);
    const int wave0 = __builtin_amdgcn_readfirstlane((int)threadIdx.x >> 6);
    F.tid = threadIdx.x; F.lane = F.tid & 63; F.wave = wave0;
    F.G = gridDim.x; F.bx = blockIdx.x; F.vcu = F.bx;
    volatile LAS unsigned* MISC = (volatile LAS unsigned*)(F.lds + MISC_OFF);
    for (int u = F.tid; u < 256; u += NTHR) MISC[u] = 0u;
    __syncthreads();
    const int lo = args.ph_lo, hi = args.ph_hi;
    const bool multi = (hi - lo) > 1;
    XcdBarrier bar; bar.bar = (unsigned*)(F.ctl + CW_BAR); bar.x = 0; bar.st = nullptr;
    if (multi) bar = xcd_barrier_post((unsigned*)(F.ctl + CW_BAR), MISC + 8, F.tid);
#ifndef PH_MASK
#define PH_MASK 0xFFFFFFFFu
#endif
#define IN(k) (lo <= (k) && (k) < hi)
#define PHM(bit) ((PH_MASK >> (bit)) & 1u)
#ifndef DUP_MASK
#define DUP_MASK 0u
#endif
#define REP(bit) _Pragma("unroll 1") for (int rep_ = 0; rep_ < (((DUP_MASK >> (bit)) & 1u) ? 2 : 1); ++rep_)
#define FRESH() do { const int t_ = (wave0 << 6) | lane_id_asm(); F.tid = t_; F.lane = t_ & 63; F.wave = wave0; \
    unsigned char* w_ = args.ws; asm volatile("" : "+s"(w_)); F.ws = w_; F.ctl = (gu32*)(w_ + WS_CTL); \
    int bx_ = blockIdx.x, g_ = gridDim.x; asm volatile("" : "+s"(bx_), "+s"(g_)); F.bx = bx_; F.G = g_; F.vcu = (g_ % 8 == 0) ? (bx_ % 8) * (g_ / 8) + bx_ / 8 : bx_; } while (0)
#define SEAM(k) do { if (IN(k) && IN((k) + 1)) { XcdBarrier b_ = bar; unsigned char* p_ = args.ws; asm volatile("" : "+s"(p_)); b_.bar = (unsigned*)(p_ + WS_CTL) + CW_BAR; xcd_barrier(b_, (wave0 << 6) | lane_id_asm()); } } while (0)
    PG8_LAS unsigned char* glds = (PG8_LAS unsigned char*)lds_raw;

    if (PHM(0) && IN(0)) { FRESH(); REP(0) { p0_modv(F); p0_weights(F); __syncthreads(); p0_h2(F); p0_s5(F); p0_misc(F); } }
    SEAM(0);
    if (PHM(1) && IN(1)) { FRESH(); REP(0) { p0_filters(F); } }
    SEAM(1);

#pragma unroll 1
    for (int l = 0; l < DEPTH; ++l) {
        const int pb = PH_LAYER0 + l * NPL;
        if (PHM(2) && IN(pb + 0)) { FRESH(); n1_phase(F, l); __syncthreads(); REP(1) { moe_weights(F, l); } }
        SEAM(pb + 0);
        if (PHM(3) && IN(pb + 1)) { FRESH();
            pg8::Gemm g{WSP(bf16, WS_H), WSP(bf16, WS_WINT) + (size_t)l * INC * DM, MT, INC, DM}; pg8::StaticOrder S; S.init(MT, INC, F.G, F.bx);
            EpiG1 E{WSP(bf16, WS_P), WSP(bf16, WS_QR), WSP(bf16, WS_U5), WSP(f32x2, WS_ROPE)};
            REP(2) { pg8::gemm_phase<EpiG1, pg8::StaticOrder, true, true, false>(glds, g, S, E, F.tid); }
        }
        SEAM(pb + 1);
        if (PHM(4) && IN(pb + 2)) { FRESH();
            const float lam = WSP(float, WS_MISC)[l], oml = WSP(float, WS_MISC)[4 + l];
#if !defined(SUBM) || (SUBM & 1)
            REP(3) for (int u = F.vcu; u < 1088; u += F.G) att::attn_unit((LAS char*)lds_raw, WSP(bf16, WS_P), WSP(bf16, WS_QR), WSP(bf16, WS_MIX), inptr(I_SUBLN) + l * 128, lam, oml, u, F.tid);
#endif
            __syncthreads();
#if !defined(SUBM) || (SUBM & 2)
            REP(4) { for (int u = F.vcu; u < 1024; u += F.G) hyena_unit(F, l, u);
            for (int u = F.vcu; u < 256; u += F.G) hyena_ctx_unit(F, l, u); }
#endif
            __syncthreads();
#if !defined(SUBM) || (SUBM & 4)
            { pg8::Gemm g{WSP(bf16, WS_U5), WSP(bf16, WS_S5MB) + (size_t)l * 16 * 768 * 512, 16 * S5RP, 16 * 768, 512}; ListOrder S{240, 15, 3, 5, 3, F.G, F.bx};
              EpiS5i E{WSP(float, WS_YI), WSP(float, WS_ST)};
              REP(5) { pg8::gemm_phase<EpiS5i, ListOrder, true, true, false>(glds, g, S, E, F.tid); } }
#endif
        }
        SEAM(pb + 2);
        if (PHM(5) && IN(pb + 3)) { FRESH(); REP(6) { s5_scan_phase(F, l); } }
        SEAM(pb + 3);
        if (PHM(6) && IN(pb + 4)) { FRESH();
            pg8::Gemm g{WSP(bf16, WS_HIN), WSP(bf16, WS_S5CS) + (size_t)l * 16 * 512 * 256, 16 * S5RP, 16 * 512, 256}; ListOrder S{160, 10, 2, 5, 2, F.G, F.bx};
            EpiS5c E{WSP(float, WS_YI), WSP(bf16, WS_GY)};
            REP(6) { pg8::gemm_phase<EpiS5c, ListOrder, true, true, false>(glds, g, S, E, F.tid); }
        }
        SEAM(pb + 4);
        if (PHM(7) && IN(pb + 5)) { FRESH();
            { pg8::Gemm g{WSP(bf16, WS_GY), WSP(bf16, WS_GLUT) + (size_t)l * 65536, MT, 256, 256}; ListOrder S{MT / 256, 1, 1, 1, 0, F.G, F.bx};
              EpiGlu E{WSP(bf16, WS_GY), WSP(bf16, WS_MIX), inptr(I_S5NG) + l * 256};
              REP(6) { pg8::gemm_phase<EpiGlu, ListOrder, false, true, false>(glds, g, S, E, F.tid); } }
            __syncthreads();
            REP(6) for (int u = F.vcu; u < MT / 64; u += F.G) hyena_fin_unit(F, l, u);
        }
        SEAM(pb + 5);
        if (PHM(8) && IN(pb + 6)) { FRESH();
            pg8::Gemm g{WSP(bf16, WS_MIX), WSP(bf16, WS_WOUTT) + (size_t)l * DM * DM, MT, DM, DM}; pg8::StaticOrder S; S.init(MT, DM, F.G, F.bx);
            EpiG2 E{WSP(float, WS_X), WSP(float, WS_MODV) + (size_t)l * 9 * NMOD};
            pg8::gemm_phase<EpiG2, pg8::StaticOrder, true, true, false>(glds, g, S, E, F.tid);
        }
        SEAM(pb + 6);
        if (PHM(9) && IN(pb + 7)) { FRESH(); REP(8) { n2r_phase(F, l); } }
        SEAM(pb + 7);
        if (PHM(10) && IN(pb + 8)) { FRESH(); REP(9) { assign_phase(F, l); } }
        SEAM(pb + 8);
        if (PHM(11) && IN(pb + 9)) { FRESH();
            const int ntiles = (int)__hip_atomic_load(F.ctl + CW_NTILES + l, RLX_AGENT);
            pg8::Gemm g{WSP(bf16, WS_H), WSP(bf16, WS_MOEW13), NSLOT, NEXP * 1024, DM}; MoeOrder S{(const int*)(F.ws + WS_TOK + TK_TILEE), ntiles, F.G, F.bx};
            EpiUp E{WSP(bf16, WS_HID)};
            REP(10) { pg8::gemm_phase<EpiUp, MoeOrder, true, true, true>(glds, g, S, E, F.tid, (const int*)(F.ws + WS_TOK + TK_STOK)); }
        }
        SEAM(pb + 9);
        if (PHM(12) && IN(pb + 10)) { FRESH();
            const int ntiles = (int)__hip_atomic_load(F.ctl + CW_NTILES + l, RLX_AGENT);
            pg8::Gemm g{WSP(bf16, WS_HID), WSP(bf16, WS_MOEW2), NSLOT, NEXP * 1024, EHID}; MoeOrder S{(const int*)(F.ws + WS_TOK + TK_TILEE), ntiles, F.G, F.bx};
            EpiDown E{WSP(bf16, WS_YB), (const float*)(F.ws + WS_TOK + TK_SGATE)};
            REP(11) { pg8::gemm_phase<EpiDown, MoeOrder, true, true, false>(glds, g, S, E, F.tid); }
        }
        SEAM(pb + 10);
    }
    if (PHM(13) && IN(PH_FINAL)) { FRESH(); n1_phase(F, DEPTH); }
#undef IN
#undef SEAM
}

#ifndef MK_SPLIT
#define MK_SPLIT 0
#endif
extern "C" void kernel_launch(void* const* d_in, const int* in_sizes, int n_in, void* d_out, int out_size, void* d_ws, size_t ws_size, hipStream_t stream) {
    static int grid = 0;
    if (grid == 0) {
        if (n_in != 43 || out_size != ML * DM || ws_size < WS_END) { fprintf(stderr, "kernel_launch: unexpected problem: n_in %d out %d ws %zu (need %zu)\n", n_in, out_size, ws_size, (size_t)WS_END); grid = -1; return; }
        int dev = 0, cus = 0, per_cu = 0;
        if (hipGetDevice(&dev) != hipSuccess || hipDeviceGetAttribute(&cus, hipDeviceAttributeMultiprocessorCount, dev) != hipSuccess) { grid = -1; return; }
        if (hipFuncSetAttribute((const void*)mega_fwd, hipFuncAttributeMaxDynamicSharedMemorySize, LDS_BYTES) != hipSuccess) { fprintf(stderr, "kernel_launch: hipFuncSetAttribute failed\n"); grid = -1; return; }
        if (hipOccupancyMaxActiveBlocksPerMultiprocessor(&per_cu, (const void*)mega_fwd, NTHR, LDS_BYTES) != hipSuccess || per_cu < 1) fprintf(stderr, "kernel_launch: occupancy query says %d\n", per_cu);
        (void)hipGetLastError();
        grid = cus;
    }
    if (grid < 0) return;
    if (hipMemsetAsync((char*)d_ws + WS_CTL, 0, CTL_ZERO_BYTES, stream) != hipSuccess) return;
    Args a{};
    for (int i = 0; i < 43; ++i) a.in[i] = (const float*)d_in[i];
    a.out = (float*)d_out; a.ws = (unsigned char*)d_ws;
#if MK_SPLIT
    for (int p = 0; p < PH_TOTAL; ++p) { a.ph_lo = p; a.ph_hi = p + 1; hipLaunchKernelGGL(mega_fwd, dim3(grid), dim3(NTHR), LDS_BYTES, stream, a); }
#else
    a.ph_lo = 0; a.ph_hi = PH_TOTAL; hipLaunchKernelGGL(mega_fwd, dim3(grid), dim3(NTHR), LDS_BYTES, stream, a);
#endif
    const hipError_t le = hipPeekAtLastError();
    if (le != hipSuccess) fprintf(stderr, "kernel_launch: launch failed: %s\n", hipGetErrorName(le));
}
```

```cpp
#include <hip/hip_runtime.h>
#include <cstdio>
#include <cstdint>
#include <cmath>
__device__ __forceinline__ int lane_id_asm() { int l; asm volatile("v_mbcnt_lo_u32_b32 %0, -1, 0\n\tv_mbcnt_hi_u32_b32 %0, -1, %0" : "=v"(l)); return l; }
namespace pg8 {
#define PG8_LAS __attribute__((address_space(3)))
typedef unsigned short bf16_t;
typedef short bf16x8 __attribute__((ext_vector_type(8)));
typedef float f32x4 __attribute__((ext_vector_type(4)));
typedef unsigned u32x4 __attribute__((ext_vector_type(4)));
constexpr int BM = 256, BK = 64, HALF = 128, HTB = HALF * BK * 2  , STAGE_BYTES = 8 * HTB, NXCD = 8, WGM = 8;

__host__ __device__ __forceinline__ int lds_byte(int r, int c) { const int st = (r >> 4) * 2 + (c >> 5), rr = r & 15, cc = c & 31, ob = rr * 64 + cc * 2; return st * 1024 + (ob ^ (((ob >> 9) & 1) << 5)); }
__host__ __device__ __forceinline__ void stage_rc(int b, int& R, int& C) { const int st = b / 1024, sb = b % 1024, swz = sb ^ (((sb >> 9) & 1) << 5); R = (st >> 1) * 16 + swz / 64; C = (st & 1) * 32 + (swz % 64) / 2; }
__host__ __device__ __forceinline__ int perm32(int rho) { const int n = rho >> 4, i = rho & 15; return 8 * (i >> 2) + 4 * n + (i & 3); }

struct Unit { int pm, pn; };
struct Gemm { const bf16_t* A; const bf16_t* Bt; int M, N, K; };

struct StaticOrder {
    int nM, nN, nwg, G, c;
    __host__ __device__ void init(int M, int N, int G_, int c_) { nM = M / BM; nN = N / BM; nwg = nM * nN; G = G_; c = c_; }
    __host__ __device__ bool next(int i, Unit& u) const {
        const long L = (long)i * G + c; if (L >= nwg) return false;
        int wgid = (int)L; { const int q = nwg / NXCD, r = nwg % NXCD, xcd = wgid % NXCD, off = wgid / NXCD; wgid = (xcd < r ? xcd * (q + 1) : r * (q + 1) + (xcd - r) * q) + off; }
        const int nig = WGM * nN, gid = wgid / nig, fm = gid * WGM, gsz = (nM - fm) < WGM ? (nM - fm) : WGM;
        u.pm = fm + ((wgid % nig) % gsz); u.pn = (wgid % nig) / gsz; return true;
    }
    __device__ __forceinline__ void a_ready(const Unit&) const {}
    __device__ __forceinline__ void done(const Unit&) const {}
};

__device__ __forceinline__ unsigned cvt_pk_bf16(float lo, float hi) { unsigned r; asm volatile("v_cvt_pk_bf16_f32 %0, %1, %2" : "=v"(r) : "v"(lo), "v"(hi)); return r; }
typedef float f32x2 __attribute__((ext_vector_type(2)));
template <class Epi, class Sched, bool ALIGN_EPI = false, bool SP2 = false, bool GATHER = false>
__device__ __forceinline__ void gemm_phase(PG8_LAS unsigned char* lds, const Gemm g, const Sched& S, const Epi& E, int tid_, const int* rowidx = nullptr) {
    asm volatile("" : "+v"(tid_));
    const int tid = tid_, wid = __builtin_amdgcn_readfirstlane(tid >> 6), lane = tid & 63, wr = wid >> 2, wc = wid & 3, fr = lane & 15, fq = lane >> 4;
    const int K = g.K, nt = K / BK;
    unsigned voffA[2], voffB[2]; int RA[2], CA[2]; unsigned oC[2][2], oN[2][2];
#pragma unroll
    for (int i = 0; i < 2; ++i) { int R, C; stage_rc(tid * 16 + i * 8192, R, C); const int Rb = Epi::PERM ? ((R & ~31) + perm32(R & 31)) : R;
        voffA[i] = (unsigned)(R * K + C) * 2u; voffB[i] = (unsigned)(Rb * K + C) * 2u; RA[i] = R; CA[i] = C; }
    const size_t kstep = (size_t)(BK * 2);
    const size_t hstep = (size_t)HALF * K * 2;
    const size_t tstep = 2 * hstep;
    const size_t tstepA = GATHER ? (size_t)0 : tstep;
    const unsigned ldsw = (unsigned)wid * 1024u;
    const int aoff = lds_byte(wr * 64 + fr, fq * 8), boff = lds_byte(wc * 32 + fr, fq * 8);
#define PG8_SA(b, h) (((b) * 2 + (h)) * HTB)
#define PG8_SB(b, h) ((4 + (b) * 2 + (h)) * HTB)
#define PG8_STAGEA(bufoff, gbase, h, NX) do { _Pragma("unroll") for (int _i = 0; _i < 2; ++_i) { \
        const unsigned _o = GATHER ? ((NX) ? oN[h][_i] : oC[h][_i]) : (unsigned)((h) * hstep) + voffA[_i]; \
        __builtin_amdgcn_global_load_lds((const unsigned*)((const char*)(gbase) + _o), (PG8_LAS unsigned*)(lds + (bufoff) + ldsw + _i * 8192), 16, 0, 0); } } while (0)
#define PG8_GIDX(dst, pm_) do { _Pragma("unroll") for (int _h = 0; _h < 2; ++_h) _Pragma("unroll") for (int _i = 0; _i < 2; ++_i) \
        dst[_h][_i] = ((unsigned)rowidx[(pm_) * BM + _h * HALF + RA[_i]] * (unsigned)K + (unsigned)CA[_i]) * 2u; } while (0)
#define PG8_STAGE(bufoff, gbase, voff) do { _Pragma("unroll") for (int _i = 0; _i < 2; ++_i) \
        __builtin_amdgcn_global_load_lds((const unsigned*)((const char*)(gbase) + (voff)[_i]), (PG8_LAS unsigned*)(lds + (bufoff) + ldsw + _i * 8192), 16, 0, 0); } while (0)
#define PG8_LDA(dst, b, h) do { _Pragma("unroll") for (int m = 0; m < 4; ++m) _Pragma("unroll") for (int k = 0; k < 2; ++k) dst[m][k] = *(const PG8_LAS bf16x8*)(lds + PG8_SA(b, h) + aoff + m * 2048 + k * 1024); } while (0)
#define PG8_LDB(dst, b, h) do { _Pragma("unroll") for (int n = 0; n < 2; ++n) _Pragma("unroll") for (int k = 0; k < 2; ++k) dst[n][k] = *(const PG8_LAS bf16x8*)(lds + PG8_SB(b, h) + boff + n * 2048 + k * 1024); } while (0)
#define PG8_MMA(ai, bj, At, Bt) do { __builtin_amdgcn_s_setprio(1); _Pragma("unroll") for (int m = 0; m < 4; ++m) _Pragma("unroll") for (int n = 0; n < 2; ++n) _Pragma("unroll") for (int k = 0; k < 2; ++k) \
        acc[ai][bj][m][n] = __builtin_amdgcn_mfma_f32_16x16x32_bf16(Bt[n][k], At[m][k], acc[ai][bj][m][n], 0, 0, 0); __builtin_amdgcn_s_setprio(0); } while (0)
#define PG8_WAIT_V(n) asm volatile("s_waitcnt vmcnt(" #n ")" ::: "memory")
#define PG8_WAIT_L(n) asm volatile("s_waitcnt lgkmcnt(" #n ")" ::: "memory")
#define PG8_BAR __builtin_amdgcn_s_barrier()
#define PG8_SCHED __builtin_amdgcn_sched_barrier(0)
    Unit cur, nxt; int ui = 0;
    if (!S.next(0, cur)) return;
    f32x4 acc[2][2][4][2];
#pragma unroll
    for (int a = 0; a < 2; ++a)
#pragma unroll
        for (int b = 0; b < 2; ++b)
#pragma unroll
            for (int m = 0; m < 4; ++m)
#pragma unroll
                for (int n = 0; n < 2; ++n) acc[a][b][m][n] = (f32x4){0.f, 0.f, 0.f, 0.f};
    bf16x8 At[4][2], B0[2][2], B1[2][2];
    const char* cA = (const char*)g.A + (size_t)cur.pm * tstepA; const char* cB = (const char*)g.Bt + (size_t)cur.pn * tstep;
    if constexpr (GATHER) { PG8_GIDX(oC, cur.pm); asm volatile("s_waitcnt vmcnt(0)" ::: "memory"); }
    S.a_ready(cur);
    if constexpr (SP2) {
        PG8_STAGE(PG8_SB(0, 0), cB, voffB); PG8_STAGE(PG8_SB(0, 1), cB + hstep, voffB); PG8_STAGEA(PG8_SA(0, 0), cA, 0, false); PG8_STAGEA(PG8_SA(0, 1), cA, 1, false);
        if (wr == 1) PG8_BAR;
        PG8_WAIT_V(2); PG8_BAR;
        PG8_STAGE(PG8_SB(1, 0), cB + kstep, voffB); PG8_STAGEA(PG8_SA(1, 0), cA + kstep, 0, false); PG8_STAGE(PG8_SB(1, 1), cB + hstep + kstep, voffB);
        PG8_WAIT_V(6); PG8_BAR;
    } else {
        PG8_STAGE(PG8_SB(0, 0), cB, voffB); PG8_STAGEA(PG8_SA(0, 0), cA, 0, false); PG8_STAGE(PG8_SB(0, 1), cB + hstep, voffB); PG8_STAGEA(PG8_SA(0, 1), cA, 1, false);
        if (wr == 1) PG8_BAR;
        PG8_WAIT_V(4); PG8_BAR;
        PG8_STAGE(PG8_SB(1, 0), cB + kstep, voffB); PG8_STAGEA(PG8_SA(1, 0), cA + kstep, 0, false); PG8_STAGE(PG8_SB(1, 1), cB + hstep + kstep, voffB);
        PG8_WAIT_V(6); PG8_BAR;
    }
    for (;;) {
        const bool has_next = S.next(ui + 1, nxt);
        const char* nA = has_next ? (const char*)g.A + (size_t)nxt.pm * tstepA : cA; const char* nB = has_next ? (const char*)g.Bt + (size_t)nxt.pn * tstep : cB;
        if constexpr (GATHER) { if (has_next) { PG8_GIDX(oN, nxt.pm); asm volatile("s_waitcnt vmcnt(0)" ::: "memory"); } else { _Pragma("unroll") for (int _h = 0; _h < 2; ++_h) _Pragma("unroll") for (int _i = 0; _i < 2; ++_i) oN[_h][_i] = oC[_h][_i]; } }
        for (int t = 0; t < nt; t += 2) {
            const bool last = (t == nt - 2);
            const char* a1 = cA + (size_t)(t + 1) * kstep;
            const char* a2 = last ? nA : cA + (size_t)(t + 2) * kstep; const char* b2 = last ? nB : cB + (size_t)(t + 2) * kstep;
            const char* a3 = a2 + kstep; const char* b3 = b2 + kstep;
            if (last && has_next) S.a_ready(nxt);
            if constexpr (SP2) {
            PG8_LDB(B0, 0, 0); PG8_LDB(B1, 0, 1); PG8_SCHED; PG8_LDA(At, 0, 0); PG8_STAGEA(PG8_SA(1, 1), a1, 1, false);
            PG8_WAIT_V(8); PG8_WAIT_L(0); PG8_BAR; PG8_MMA(0, 0, At, B0); PG8_MMA(0, 1, At, B1); PG8_BAR; PG8_SCHED;
            PG8_LDA(At, 0, 1); PG8_STAGE(PG8_SB(0, 0), b2, voffB); PG8_STAGE(PG8_SB(0, 1), b2 + hstep, voffB); PG8_STAGEA(PG8_SA(0, 0), a2, 0, last);
            PG8_WAIT_V(8); PG8_WAIT_L(0); PG8_BAR; PG8_MMA(1, 0, At, B0); PG8_MMA(1, 1, At, B1); PG8_BAR; PG8_SCHED;
            PG8_LDB(B0, 1, 0); PG8_LDB(B1, 1, 1); PG8_SCHED; PG8_LDA(At, 1, 0); PG8_STAGEA(PG8_SA(0, 1), a2, 1, last);
            PG8_WAIT_V(8); PG8_WAIT_L(0); PG8_BAR; PG8_MMA(0, 0, At, B0); PG8_MMA(0, 1, At, B1); PG8_BAR; PG8_SCHED;
            PG8_LDA(At, 1, 1); PG8_STAGE(PG8_SB(1, 0), b3, voffB); PG8_STAGE(PG8_SB(1, 1), b3 + hstep, voffB); PG8_STAGEA(PG8_SA(1, 0), a3, 0, last);
            PG8_WAIT_V(8); PG8_WAIT_L(0); PG8_BAR; PG8_MMA(1, 0, At, B0); PG8_MMA(1, 1, At, B1); PG8_BAR; PG8_SCHED;
            } else {
            PG8_LDB(B0, 0, 0); PG8_SCHED; PG8_LDA(At, 0, 0); PG8_STAGEA(PG8_SA(1, 1), a1, 1, false);
            PG8_WAIT_L(8); PG8_BAR; PG8_WAIT_L(0); PG8_MMA(0, 0, At, B0); PG8_BAR; PG8_SCHED;
            PG8_LDB(B1, 0, 1); PG8_STAGE(PG8_SB(0, 0), b2, voffB);
            PG8_BAR; PG8_WAIT_L(0); PG8_MMA(0, 1, At, B1); PG8_BAR;
            PG8_LDA(At, 0, 1); PG8_STAGEA(PG8_SA(0, 0), a2, 0, last);
            PG8_BAR; PG8_WAIT_L(0); PG8_MMA(1, 0, At, B0); PG8_BAR; PG8_SCHED;
            PG8_STAGE(PG8_SB(0, 1), b2 + hstep, voffB);
            PG8_WAIT_V(6); PG8_BAR; PG8_MMA(1, 1, At, B1); PG8_BAR;
            PG8_LDB(B0, 1, 0); PG8_SCHED; PG8_LDA(At, 1, 0); PG8_STAGEA(PG8_SA(0, 1), a2, 1, last);
            PG8_WAIT_L(8); PG8_BAR; PG8_WAIT_L(0); PG8_MMA(0, 0, At, B0); PG8_BAR; PG8_SCHED;
            PG8_LDB(B1, 1, 1); PG8_STAGE(PG8_SB(1, 0), b3, voffB);
            PG8_BAR; PG8_WAIT_L(0); PG8_MMA(0, 1, At, B1); PG8_BAR;
            PG8_LDA(At, 1, 1); PG8_STAGEA(PG8_SA(1, 0), a3, 0, last);
            PG8_BAR; PG8_WAIT_L(0); PG8_MMA(1, 0, At, B0); PG8_BAR; PG8_SCHED;
            PG8_STAGE(PG8_SB(1, 1), b3 + hstep, voffB);
            PG8_WAIT_V(6); PG8_BAR; PG8_MMA(1, 1, At, B1); PG8_BAR;
            }
        }
        if constexpr (ALIGN_EPI) { if (wr == 0) PG8_BAR; }
        if constexpr (!Epi::AFTER_DRAIN) { const int l2_ = lane_id_asm(); E(acc, cur, wr, wc, l2_ & 15, l2_ >> 4); S.done(cur); }
        if (!has_next) break;
#pragma unroll
        for (int a = 0; a < 2; ++a)
#pragma unroll
            for (int b = 0; b < 2; ++b)
#pragma unroll
                for (int m = 0; m < 4; ++m)
#pragma unroll
                    for (int n = 0; n < 2; ++n) acc[a][b][m][n] = (f32x4){0.f, 0.f, 0.f, 0.f};
        cur = nxt; cA = nA; cB = nB; ++ui;
        if constexpr (GATHER) { _Pragma("unroll") for (int _h = 0; _h < 2; ++_h) _Pragma("unroll") for (int _i = 0; _i < 2; ++_i) oC[_h][_i] = oN[_h][_i]; }
        if constexpr (ALIGN_EPI) { if (wr == 1) PG8_BAR; }
    }
    PG8_WAIT_V(0);
    if constexpr (!ALIGN_EPI) { if (wr == 0) PG8_BAR; }
    PG8_BAR;
    if constexpr (Epi::AFTER_DRAIN) { const int l2_ = lane_id_asm(); E.fused(acc, cur, wr, wc, l2_ & 15, l2_ >> 4, lds, wid, l2_); S.done(cur); }
#undef PG8_SA
#undef PG8_SB
#undef PG8_STAGE
#undef PG8_STAGEA
#undef PG8_GIDX
#undef PG8_LDA
#undef PG8_LDB
#undef PG8_MMA
#undef PG8_WAIT_V
#undef PG8_WAIT_L
#undef PG8_BAR
#undef PG8_SCHED
}
}

#ifndef DUP_MASK
#define DUP_MASK 0u
#endif
constexpr int DM = 1024, NB = 8, SEQ = 4096, CTXL = 256, DEPTH = 4;
constexpr int ML = NB * SEQ;
constexpr int MC = NB * CTXL;
constexpr int MT = ML + MC;
constexpr int INC = 2560;
constexpr int C_S5 = 768, C_Q = 1024, C_K = 1536, C_V = 2048;
constexpr int NMOD = 6 * DM;
constexpr int NEXP = 32, EHID = 512;
constexpr int NSLOT = (MT * 2 / 256 + NEXP) * 256;
constexpr float EPSF = 1e-6f;
constexpr int S5T = 32;
constexpr int S5ROWS = MT / S5T;
constexpr int S5RP = 1280;
constexpr int NWAVES = 8, NTHR = 512;
constexpr int NPL = 11;
constexpr int PH_LAYER0 = 2, PH_FINAL = PH_LAYER0 + DEPTH * NPL, PH_TOTAL = PH_FINAL + 1;

constexpr size_t MiB = 1u << 20;
constexpr size_t WS_CTL = 0, CTL_ZERO_BYTES = 1 * MiB;
constexpr size_t WS_MODV = 2 * MiB;
constexpr size_t WS_MISC = 3 * MiB;
constexpr size_t WS_ROPE = 4 * MiB;
constexpr size_t WS_H2T = 5 * MiB;
constexpr size_t WS_H2C = 9 * MiB;
constexpr size_t WS_FC = 10 * MiB;
constexpr size_t WS_WGE = 12 * MiB;
constexpr size_t WS_GLUT = 13 * MiB;
constexpr size_t WS_WINT = 16 * MiB;
constexpr size_t WS_WOUTT = 36 * MiB;
constexpr size_t WS_S5MB = 44 * MiB;
constexpr size_t WS_S5CS = 92 * MiB;
constexpr size_t WS_FSPEC = 108 * MiB;
constexpr size_t WS_X = 172 * MiB;
constexpr size_t WS_H = 308 * MiB;
constexpr size_t WS_MOEW13 = 377 * MiB;
constexpr size_t WS_MOEW2 = 441 * MiB;
constexpr size_t WS_U5 = 473 * MiB;
constexpr size_t WS_YI = 493 * MiB;
constexpr size_t WS_ST = 533 * MiB;
constexpr size_t WS_HIN = 553 * MiB;
constexpr size_t WS_GY = 563 * MiB;
constexpr size_t WS_HYW = 583 * MiB;
constexpr size_t WS_HYWC = 615 * MiB;
constexpr size_t WS_TOK = 617 * MiB;
constexpr size_t WS_R = 620 * MiB;
constexpr size_t WS_P = WS_R;
constexpr size_t WS_QR = WS_R + 170 * MiB;
constexpr size_t WS_MIX = WS_R + 202 * MiB;
constexpr size_t WS_HID = WS_R;
constexpr size_t WS_YB = WS_R + 76 * MiB;
constexpr size_t WS_END = WS_R + 270 * MiB;
constexpr size_t TK_E = 0, TK_POS = TK_E + (size_t)MT * 2 * 4, TK_GATE = TK_POS + (size_t)MT * 2 * 4, TK_SLOT = TK_GATE + (size_t)MT * 2 * 4;
constexpr size_t TK_STOK = TK_SLOT + (size_t)MT * 2 * 4, TK_SGATE = TK_STOK + (size_t)NSLOT * 4, TK_TILEE = TK_SGATE + (size_t)NSLOT * 4, TK_HIST = TK_TILEE + 4096, TK_END = TK_HIST + 256 * 32 * 4;
static_assert(TK_END <= 3 * MiB, "routing tables");
constexpr int CW_TMO = 0;
constexpr int CW_BAR = 4096;
constexpr int CW_CNT = 16384;
constexpr int CW_NTILES = 16384 + 1024;

constexpr int LDS_BYTES = 163840;
constexpr int MISC_OFF = 162816;

struct Args { const float* in[43]; float* out; unsigned char* ws; int ph_lo, ph_hi; };
enum InIdx { I_X = 0, I_C, I_CTX, I_CCTX, I_WMOD, I_BMOD, I_N1G, I_N2G, I_FING, I_WIN, I_WOUT, I_HYCW, I_HYCB, I_HYW1, I_HYB1, I_HYW2, I_HYB2, I_HYW3, I_HYFREQ, I_HYSKIP, I_HYNG,
             I_S5ARE, I_S5AIM, I_S5LDT, I_S5BRE, I_S5BIM, I_S5CRE, I_S5CIM, I_S5D, I_S5GLU, I_S5NG, I_LQ1, I_LK1, I_LQ2, I_LK2, I_SUBLN, I_MWG, I_MBG, I_MWE, I_MBE, I_MW1, I_MW3, I_MW2 };
#if defined(__HIP_DEVICE_COMPILE__)
#define GAS __attribute__((address_space(1)))
#define LAS __attribute__((address_space(3)))
typedef unsigned short bf16;
typedef unsigned v4u __attribute__((ext_vector_type(4)));
typedef unsigned v2u __attribute__((ext_vector_type(2)));
typedef float f32x4 __attribute__((ext_vector_type(4)));
typedef float f32x2 __attribute__((ext_vector_type(2)));
typedef float f32x16 __attribute__((ext_vector_type(16)));
typedef short bf16x8 __attribute__((ext_vector_type(8)));
typedef short s16x4 __attribute__((ext_vector_type(4)));
typedef GAS unsigned gu32;
#define RLX_AGENT __ATOMIC_RELAXED, __HIP_MEMORY_SCOPE_AGENT
#define LDS_WAIT() asm volatile("s_waitcnt lgkmcnt(0)" ::: "memory")
#define VM_WAIT() asm volatile("s_waitcnt vmcnt(0)" ::: "memory")
__device__ __forceinline__ unsigned f2bf(float f) { unsigned u = __builtin_bit_cast(unsigned, f); return (u + 0x7fffu + ((u >> 16) & 1u)) >> 16; }
__device__ __forceinline__ unsigned pk2(float lo, float hi) { return pg8::cvt_pk_bf16(lo, hi); }
__device__ __forceinline__ float bf2f(unsigned short h) { return __builtin_bit_cast(float, (unsigned)h << 16); }
__device__ __forceinline__ float bflo(unsigned w) { return __builtin_bit_cast(float, w << 16); }
__device__ __forceinline__ float bfhi(unsigned w) { return __builtin_bit_cast(float, w & 0xffff0000u); }
__device__ __forceinline__ float fexp(float x) { return __builtin_amdgcn_exp2f(x * 1.4426950408889634f); }
__device__ __forceinline__ float fsigmoid(float x) { return __builtin_amdgcn_rcpf(1.f + fexp(-x)); }
__device__ __forceinline__ float fsilu(float x) { return x * fsigmoid(x); }
__device__ __forceinline__ float fgelu_tanh(float x) { const float u = 0.7978845608028654f * (x + 0.044715f * x * x * x); return x * fsigmoid(2.f * u); }
template <int M> __device__ __forceinline__ float xor_add(float v) {
    if constexpr (M < 32) return v + __builtin_bit_cast(float, __builtin_amdgcn_ds_swizzle(__builtin_bit_cast(int, v), (M << 10) | 0x1f));
    else { auto rr = __builtin_amdgcn_permlane32_swap(__float_as_uint(v), __float_as_uint(v), false, false); const unsigned a = rr[0], b = rr[1]; return __uint_as_float(a) + __uint_as_float(b); }
}
__device__ __forceinline__ float wave_sum(float v) { v = xor_add<1>(v); v = xor_add<2>(v); v = xor_add<4>(v); v = xor_add<8>(v); v = xor_add<16>(v); v = xor_add<32>(v); return v; }
#define XB_TMO      128
#define XB_XCNT(j)  (256  + 64 * (j))
#define XB_XSUB(j)  (1280 + 64 * (j))
#define XB_XGEN(j)  (2304 + 64 * (j))
#define XB_TOP      3328
#define XB_TOPGEN   3392
#define XCD_BAR_WORDS 3456
#define XB_SPIN_CAP (1u << 18)

__device__ __forceinline__ unsigned xb_ld(unsigned* p)              { return __hip_atomic_load(p, __ATOMIC_RELAXED, __HIP_MEMORY_SCOPE_AGENT); }
__device__ __forceinline__ unsigned xb_add(unsigned* p, unsigned v) { return __hip_atomic_fetch_add(p, v, __ATOMIC_RELAXED, __HIP_MEMORY_SCOPE_AGENT); }
__device__ __forceinline__ unsigned xb_xcc_id() { return (unsigned)__builtin_amdgcn_s_getreg((3 << 11) | 20) & 0xFu; }
#define XB_SPIN(cond, bar) do { unsigned _sp = 0; while (cond) { __builtin_amdgcn_s_sleep(1); \
    if ((++_sp & 255u) == 0u) { if (xb_ld(&(bar)[XB_TMO])) break; if (_sp > XB_SPIN_CAP) { atomicAdd(&(bar)[XB_TMO], 1u); break; } } } } while (0)

struct XcdBarrier {
    unsigned* bar; unsigned x;
    volatile LAS unsigned* st;
};

__device__ __forceinline__ XcdBarrier xcd_barrier_post(unsigned* bar, volatile LAS unsigned* st, int tid) {
    XcdBarrier b; b.bar = bar; b.x = xb_xcc_id(); b.st = st;
    if (tid == 0) (void)xb_add(&bar[XB_XCNT(b.x)], 1u);
    return b;
}
__device__ __forceinline__ void xcd_barrier_complete(unsigned* bar, unsigned x, unsigned& nloc, unsigned& nx) {
    const unsigned G = gridDim.x * gridDim.y * gridDim.z;
    unsigned sum, cnt, mine, sp = 0u;
    for (;;) {
        sum = 0u; cnt = 0u; mine = 0u;
#pragma unroll
        for (unsigned j = 0; j < 16; ++j) { const unsigned c = xb_ld(&bar[XB_XCNT(j)]); sum += c; cnt += (c > 0u) ? 1u : 0u; mine = (j == x) ? c : mine; }
        if (sum == G) break;
        __builtin_amdgcn_s_sleep(1);
        if ((++sp & 255u) == 0u) { if (xb_ld(&bar[XB_TMO])) break; if (sp > XB_SPIN_CAP) { atomicAdd(&bar[XB_TMO], 1u); break; } }
    }
    nloc = mine > 0u ? mine : 1u; nx = cnt > 0u ? cnt : 1u;
}

__device__ __forceinline__ void xcd_barrier(const XcdBarrier& b, int tid) {
    asm volatile("s_waitcnt vmcnt(0)" ::: "memory");
    __syncthreads();
    if (tid == 0) {
        unsigned* bar = b.bar;
        __builtin_amdgcn_s_waitcnt(0);
        unsigned nloc = b.st[0], nx = b.st[1];
        if (nloc == 0u) { xcd_barrier_complete(bar, b.x, nloc, nx); b.st[0] = nloc; b.st[1] = nx; }
        const unsigned old = xb_add(&bar[XB_XSUB(b.x)], 1u);
        const unsigned gen = old / nloc;
        if (old + 1u == (gen + 1u) * nloc) {
            __builtin_amdgcn_fence(__ATOMIC_RELEASE, "agent");
            asm volatile("s_waitcnt vmcnt(0)" ::: "memory");
            const unsigned og = xb_add(&bar[XB_TOP], 1u);
            const unsigned tg = og / nx;
            if (og + 1u == (tg + 1u) * nx) xb_add(&bar[XB_TOPGEN], 1u);
            else XB_SPIN(xb_ld(&bar[XB_TOPGEN]) == tg, bar);
            __builtin_amdgcn_fence(__ATOMIC_ACQUIRE, "agent");
            xb_add(&bar[XB_XGEN(b.x)], 1u);
            asm volatile("s_waitcnt vmcnt(0)" ::: "memory");
        } else {
            XB_SPIN(xb_ld(&bar[XB_XGEN(b.x)]) == gen, bar);
            __builtin_amdgcn_fence(__ATOMIC_ACQUIRE, "agent");
            asm volatile("s_waitcnt vmcnt(0)" ::: "memory");
        }
    }
    __syncthreads();
}

struct Frame {
    LAS unsigned char* lds;
    GAS float* out; GAS unsigned char* ws; gu32* ctl;
    int tid, lane, wave, vcu, G, bx;
};
#define WSP(T, off) ((GAS T*)(F.ws + (off)))
__device__ __forceinline__ const GAS float* inptr(int idx) { const unsigned long ka = (unsigned long)__builtin_amdgcn_kernarg_segment_ptr(); const GAS float* p;
    asm volatile("s_load_dwordx2 %0, %1, %2\n\ts_waitcnt lgkmcnt(0)" : "=s"(p) : "s"(ka), "n"(idx * 8)); return p; }

template <class RowMap>
__device__ __forceinline__ void transpose_item(const GAS float* W, int K, int N, GAS bf16* WT, LAS float* scr, int item, int lane, const RowMap& rowmap) {
    const int nblk = N / 64, kb = item / nblk, nb = item % nblk, k0 = 64 * kb, n0 = 64 * nb;
    f32x4 v[16];
#pragma unroll
    for (int i = 0; i < 16; ++i) v[i] = *(const GAS f32x4*)(W + (size_t)(k0 + 4 * i + (lane >> 4)) * N + n0 + 4 * (lane & 15));
#pragma unroll
    for (int i = 0; i < 16; ++i) { LAS float* d = scr + (4 * i + (lane >> 4)) * 65 + 4 * (lane & 15); d[0] = v[i].x; d[1] = v[i].y; d[2] = v[i].z; d[3] = v[i].w; }
    LDS_WAIT(); asm volatile("" ::: "memory");
    const int c = lane & 7;
#pragma unroll
    for (int j = 0; j < 8; ++j) { const int n = (lane >> 3) + 8 * j; const LAS float* s = scr + (8 * c) * 65 + n;
        v4u o; o.x = pk2(s[0 * 65], s[1 * 65]); o.y = pk2(s[2 * 65], s[3 * 65]); o.z = pk2(s[4 * 65], s[5 * 65]); o.w = pk2(s[6 * 65], s[7 * 65]);
        *(GAS v4u*)(WT + (size_t)rowmap(n0 + n) * K + k0 + 8 * c) = o; }
    LDS_WAIT(); asm volatile("" ::: "memory");
}
struct RowId { __device__ __forceinline__ int operator()(int n) const { return n; } };
struct RowWin {
    __device__ __forceinline__ int operator()(int n) const { if (n < C_Q || n >= C_V) return n; const int d = n & 63, j = d & 31, s = d >> 5; return (n - d) + 2 * j + s; } };
struct RowW13 { int off; __device__ __forceinline__ int operator()(int j) const { return (j >> 7) * 256 + off + (j & 127); } };

__device__ __forceinline__ void p0_modv(Frame& F) {
    const GAS float* const in_BMOD = inptr(I_BMOD);
    const GAS float* const in_C = inptr(I_C);
    const GAS float* const in_CCTX = inptr(I_CCTX);
    const GAS float* const in_WMOD = inptr(I_WMOD);
    LAS float* sc = (LAS float*)F.lds;
    LAS float* red = (LAS float*)(F.lds + 36864);
    for (int i = F.tid; i < 9 * 1024; i += NTHR) { const int bi = i >> 10, k = i & 1023; const float v = bi < 8 ? in_C[bi * 1024 + k] : in_CCTX[k]; sc[i] = fsilu(v); }
    __syncthreads();
    for (int unit = F.vcu; unit < DEPTH * 48; unit += F.G) {
        const int l = unit / 48, cb = unit % 48, c4 = F.tid & 31, kk = F.tid >> 5;
        f32x4 acc[9];
#pragma unroll
        for (int b = 0; b < 9; ++b) acc[b] = (f32x4){0.f, 0.f, 0.f, 0.f};
        const GAS float* wb = in_WMOD + (size_t)l * DM * NMOD + cb * 128 + c4 * 4;
#pragma unroll 4
        for (int i = 0; i < 64; ++i) { const int k = kk + 16 * i; const f32x4 w = *(const GAS f32x4*)(wb + (size_t)k * NMOD);
#pragma unroll
            for (int b = 0; b < 9; ++b) acc[b] += sc[b * 1024 + k] * w; }
#pragma unroll
        for (int b = 0; b < 9; ++b) *(LAS f32x4*)(red + (kk * 9 + b) * 128 + c4 * 4) = acc[b];
        __syncthreads();
        for (int o = F.tid; o < 9 * 128; o += NTHR) { const int b = o >> 7, cc = o & 127; float s = in_BMOD[l * NMOD + cb * 128 + cc];
#pragma unroll
            for (int q = 0; q < 16; ++q) s += red[(q * 9 + b) * 128 + cc];
            WSP(float, WS_MODV)[(size_t)(l * 9 + b) * NMOD + cb * 128 + cc] = s; }
        __syncthreads();
    }
    __syncthreads();
}
__device__ __forceinline__ void p0_weights(Frame& F) {
    const GAS float* const in_S5GLU = inptr(I_S5GLU);
    const GAS float* const in_WIN = inptr(I_WIN);
    const GAS float* const in_WOUT = inptr(I_WOUT);
    LAS float* scr = (LAS float*)(F.lds + F.wave * 16640);
    const int gw = F.vcu * NWAVES + F.wave, NGW = F.G * NWAVES;
    constexpr int I_IN = (DM / 64) * (INC / 64), I_OUT = (DM / 64) * (DM / 64), I_GLU = (256 / 64) * (256 / 64);
    constexpr int NIT = DEPTH * (I_IN + I_OUT + I_GLU);
    for (int it = gw; it < NIT; it += NGW) {
        int r = it; const int l = r / (I_IN + I_OUT + I_GLU); r -= l * (I_IN + I_OUT + I_GLU);
        if (r < I_IN) { transpose_item(in_WIN + (size_t)l * DM * INC, DM, INC, WSP(bf16, WS_WINT) + (size_t)l * INC * DM, scr, r, F.lane, RowWin{}); continue; } r -= I_IN;
        if (r < I_OUT) { transpose_item(in_WOUT + (size_t)l * DM * DM, DM, DM, WSP(bf16, WS_WOUTT) + (size_t)l * DM * DM, scr, r, F.lane, RowId{}); continue; } r -= I_OUT;
        transpose_item(in_S5GLU + (size_t)l * 65536, 256, 256, WSP(bf16, WS_GLUT) + (size_t)l * 65536, scr, r, F.lane, RowId{});
    }
}
__device__ __forceinline__ void moe_weights(Frame& F, int l) {
    const GAS float* const in_MW1 = inptr(I_MW1);
    const GAS float* const in_MW2 = inptr(I_MW2);
    const GAS float* const in_MW3 = inptr(I_MW3);
    LAS float* scr = (LAS float*)(F.lds + F.wave * 16640);
    const int gw = F.vcu * NWAVES + F.wave, NGW = F.G * NWAVES;
    constexpr int I_1 = (DM / 64) * (EHID / 64), I_2 = (EHID / 64) * (DM / 64);
    for (int it = gw; it < NEXP * (2 * I_1 + I_2); it += NGW) {
        const int e = it / (2 * I_1 + I_2); int r = it - e * (2 * I_1 + I_2);
        const size_t eo = (size_t)(l * NEXP + e) * DM * EHID;
        if (r < I_1) { transpose_item(in_MW1 + eo, DM, EHID, WSP(bf16, WS_MOEW13) + (size_t)e * 1024 * 1024, scr, r, F.lane, RowW13{0}); continue; } r -= I_1;
        if (r < I_1) { transpose_item(in_MW3 + eo, DM, EHID, WSP(bf16, WS_MOEW13) + (size_t)e * 1024 * 1024, scr, r, F.lane, RowW13{128}); continue; } r -= I_1;
        transpose_item(in_MW2 + eo, EHID, DM, WSP(bf16, WS_MOEW2) + (size_t)e * 1024 * 512, scr, r, F.lane, RowId{});
    }
}
__device__ __forceinline__ void p0_h2(Frame& F) {
    const GAS float* const in_HYB1 = inptr(I_HYB1);
    const GAS float* const in_HYB2 = inptr(I_HYB2);
    const GAS float* const in_HYFREQ = inptr(I_HYFREQ);
    const GAS float* const in_HYW1 = inptr(I_HYW1);
    const GAS float* const in_HYW2 = inptr(I_HYW2);
    LAS float* feat = (LAS float*)F.lds;
    LAS float* h1 = feat + 8 * 33;
    constexpr int UPL = (SEQ + CTXL) / 8;
    for (int unit = F.vcu; unit < DEPTH * UPL; unit += F.G) {
        const int l = unit / UPL, ub = unit % UPL; const bool isc = ub >= SEQ / 8; const int pos0 = isc ? (ub - SEQ / 8) * 8 : ub * 8; const float invL = isc ? 1.f / CTXL : 1.f / SEQ;
        if (F.tid < 8 * 33) { const int p = F.tid / 33, j = F.tid % 33; const float t = (float)(pos0 + p) * invL; float v;
            if (j == 0) v = t; else { const int m = j <= 16 ? j : j - 16; const float ang = 6.283185307179586f * t * (float)m; v = j <= 16 ? cosf(ang) : sinf(ang); }
            feat[F.tid] = v; }
        __syncthreads();
        const int p = F.tid >> 6, k = F.tid & 63;
        { float s = in_HYB1[l * 64 + k]; const GAS float* w1 = in_HYW1 + (size_t)l * 33 * 64 + k;
#pragma unroll
          for (int j = 0; j < 33; ++j) s += feat[p * 33 + j] * w1[j * 64];
          h1[p * 64 + k] = sinf(in_HYFREQ[l * 64 + k] * s); }
        __syncthreads();
        { float s = in_HYB2[l * 64 + k]; const GAS float* w2 = in_HYW2 + (size_t)l * 64 * 64 + k;
#pragma unroll 8
          for (int j = 0; j < 64; ++j) s += h1[p * 64 + j] * w2[j * 64];
          const float v = sinf(in_HYFREQ[l * 64 + k] * s);
          if (isc) WSP(float, WS_H2C)[((size_t)l * CTXL + pos0 + p) * 64 + k] = v; else WSP(float, WS_H2T)[((size_t)l * SEQ + pos0 + p) * 64 + k] = v; }
        __syncthreads();
    }
}
__device__ __forceinline__ void p0_misc(Frame& F) {
    const GAS float* const in_MWE = inptr(I_MWE);
    const GAS float* const in_MWG = inptr(I_MWG);
    const GAS float* const in_LK1 = inptr(I_LK1);
    const GAS float* const in_LK2 = inptr(I_LK2);
    const GAS float* const in_LQ1 = inptr(I_LQ1);
    const GAS float* const in_LQ2 = inptr(I_LQ2);
    for (int i = F.vcu * NTHR + F.tid; i < SEQ * 32; i += F.G * NTHR) { const int t = i >> 5, j = i & 31; const float inv = powf(10000.f, -(float)(j & 15) / 16.f);
        const float ang = (float)(j < 16 ? (t >> 6) : (t & 63)) * inv; WSP(f32x2, WS_ROPE)[i] = (f32x2){cosf(ang), sinf(ang)}; }
    for (int i = F.vcu * NTHR + F.tid; i < DEPTH * 48 * 1024; i += F.G * NTHR) { const int l = i / (48 * 1024), n = (i >> 10) % 48, k = i & 1023;
        const float w = n < 32 ? in_MWE[((size_t)l * DM + k) * 32 + n] : n < 36 ? in_MWG[((size_t)l * DM + k) * 4 + (n - 32)] : 0.f;
        const unsigned hi = f2bf(w); const float lo = w - __builtin_bit_cast(float, hi << 16);
        GAS bf16* dst = WSP(bf16, WS_WGE) + (size_t)l * 2 * 48 * 1024 + (size_t)n * 1024 + k; dst[0] = (bf16)hi; dst[48 * 1024] = (bf16)f2bf(lo); }
    if (F.bx == 0) {
        if (F.tid < DEPTH) { const int l = F.tid; float s1 = 0.f, s2 = 0.f;
            for (int d = 0; d < 64; ++d) { s1 += in_LQ1[l * 64 + d] * in_LK1[l * 64 + d]; s2 += in_LQ2[l * 64 + d] * in_LK2[l * 64 + d]; }
            const float li = 0.8f - 0.6f * expf(-0.3f * (float)l);
            WSP(float, WS_MISC)[l] = expf(s1) - expf(s2) + li; WSP(float, WS_MISC)[4 + l] = 1.f - li; }
        for (int i = F.tid; i < DM / 2; i += NTHR) WSP(unsigned, WS_H)[(size_t)MT * (DM / 2) + i] = 0u;
    }
}
__device__ __forceinline__ void p0_s5(Frame& F) {
    const GAS float* const in_S5AIM = inptr(I_S5AIM);
    const GAS float* const in_S5ARE = inptr(I_S5ARE);
    const GAS float* const in_S5BIM = inptr(I_S5BIM);
    const GAS float* const in_S5BRE = inptr(I_S5BRE);
    const GAS float* const in_S5CIM = inptr(I_S5CIM);
    const GAS float* const in_S5CRE = inptr(I_S5CRE);
    const GAS float* const in_S5D = inptr(I_S5D);
    const GAS float* const in_S5LDT = inptr(I_S5LDT);
    LAS f32x2* ap = (LAS f32x2*)F.lds;
    LAS f32x2* bb = ap + 2 * 33 * 64;
    LAS f32x2* cc = bb + 2 * 64 * 16;
    LAS float* kt = (LAS float*)(cc + 2 * 16 * 64);
    for (int unit = F.vcu; unit < DEPTH * 16; unit += F.G) {
        const int l = unit >> 4, g = unit & 15;
        for (int i = F.tid; i < 2 * 33 * 64; i += NTHR) { const int d = i / (33 * 64), tau = (i / 64) % 33, p = i & 63; const int pi = ((l * 2 + d) * 16 + g) * 64 + p;
            const float dt = expf(in_S5LDT[(l * 2 + d) * 16 + g]); const float xr = (float)tau * dt * in_S5ARE[pi], xi = (float)tau * dt * in_S5AIM[pi];
            const float m = expf(xr); ap[i] = (f32x2){m * cosf(xi), m * sinf(xi)}; }
        for (int i = F.tid; i < 2 * 64 * 16; i += NTHR) { const int d = i >> 10, p = (i >> 4) & 63, h = i & 15; const int pi = ((l * 2 + d) * 16 + g) * 64 + p;
            const float dt = expf(in_S5LDT[(l * 2 + d) * 16 + g]); const float ar = in_S5ARE[pi], ai = in_S5AIM[pi];
            const float m = expf(dt * ar); const float er = m * cosf(dt * ai) - 1.f, ei = m * sinf(dt * ai);
            const float den = 1.f / (ar * ar + ai * ai); const float cr = (er * ar + ei * ai) * den, ci = (ei * ar - er * ai) * den;
            const float br = in_S5BRE[(size_t)pi * 16 + h], bi = in_S5BIM[(size_t)pi * 16 + h];
            bb[i] = (f32x2){cr * br - ci * bi, cr * bi + ci * br}; }
        for (int i = F.tid; i < 2 * 16 * 64; i += NTHR) { const int d = i >> 10, h = (i >> 6) & 15, p = i & 63; const size_t ci = ((size_t)((l * 2 + d) * 16 + g) * 16 + h) * 64 + p;
            cc[i] = (f32x2){in_S5CRE[ci], in_S5CIM[ci]}; }
        __syncthreads();
        for (int i = F.tid; i < 2 * 32 * 256; i += NTHR) { const int d = i >> 13, tau = (i >> 8) & 31, h = (i >> 4) & 15, h2 = i & 15; float s = 0.f;
            for (int p = 0; p < 64; ++p) { const f32x2 c = cc[(d * 16 + h) * 64 + p], a = ap[(d * 33 + tau) * 64 + p], b = bb[(d * 64 + p) * 16 + h2];
                const float tr = c.x * a.x - c.y * a.y, ti = c.x * a.y + c.y * a.x; s += tr * b.x - ti * b.y; }
            kt[i] = s; }
        __syncthreads();
        GAS bf16* MB = WSP(bf16, WS_S5MB) + (size_t)(l * 16 + g) * 768 * 512;
        GAS bf16* CS = WSP(bf16, WS_S5CS) + (size_t)(l * 16 + g) * 512 * 256;
        for (int i = F.tid; i < 512 * 64; i += NTHR) { const int n = i >> 6, k8 = (i & 63) * 8, t = n >> 4, h = n & 15, s = k8 >> 4, h0 = k8 & 15; float v[8];
#pragma unroll
            for (int j = 0; j < 8; ++j) { float x = 0.f; if (t >= s) x += kt[((0 * 32 + (t - s)) * 16 + h) * 16 + h0 + j]; if (s >= t) x += kt[((1 * 32 + (s - t)) * 16 + h) * 16 + h0 + j];
                if (t == s && h == h0 + j) x += in_S5D[l * 256 + g * 16 + h]; v[j] = x; }
            *(GAS v4u*)(MB + (size_t)n * 512 + k8) = (v4u){pk2(v[0], v[1]), pk2(v[2], v[3]), pk2(v[4], v[5]), pk2(v[6], v[7])}; }
        for (int i = F.tid; i < 256 * 64; i += NTHR) { const int n = i >> 6, k8 = (i & 63) * 8, d = n >> 7, im = (n >> 6) & 1, p = n & 63, s = k8 >> 4, h0 = k8 & 15; float v[8];
            const f32x2 a = ap[(d * 33 + (d == 0 ? 31 - s : s)) * 64 + p];
#pragma unroll
            for (int j = 0; j < 8; ++j) { const f32x2 b = bb[(d * 64 + p) * 16 + h0 + j]; v[j] = im ? (a.x * b.y + a.y * b.x) : (a.x * b.x - a.y * b.y); }
            *(GAS v4u*)(MB + (size_t)(512 + n) * 512 + k8) = (v4u){pk2(v[0], v[1]), pk2(v[2], v[3]), pk2(v[4], v[5]), pk2(v[6], v[7])}; }
        for (int i = F.tid; i < 512 * 32; i += NTHR) { const int n = i >> 5, k8 = (i & 31) * 8, t = n >> 4, h = n & 15, d = k8 >> 7, im = (k8 >> 6) & 1, p0 = k8 & 63; float v[8];
#pragma unroll
            for (int j = 0; j < 8; ++j) { const f32x2 c = cc[(d * 16 + h) * 64 + p0 + j], a = ap[(d * 33 + (d == 0 ? t + 1 : 32 - t)) * 64 + p0 + j];
                v[j] = im ? -(c.x * a.y + c.y * a.x) : (c.x * a.x - c.y * a.y); }
            *(GAS v4u*)(CS + (size_t)n * 256 + k8) = (v4u){pk2(v[0], v[1]), pk2(v[2], v[3]), pk2(v[4], v[5]), pk2(v[6], v[7])}; }
        __syncthreads();
    }
}

__device__ __forceinline__ f32x2 cmul(f32x2 a, f32x2 b) { return (f32x2){a.x * b.x - a.y * b.y, a.x * b.y + a.y * b.x}; }
__device__ __forceinline__ f32x2 twid(int p, float invB) { const float x = (float)p * invB; return (f32x2){__builtin_amdgcn_cosf(x), -__builtin_amdgcn_sinf(x)}; }
template <bool INV> __device__ __forceinline__ void bfly(f32x2& a, f32x2& b, f32x2 w) {
    if (!INV) { const f32x2 s = a + b, d = a - b; a = s; b = cmul(d, w); }
    else { const f32x2 t = cmul(b, (f32x2){w.x, -w.y}); const f32x2 s = a + t, d = a - t; a = s; b = d; }
}
#define FPAD(e) ((e) + ((e) >> 4))
template <bool INV> __device__ __forceinline__ void fft_r8(LAS f32x2* buf, int B, int tid) {
    const int S = B >> 3; const float iB = 1.f / (float)B;
#pragma unroll 1
    for (int gi = tid; gi < 1024; gi += NTHR) {
        const int blk = gi / S, j = gi - blk * S, base = blk * B + j;
        f32x2 x[8];
#pragma unroll
        for (int k = 0; k < 8; ++k) x[k] = buf[FPAD(base + k * S)];
        if (!INV) {
#pragma unroll
            for (int k = 0; k < 4; ++k) bfly<false>(x[k], x[k + 4], twid(j + k * S, iB));
#pragma unroll
            for (int hh = 0; hh < 8; hh += 4)
#pragma unroll
                for (int k = 0; k < 2; ++k) bfly<false>(x[hh + k], x[hh + k + 2], twid(j + k * S, 2.f * iB));
            const f32x2 w = twid(j, 4.f * iB);
#pragma unroll
            for (int q = 0; q < 8; q += 2) bfly<false>(x[q], x[q + 1], w);
        } else {
            const f32x2 w = twid(j, 4.f * iB);
#pragma unroll
            for (int q = 0; q < 8; q += 2) bfly<true>(x[q], x[q + 1], w);
#pragma unroll
            for (int hh = 0; hh < 8; hh += 4)
#pragma unroll
                for (int k = 0; k < 2; ++k) bfly<true>(x[hh + k], x[hh + k + 2], twid(j + k * S, 2.f * iB));
#pragma unroll
            for (int k = 0; k < 4; ++k) bfly<true>(x[k], x[k + 4], twid(j + k * S, iB));
        }
#pragma unroll
        for (int k = 0; k < 8; ++k) buf[FPAD(base + k * S)] = x[k];
    }
    __syncthreads();
}
__device__ __forceinline__ void fft_r2(LAS f32x2* buf, int tid) {
    for (int i = tid; i < 4096; i += NTHR) { const int e0 = FPAD(2 * i); const f32x2 a = buf[e0], b = buf[e0 + 1]; buf[e0] = a + b; buf[e0 + 1] = a - b; }
    __syncthreads();
}
__device__ __forceinline__ void fft_fwd(LAS f32x2* buf, int tid) { fft_r8<false>(buf, 8192, tid); fft_r8<false>(buf, 1024, tid); fft_r8<false>(buf, 128, tid); fft_r8<false>(buf, 16, tid); fft_r2(buf, tid); }
__device__ __forceinline__ void fft_inv(LAS f32x2* buf, int tid) { fft_r2(buf, tid); fft_r8<true>(buf, 16, tid); fft_r8<true>(buf, 128, tid); fft_r8<true>(buf, 1024, tid); fft_r8<true>(buf, 8192, tid); }

constexpr float HY_DMIN = 3.0701134573253946f, HY_DMAX = 15.350567286626973f;
__device__ __forceinline__ float block_sum(float v, LAS float* red, int tid) {
    v = wave_sum(v); __syncthreads(); if ((tid & 63) == 0) red[tid >> 6] = v; __syncthreads();
    float s = 0.f;
#pragma unroll
    for (int w = 0; w < NWAVES; ++w) s += red[w];
    return s;
}
__device__ __forceinline__ void p0_filters(Frame& F) {
    const GAS float* const in_HYSKIP = inptr(I_HYSKIP);
    const GAS float* const in_HYW3 = inptr(I_HYW3);
    LAS f32x2* buf = (LAS f32x2*)F.lds; LAS float* w3s = (LAS float*)(F.lds + 69632); LAS float* red = w3s + 128;
    for (int unit = F.vcu; unit < DEPTH * 256; unit += F.G) {
        const int l = unit >> 8, c = unit & 255;
        if (F.tid < 128) w3s[F.tid] = in_HYW3[(size_t)l * 64 * 512 + (F.tid & 63) * 512 + (F.tid >> 6) * 256 + c];
        __syncthreads();
        const float decay = HY_DMIN + (HY_DMAX - HY_DMIN) * (float)c / 255.f;
        float asum = 0.f;
#pragma unroll 1
        for (int i = 0; i < 16; ++i) { const int n = F.tid + NTHR * i; float v = 0.f;
            if (n != SEQ) { const int pos = n < SEQ ? n : 2 * SEQ - n; const LAS float* w = w3s + (n < SEQ ? 0 : 64); const GAS f32x4* hp = (const GAS f32x4*)(WSP(float, WS_H2T) + ((size_t)l * SEQ + pos) * 64);
                float s = 0.f;
#pragma unroll
                for (int q = 0; q < 16; ++q) { const f32x4 h = hp[q]; s += h.x * w[4 * q] + h.y * w[4 * q + 1] + h.z * w[4 * q + 2] + h.w * w[4 * q + 3]; }
                v = s * expf(-((float)pos / (float)SEQ) * decay); }
            buf[FPAD(n)] = (f32x2){v, 0.f}; asum += fabsf(v); }
        const float tot = block_sum(asum, red, F.tid); const float nrm = 1.f / (tot + EPSF);
        for (int i = 0; i < 16; ++i) { const int n = F.tid + NTHR * i; f32x2 v = buf[FPAD(n)]; v.x = v.x * nrm + (n == 0 ? in_HYSKIP[l * 256 + c] : 0.f); buf[FPAD(n)] = v; }
        __syncthreads();
        fft_fwd(buf, F.tid);
        GAS f32x2* dst = WSP(f32x2, WS_FSPEC) + (size_t)unit * 8192;
        for (int i = F.tid; i < 8192; i += NTHR) dst[i] = buf[FPAD(i)] * (1.f / 8192.f);
        __syncthreads();
    }
    LAS float* red2 = (LAS float*)(F.lds + 1024);
    LAS float* w3c = (LAS float*)F.lds;
    for (int unit = F.vcu; unit < DEPTH * 256; unit += F.G) {
        const int l = unit >> 8, c = unit & 255, n = F.tid;
        if (F.tid < 128) w3c[F.tid] = in_HYW3[(size_t)l * 64 * 512 + (F.tid & 63) * 512 + (F.tid >> 6) * 256 + c];
        __syncthreads();
        const float decay = HY_DMIN + (HY_DMAX - HY_DMIN) * (float)c / 255.f; float v = 0.f;
        if (n != CTXL) { const int pos = n < CTXL ? n : 2 * CTXL - n; const LAS float* w = w3c + (n < CTXL ? 0 : 64); const GAS float* hp = WSP(float, WS_H2C) + ((size_t)l * CTXL + pos) * 64; float s = 0.f;
            for (int q = 0; q < 64; ++q) s += hp[q] * w[q];
            v = s * expf(-((float)pos / (float)CTXL) * decay); }
        const float tot = block_sum(fabsf(v), red2, F.tid);
        WSP(float, WS_FC)[(size_t)unit * 512 + n] = v / (tot + EPSF) + (n == 0 ? in_HYSKIP[l * 256 + c] : 0.f);
        __syncthreads();
    }
}
__device__ __forceinline__ float sconv(const GAS bf16* P, int r0, int len, int t, int col, float w0, float w1, float w2, float bias) {
    const GAS bf16* p = P + (size_t)(r0 + t) * INC + col;
    const float a = t > 0 ? bf2f(p[-INC]) : 0.f, b = bf2f(p[0]), c = t + 1 < len ? bf2f(p[INC]) : 0.f;
    return a * w0 + b * w1 + c * w2 + bias;
}
__device__ __forceinline__ void hypre_unit(Frame& F, int l, int unit) {
    const GAS float* const in_HYCB = inptr(I_HYCB);
    const GAS float* const in_HYCW = inptr(I_HYCW);
    LAS float* zt = (LAS float*)F.lds;
    const int r0 = unit * 64; const bool isc = r0 >= ML; const int b = isc ? (r0 - ML) / CTXL : r0 / SEQ; const int len = isc ? CTXL : SEQ;
    const int seq0 = isc ? ML + b * CTXL : b * SEQ, t0 = r0 - seq0;
    const GAS bf16* P = WSP(bf16, WS_P); const GAS float* cw = in_HYCW + (size_t)l * 3 * 768; const GAS float* cb = in_HYCB + (size_t)l * 768;
    const int c4 = 4 * F.lane;
    const f32x4 a0 = *(const GAS f32x4*)(cw + 256 + c4), a1 = *(const GAS f32x4*)(cw + 768 + 256 + c4), a2 = *(const GAS f32x4*)(cw + 1536 + 256 + c4), ab = *(const GAS f32x4*)(cb + 256 + c4);
    const f32x4 v0 = *(const GAS f32x4*)(cw + 512 + c4), v1 = *(const GAS f32x4*)(cw + 768 + 512 + c4), v2 = *(const GAS f32x4*)(cw + 1536 + 512 + c4), vb = *(const GAS f32x4*)(cb + 512 + c4);
    auto ld4 = [&](int t, int col) -> f32x4 { if (t < 0 || t >= len) return (f32x4){0.f, 0.f, 0.f, 0.f}; const v2u u = *(const GAS v2u*)(P + (size_t)(seq0 + t) * INC + col + c4); return (f32x4){bflo(u.x), bfhi(u.x), bflo(u.y), bfhi(u.y)}; };
    const int tb = t0 + 8 * F.wave;
    f32x4 xp = ld4(tb - 1, 256), xc = ld4(tb, 256), vp = ld4(tb - 1, 512), vc = ld4(tb, 512);
#pragma unroll
    for (int k = 0; k < 8; ++k) { const f32x4 xn = ld4(tb + k + 1, 256), vn = ld4(tb + k + 1, 512);
        const f32x4 z = (xp * a0 + xc * a1 + xn * a2 + ab) * (vp * v0 + vc * v1 + vn * v2 + vb); const int tl = 8 * F.wave + k;
        zt[(c4 + 0) * 65 + tl] = z.x; zt[(c4 + 1) * 65 + tl] = z.y; zt[(c4 + 2) * 65 + tl] = z.z; zt[(c4 + 3) * 65 + tl] = z.w;
        xp = xc; xc = xn; vp = vc; vc = vn; }
    __syncthreads();
    GAS float* dst = isc ? WSP(float, WS_HYWC) + (size_t)b * 256 * CTXL : WSP(float, WS_HYW) + (size_t)b * 256 * SEQ;
    for (int i = F.tid; i < 256 * 16; i += NTHR) { const int c = i >> 4, q = i & 15; const LAS float* s = zt + c * 65 + 4 * q;
        *(GAS f32x4*)(dst + (size_t)c * len + t0 + 4 * q) = (f32x4){s[0], s[1], s[2], s[3]}; }
    __syncthreads();
}
__device__ __forceinline__ void hyena_unit(Frame& F, int l, int unit) {
    LAS f32x2* buf = (LAS f32x2*)F.lds;
    const int c = unit >> 2, bp = unit & 3;
    GAS float* o0 = WSP(float, WS_HYW) + ((size_t)(2 * bp) * 256 + c) * SEQ; GAS float* o1 = o0 + (size_t)256 * SEQ;
    for (int i = F.tid; i < SEQ / 4; i += NTHR) { const f32x4 za = *(const GAS f32x4*)(o0 + 4 * i), zb = *(const GAS f32x4*)(o1 + 4 * i); const int e = FPAD(4 * i);
        buf[e] = (f32x2){za.x, zb.x}; buf[e + 1] = (f32x2){za.y, zb.y}; buf[e + 2] = (f32x2){za.z, zb.z}; buf[e + 3] = (f32x2){za.w, zb.w}; }
    for (int i = F.tid; i < SEQ; i += NTHR) buf[FPAD(SEQ + i)] = (f32x2){0.f, 0.f};
    __syncthreads();
#if defined(DUP_MASK) && ((DUP_MASK >> 13) & 1)
    fft_fwd(buf, F.tid); fft_inv(buf, F.tid); for (int i = F.tid; i < 8704; i += NTHR) buf[i] = buf[i] * (1.f / 8192.f); __syncthreads();
#endif
    fft_fwd(buf, F.tid);
    const GAS f32x2* fs = WSP(f32x2, WS_FSPEC) + (size_t)(l * 256 + c) * 8192;
    for (int i = F.tid; i < 8192; i += NTHR) { const int e = FPAD(i); buf[e] = cmul(buf[e], fs[i]); }
    __syncthreads();
    fft_inv(buf, F.tid);
    for (int i = F.tid; i < SEQ / 4; i += NTHR) { const int e = FPAD(4 * i); const f32x2 p0 = buf[e], p1 = buf[e + 1], p2 = buf[e + 2], p3 = buf[e + 3];
        *(GAS f32x4*)(o0 + 4 * i) = (f32x4){p0.x, p1.x, p2.x, p3.x}; *(GAS f32x4*)(o1 + 4 * i) = (f32x4){p0.y, p1.y, p2.y, p3.y}; }
    __syncthreads();
}
__device__ __forceinline__ void hyena_ctx_unit(Frame& F, int l, int c) {
    LAS float* z = (LAS float*)F.lds; LAS float* fc = z + NB * CTXL;
    fc[F.tid] = WSP(float, WS_FC)[(size_t)(l * 256 + c) * 512 + F.tid];
    for (int i = F.tid; i < NB * CTXL; i += NTHR) { const int b = i >> 8, t = i & 255; z[i] = WSP(float, WS_HYWC)[((size_t)b * 256 + c) * CTXL + t]; }
    __syncthreads();
    for (int i = F.tid; i < NB * CTXL; i += NTHR) { const int b = i >> 8, t = i & 255; float s = 0.f;
        for (int k = 0; k < CTXL; ++k) s += fc[(t - k) & 511] * z[b * CTXL + k];
        WSP(float, WS_HYWC)[((size_t)b * 256 + c) * CTXL + t] = s; }
    __syncthreads();
}
__device__ __forceinline__ void hyena_fin_unit(Frame& F, int l, int unit) {
    const GAS float* const in_HYCB = inptr(I_HYCB);
    const GAS float* const in_HYCW = inptr(I_HYCW);
    const GAS float* const in_HYNG = inptr(I_HYNG);
    LAS float* wt = (LAS float*)F.lds;
    const int r0 = unit * 64; const bool isc = r0 >= ML; const int b = isc ? (r0 - ML) / CTXL : r0 / SEQ; const int len = isc ? CTXL : SEQ;
    const int seq0 = isc ? ML + b * CTXL : b * SEQ, t0 = r0 - seq0;
    const GAS float* src = isc ? WSP(float, WS_HYWC) + (size_t)b * 256 * CTXL : WSP(float, WS_HYW) + (size_t)b * 256 * SEQ;
    for (int i = F.tid; i < 256 * 16; i += NTHR) { const int c = i >> 4, q = i & 15; const f32x4 v = *(const GAS f32x4*)(src + (size_t)c * len + t0 + 4 * q);
        wt[c * 65 + 4 * q] = v.x; wt[c * 65 + 4 * q + 1] = v.y; wt[c * 65 + 4 * q + 2] = v.z; wt[c * 65 + 4 * q + 3] = v.w; }
    __syncthreads();
    const GAS bf16* P = WSP(bf16, WS_P); const GAS float* cw = in_HYCW + (size_t)l * 3 * 768; const GAS float* cb = in_HYCB + (size_t)l * 768;
    for (int tt = 0; tt < 8; ++tt) { const int tl = F.wave * 8 + tt, t = t0 + tl; float v[4]; float ss = 0.f;
#pragma unroll
        for (int j = 0; j < 4; ++j) { const int c = F.lane + 64 * j; const float x0 = sconv(P, seq0, len, t, c, cw[c], cw[768 + c], cw[1536 + c], cb[c]); v[j] = x0 * wt[c * 65 + tl]; ss += v[j] * v[j]; }
        const float rs = rsqrtf(wave_sum(ss) * (1.f / 256.f) + EPSF);
#pragma unroll
        for (int j = 0; j < 4; ++j) { const int c = F.lane + 64 * j; WSP(bf16, WS_MIX)[(size_t)(r0 + tl) * DM + c] = (bf16)f2bf(v[j] * rs * in_HYNG[l * 256 + c]); }
    }
    __syncthreads();
}

__device__ __forceinline__ void n1_phase(Frame& F, int l) {
    const GAS float* const in_CTX = inptr(I_CTX);
    const GAS float* const in_FING = inptr(I_FING);
    const GAS float* const in_N1G = inptr(I_N1G);
    const GAS float* const in_X = inptr(I_X);
    const int gw = F.vcu * NWAVES + F.wave, NGW = F.G * NWAVES;
    const int nblk = (l == DEPTH ? ML : MT) / 4;
    constexpr int NR = 4;
    for (int blk = gw; blk < nblk; blk += NGW) {
        const int r0 = blk * NR; const int bi = r0 < ML ? r0 >> 12 : 8;
        f32x4 v[NR][4];
        if (l == 0) {
#pragma unroll
            for (int k = 0; k < NR; ++k) { const int r = r0 + k; const GAS float* src = r < ML ? in_X + (size_t)r * DM : in_CTX + (size_t)(r - ML) * DM;
#pragma unroll
                for (int j = 0; j < 4; ++j) v[k][j] = *(const GAS f32x4*)(src + 4 * F.lane + 256 * j); }
        } else {
            const GAS int* ts = (const GAS int*)(F.ws + WS_TOK + TK_SLOT) + 2 * r0; int sl[2 * NR];
#pragma unroll
            for (int k = 0; k < 2 * NR; ++k) sl[k] = ts[k];
            const GAS float* g2 = WSP(float, WS_MODV) + (size_t)((l - 1) * 9 + bi) * NMOD + 5 * DM;
            v2u ya[NR][4], yb[NR][4];
#pragma unroll
            for (int k = 0; k < NR; ++k) { const GAS float* src = WSP(float, WS_X) + (size_t)(r0 + k) * DM; const GAS bf16* pa = WSP(bf16, WS_YB) + (size_t)sl[2 * k] * DM; const GAS bf16* pb = WSP(bf16, WS_YB) + (size_t)sl[2 * k + 1] * DM;
#pragma unroll
                for (int j = 0; j < 4; ++j) { const int c = 4 * F.lane + 256 * j; v[k][j] = *(const GAS f32x4*)(src + c); ya[k][j] = *(const GAS v2u*)(pa + c); yb[k][j] = *(const GAS v2u*)(pb + c); } }
#pragma unroll
            for (int j = 0; j < 4; ++j) { const f32x4 g = *(const GAS f32x4*)(g2 + 4 * F.lane + 256 * j);
#pragma unroll
                for (int k = 0; k < NR; ++k) { const v2u a = ya[k][j], b = yb[k][j];
                    v[k][j] = v[k][j] + g * (f32x4){bflo(a.x) + bflo(b.x), bfhi(a.x) + bfhi(b.x), bflo(a.y) + bflo(b.y), bfhi(a.y) + bfhi(b.y)}; } }
        }
        float rs[NR];
#pragma unroll
        for (int k = 0; k < NR; ++k) { float ss = 0.f;
#pragma unroll
            for (int j = 0; j < 4; ++j) ss += v[k][j].x * v[k][j].x + v[k][j].y * v[k][j].y + v[k][j].z * v[k][j].z + v[k][j].w * v[k][j].w;
            rs[k] = ss; }
#pragma unroll
        for (int k = 0; k < NR; ++k) rs[k] = rsqrtf(wave_sum(rs[k]) * (1.f / DM) + EPSF);
        if (l == DEPTH) {
#pragma unroll
            for (int j = 0; j < 4; ++j) { const int c = 4 * F.lane + 256 * j; const f32x4 fg = *(const GAS f32x4*)(in_FING + c);
#pragma unroll
                for (int k = 0; k < NR; ++k) *(GAS f32x4*)(F.out + (size_t)(r0 + k) * DM + c) = v[k][j] * rs[k] * fg; }
        } else {
            const GAS float* mv = WSP(float, WS_MODV) + (size_t)(l * 9 + bi) * NMOD; const GAS float* ng = in_N1G + l * DM;
#pragma unroll
            for (int j = 0; j < 4; ++j) { const int c = 4 * F.lane + 256 * j; const f32x4 am = *(const GAS f32x4*)(ng + c) * (1.f + *(const GAS f32x4*)(mv + DM + c)), sh = *(const GAS f32x4*)(mv + c);
#pragma unroll
                for (int k = 0; k < NR; ++k) { *(GAS f32x4*)(WSP(float, WS_X) + (size_t)(r0 + k) * DM + c) = v[k][j];
                    const f32x4 h = v[k][j] * rs[k] * am + sh;
                    *(GAS v2u*)(WSP(bf16, WS_H) + (size_t)(r0 + k) * DM + c) = (v2u){pk2(h.x, h.y), pk2(h.z, h.w)}; } }
        }
    }
}
__device__ __forceinline__ void n2r_phase(Frame& F, int l) {
    const GAS float* const in_MBE = inptr(I_MBE);
    const GAS float* const in_MBG = inptr(I_MBG);
    const GAS float* const in_N2G = inptr(I_N2G);
    const int rr = F.lane & 15, q = F.lane >> 4, w = F.wave;
    LAS int* lhist = (LAS int*)F.lds;
    LAS float* rsb = (LAS float*)(F.lds + 128);
    LAS float* modA = (LAS float*)(F.lds + 256);
    LAS float* modS = modA + 1024;
    LAS float* part = modS + 1024;
    if (F.tid < 32) lhist[F.tid] = 0;
    const GAS bf16* wge = WSP(bf16, WS_WGE) + (size_t)l * 2 * 48 * 1024 + (size_t)rr * 1024 + 128 * w + 8 * q;
    bf16x8 wf[4][3][2];
#pragma unroll
    for (int c = 0; c < 4; ++c)
#pragma unroll
        for (int t = 0; t < 3; ++t)
#pragma unroll
            for (int hl = 0; hl < 2; ++hl) wf[c][t][hl] = *(const GAS bf16x8*)(wge + (size_t)(hl * 48 + t * 16) * 1024 + 32 * c);
    const GAS float* ng = in_N2G + l * DM;
#pragma unroll 1
    for (int it = 0; ; ++it) {
        const int grp = F.vcu + it * F.G; if (grp >= MT / 16) break;
        const int r0 = grp * 16, r = r0 + rr, par = it & 1; const int bi = r0 < ML ? r0 >> 12 : 8;
        const GAS float* mv = WSP(float, WS_MODV) + (size_t)(l * 9 + bi) * NMOD;
        const GAS float* xr = WSP(float, WS_X) + (size_t)r * DM + 128 * w + 8 * q; f32x4 xa[4], xb[4];
#pragma unroll
        for (int c = 0; c < 4; ++c) { xa[c] = *(const GAS f32x4*)(xr + 32 * c); xb[c] = *(const GAS f32x4*)(xr + 32 * c + 4); }
        { float s2[2];
#pragma unroll
          for (int k = 0; k < 2; ++k) { const GAS float* xs = WSP(float, WS_X) + (size_t)(r0 + 2 * w + k) * DM + 4 * F.lane; float ss = 0.f;
#pragma unroll
              for (int j = 0; j < 4; ++j) { const f32x4 x = *(const GAS f32x4*)(xs + 256 * j); ss += x.x * x.x + x.y * x.y + x.z * x.z + x.w * x.w; }
              s2[k] = ss; }
          if (F.tid < 256) { const int c = 4 * F.tid; *(LAS f32x4*)(modA + c) = *(const GAS f32x4*)(ng + c) * (1.f + *(const GAS f32x4*)(mv + 4 * DM + c)); *(LAS f32x4*)(modS + c) = *(const GAS f32x4*)(mv + 3 * DM + c); }
#pragma unroll
          for (int k = 0; k < 2; ++k) { const float t = wave_sum(s2[k]); if (F.lane == 0) rsb[2 * w + k] = rsqrtf(t * (1.f / DM) + EPSF); } }
        __syncthreads();
        const float rs = rsb[rr];
        f32x4 d0 = {0.f, 0.f, 0.f, 0.f}, d1 = d0, d2 = d0;
        GAS bf16* hrow = WSP(bf16, WS_H) + (size_t)r * DM + 128 * w + 8 * q;
#pragma unroll
        for (int c = 0; c < 4; ++c) { const int col = 128 * w + 32 * c + 8 * q;
            const f32x4 h0 = xa[c] * rs * *(LAS f32x4*)(modA + col) + *(LAS f32x4*)(modS + col);
            const f32x4 h1 = xb[c] * rs * *(LAS f32x4*)(modA + col + 4) + *(LAS f32x4*)(modS + col + 4);
            const v4u hh = {pk2(h0.x, h0.y), pk2(h0.z, h0.w), pk2(h1.x, h1.y), pk2(h1.z, h1.w)};
            *(GAS v4u*)(hrow + 32 * c) = hh;
            const v4u hl = {pk2(h0.x - bflo(hh.x), h0.y - bfhi(hh.x)), pk2(h0.z - bflo(hh.y), h0.w - bfhi(hh.y)), pk2(h1.x - bflo(hh.z), h1.y - bfhi(hh.z)), pk2(h1.z - bflo(hh.w), h1.w - bfhi(hh.w))};
            const bf16x8 bh = __builtin_bit_cast(bf16x8, hh), bl = __builtin_bit_cast(bf16x8, hl);
            d0 = __builtin_amdgcn_mfma_f32_16x16x32_bf16(wf[c][0][0], bh, d0, 0, 0, 0); d1 = __builtin_amdgcn_mfma_f32_16x16x32_bf16(wf[c][1][0], bh, d1, 0, 0, 0); d2 = __builtin_amdgcn_mfma_f32_16x16x32_bf16(wf[c][2][0], bh, d2, 0, 0, 0);
            d0 = __builtin_amdgcn_mfma_f32_16x16x32_bf16(wf[c][0][0], bl, d0, 0, 0, 0); d1 = __builtin_amdgcn_mfma_f32_16x16x32_bf16(wf[c][1][0], bl, d1, 0, 0, 0); d2 = __builtin_amdgcn_mfma_f32_16x16x32_bf16(wf[c][2][0], bl, d2, 0, 0, 0);
            d0 = __builtin_amdgcn_mfma_f32_16x16x32_bf16(wf[c][0][1], bh, d0, 0, 0, 0); d1 = __builtin_amdgcn_mfma_f32_16x16x32_bf16(wf[c][1][1], bh, d1, 0, 0, 0); d2 = __builtin_amdgcn_mfma_f32_16x16x32_bf16(wf[c][2][1], bh, d2, 0, 0, 0); }
        { LAS float* pp = part + ((par * 8 + w) * 12) * 64 + F.lane;
          pp[0] = d0.x; pp[64] = d0.y; pp[128] = d0.z; pp[192] = d0.w; pp[256] = d1.x; pp[320] = d1.y; pp[384] = d1.z; pp[448] = d1.w; pp[512] = d2.x; pp[576] = d2.y; pp[640] = d2.z; pp[704] = d2.w; }
        __syncthreads();
        if (w == 0) {
            float dd[12];
#pragma unroll
            for (int i = 0; i < 12; ++i) { float s = 0.f;
#pragma unroll
                for (int ww = 0; ww < 8; ++ww) s += part[((par * 8 + ww) * 12 + i) * 64 + F.lane];
                dd[i] = s; }
            int G = 0; float pg = 0.f;
            { const float g0 = dd[8] + in_MBG[l * 4], g1 = dd[9] + in_MBG[l * 4 + 1], g2 = dd[10] + in_MBG[l * 4 + 2], g3 = dd[11] + in_MBG[l * 4 + 3]; float m = g0; G = 0;
              if (g1 > m) { m = g1; G = 1; } if (g2 > m) { m = g2; G = 2; } if (g3 > m) { m = g3; G = 3; }
              pg = 1.f / (fexp(g0 - m) + fexp(g1 - m) + fexp(g2 - m) + fexp(g3 - m)); }
            G = __builtin_amdgcn_ds_bpermute(rr << 2, G);
            const bool hiT = (G >> 1) != 0;
            float ev[8];
#pragma unroll
            for (int j = 0; j < 8; ++j) { const int src = rr + 16 * (2 * (G & 1) + (j >> 2)); const float x = hiT ? dd[4 + (j & 3)] : dd[j & 3];
                ev[j] = __builtin_bit_cast(float, __builtin_amdgcn_ds_bpermute(src << 2, __builtin_bit_cast(int, x))); }
            if (q == 0) {
#pragma unroll
                for (int j = 0; j < 8; ++j) ev[j] += in_MBE[l * 32 + G * 8 + j];
                int ia = 0; float ma = ev[0];
#pragma unroll
                for (int j = 1; j < 8; ++j) if (ev[j] > ma) { ma = ev[j]; ia = j; }
                int ib = -1; float mb = -3.0e38f;
#pragma unroll
                for (int j = 0; j < 8; ++j) if (j != ia && ev[j] > mb) { mb = ev[j]; ib = j; }
                const float eb = fexp(mb - ma); const float ga = pg / (1.f + eb), gb = pg * eb / (1.f + eb);
                const int ea = G * 8 + ia, eb_ = G * 8 + ib;
                const int pa = __hip_atomic_fetch_add(lhist + ea, 1, __ATOMIC_RELAXED, __HIP_MEMORY_SCOPE_WORKGROUP), pb = __hip_atomic_fetch_add(lhist + eb_, 1, __ATOMIC_RELAXED, __HIP_MEMORY_SCOPE_WORKGROUP);
                GAS int* te = (GAS int*)(F.ws + WS_TOK + TK_E) + 2 * r; GAS int* tp = (GAS int*)(F.ws + WS_TOK + TK_POS) + 2 * r; GAS float* tg = (GAS float*)(F.ws + WS_TOK + TK_GATE) + 2 * r;
                te[0] = ea; te[1] = eb_; tp[0] = pa; tp[1] = pb; tg[0] = ga; tg[1] = gb;
            }
        }
    }
    __syncthreads();
    if (F.tid < 32) ((GAS int*)(F.ws + WS_TOK + TK_HIST))[F.vcu * 32 + F.tid] = lhist[F.tid];
    __syncthreads();
}
__device__ __forceinline__ void assign_phase(Frame& F, int l) {
    LAS int* base = (LAS int*)F.lds;
    LAS int* ps = base + 256 * 32;
    const GAS int* hist = (const GAS int*)(F.ws + WS_TOK + TK_HIST);
    if (F.tid < 32) { int c = 0; for (int w = 0; w < F.G; ++w) c += hist[w * 32 + F.tid]; ps[32 + F.tid] = c; }
    __syncthreads();
    if (F.tid == 0) { int acc = 0; for (int e = 0; e < NEXP; ++e) { ps[e] = acc; acc += (ps[32 + e] + 255) / 256 * 256; } ps[64] = acc; }
    __syncthreads();
    if (F.tid < 32) { int acc = ps[F.tid]; for (int w = 0; w < F.G; ++w) { base[w * 32 + F.tid] = acc; acc += hist[w * 32 + F.tid]; } }
    __syncthreads();
    GAS int* stok = (GAS int*)(F.ws + WS_TOK + TK_STOK); GAS float* sgate = (GAS float*)(F.ws + WS_TOK + TK_SGATE); GAS int* tslot = (GAS int*)(F.ws + WS_TOK + TK_SLOT);
    const GAS int* te = (const GAS int*)(F.ws + WS_TOK + TK_E); const GAS int* tp = (const GAS int*)(F.ws + WS_TOK + TK_POS); const GAS float* tg = (const GAS float*)(F.ws + WS_TOK + TK_GATE);
    for (int i = F.vcu * NTHR + F.tid; i < MT * 2; i += F.G * NTHR) { const int r = i >> 1, w = (r >> 4) % F.G;
        const int dest = base[w * 32 + te[i]] + tp[i]; stok[dest] = r; sgate[dest] = tg[i]; tslot[i] = dest; }
    for (int i = F.vcu * NTHR + F.tid; i < NEXP * 256; i += F.G * NTHR) { const int e = i >> 8, j = i & 255, c = ps[32 + e], rem = c & 255;
        if (rem != 0 && j >= rem) { const int dest = ps[e] + (c & ~255) + j; stok[dest] = MT; sgate[dest] = 0.f; } }
    if (F.bx == 0) { GAS int* tile_e = (GAS int*)(F.ws + WS_TOK + TK_TILEE); const int nt = ps[64] / 256;
        for (int t = F.tid; t < nt; t += NTHR) { int e = 0; for (int k = 1; k < NEXP; ++k) if (t * 256 >= ps[k]) e = k; tile_e[t] = e; }
        if (F.tid == 0) __hip_atomic_store(F.ctl + CW_NTILES + l, (unsigned)nt, RLX_AGENT); }
    __syncthreads();
}
__device__ __forceinline__ void s5_scan_phase(Frame& F, int l) {
    const GAS float* const in_S5AIM = inptr(I_S5AIM);
    const GAS float* const in_S5ARE = inptr(I_S5ARE);
    const GAS float* const in_S5LDT = inptr(I_S5LDT);
    LAS f32x2* sb = (LAS f32x2*)F.lds;
    const int item = F.vcu * 64 + F.lane;
    for (int it0 = F.vcu * 64; it0 < NB * 16 * 2 * 64; it0 += F.G * 64) {
        const int it = it0 + F.lane; (void)item;
        const int p = it & 63, d = (it >> 6) & 1, g = (it >> 7) & 15, b = it >> 11;
        const GAS float* ST = WSP(float, WS_ST) + (size_t)g * S5RP * 256 + d * 128 + p; GAS bf16* HIN = WSP(bf16, WS_HIN) + (size_t)g * S5RP * 256 + d * 128 + p;
#define S5_ROW(step) ((d == 0) ? ((step) < 8 ? 1024 + b * 8 + (step) : b * 128 + ((step) - 8)) : ((step) < 8 ? 1024 + b * 8 + (7 - (step)) : b * 128 + (135 - (step))))
#pragma unroll
        for (int k = 0; k < 17; ++k) { const int step = F.wave * 17 + k; const int row = S5_ROW(step); sb[step * 64 + F.lane] = (f32x2){ST[(size_t)row * 256], ST[(size_t)row * 256 + 64]}; }
        __syncthreads();
        if (F.wave == 0) {
            const int pi = ((l * 2 + d) * 16 + g) * 64 + p; const float dt = expf(in_S5LDT[(l * 2 + d) * 16 + g]);
            const float m = expf(32.f * dt * in_S5ARE[pi]), ang = 32.f * dt * in_S5AIM[pi]; const float ar = m * cosf(ang), ai = m * sinf(ang);
            float hr = 0.f, hi = 0.f;
#pragma unroll 4
            for (int step = 0; step < 136; ++step) { const int row = S5_ROW(step);
                HIN[(size_t)row * 256] = (bf16)f2bf(hr); HIN[(size_t)row * 256 + 64] = (bf16)f2bf(hi);
                const f32x2 sv = sb[step * 64 + F.lane]; const float nr = ar * hr - ai * hi + sv.x, ni = ar * hi + ai * hr + sv.y; hr = nr; hi = ni; }
        }
        __syncthreads();
#undef S5_ROW
    }
}

struct ListOrder {
    int n, per, ncol, rowmul, colmul, G, c;
    __device__ __forceinline__ bool next(int i, pg8::Unit& u) const { const int L = i * G + c; if (L >= n) return false; const int a = L / per, r = L - a * per; u.pm = rowmul * a + r / ncol; u.pn = colmul * a + r % ncol; return true; }
    __device__ __forceinline__ void a_ready(const pg8::Unit&) const {}
    __device__ __forceinline__ void done(const pg8::Unit&) const {}
};
struct MoeOrder {
    const GAS int* tile_e; int ntiles, G, c;
    __device__ __forceinline__ bool next(int i, pg8::Unit& u) const { const int L = i * G + c; if (L >= ntiles * 4) return false; const int t = L >> 2; u.pm = t; u.pn = tile_e[t] * 4 + (L & 3); return true; }
    __device__ __forceinline__ void a_ready(const pg8::Unit&) const {}
    __device__ __forceinline__ void done(const pg8::Unit&) const {}
};
using pg8::Unit; using pg8::HALF; using pg8::BM;
#define EPI_ROWS_BEGIN  _Pragma("unroll") for (int ai = 0; ai < 2; ++ai) _Pragma("unroll") for (int m = 0; m < 4; ++m) { const int row = u.pm * BM + ai * HALF + wr * 64 + m * 16 + fr;
#define EPI_ROWS_END asm volatile("" ::: "memory"); }
__device__ __forceinline__ v4u pack8(const f32x4 a, const f32x4 b) { return (v4u){pk2(a.x, a.y), pk2(a.z, a.w), pk2(b.x, b.y), pk2(b.z, b.w)}; }
struct EpiG1 {
    static constexpr bool PERM = true, AFTER_DRAIN = false;
    GAS bf16* P; GAS bf16* QR; GAS bf16* U5; const GAS f32x2* rope;
    __device__ __forceinline__ void operator()(const f32x4 (&acc)[2][2][4][2], const Unit& u, int wr, int wc, int fr, int fq) const {
        const int pn = u.pn; const bool lat = u.pm < ML / BM;
        EPI_ROWS_BEGIN
#pragma unroll
            for (int bj = 0; bj < 2; ++bj) { const int cl = bj * HALF + wc * 32 + 8 * fq, col = pn * BM + cl; const f32x4 v0 = acc[ai][bj][m][0], v1 = acc[ai][bj][m][1];
                if (pn == 3) { const int g = cl >> 4, h0 = cl & 15; *(GAS v4u*)(U5 + ((size_t)g * S5RP + (row >> 5)) * 512 + (row & 31) * 16 + h0) = pack8(v0, v1); }
                else if (pn >= 4 && pn < 8) {
                    const bool isq = pn < 6;
                    if (isq || !lat) *(GAS v4u*)(P + (size_t)row * INC + col) = pack8(v0, v1);
                    if (lat) { const int j0 = (cl & 63) >> 1; const GAS f32x4* rp = (const GAS f32x4*)(rope + (size_t)(row & (SEQ - 1)) * 32 + j0); const f32x4 c0 = rp[0], c1 = rp[1];
                        const f32x4 r0 = {v0.x * c0.x - v0.y * c0.y, v0.x * c0.y + v0.y * c0.x, v0.z * c0.z - v0.w * c0.w, v0.z * c0.w + v0.w * c0.z};
                        const f32x4 r1 = {v1.x * c1.x - v1.y * c1.y, v1.x * c1.y + v1.y * c1.x, v1.z * c1.z - v1.w * c1.w, v1.z * c1.w + v1.w * c1.z};
                        if (isq) *(GAS v4u*)(QR + (size_t)row * 512 + (col - C_Q)) = pack8(r0, r1); else *(GAS v4u*)(P + (size_t)row * INC + col) = pack8(r0, r1); }
                } else *(GAS v4u*)(P + (size_t)row * INC + col) = pack8(v0, v1);
            }
        EPI_ROWS_END
    }
};
struct EpiG2 {
    static constexpr bool PERM = false, AFTER_DRAIN = false;
    GAS float* X; const GAS float* modv_l; float sgn;
    __device__ __forceinline__ void operator()(const f32x4 (&acc)[2][2][4][2], const Unit& u, int wr, int wc, int fr, int fq) const {
        const int bi = u.pm < ML / BM ? u.pm >> 4 : 8; const GAS float* g1 = modv_l + (size_t)bi * NMOD + 2 * DM; const int col0 = u.pn * BM + wc * 32 + 4 * fq;
        f32x4 gv[2][2];
#pragma unroll
        for (int bj = 0; bj < 2; ++bj)
#pragma unroll
            for (int n = 0; n < 2; ++n) gv[bj][n] = *(const GAS f32x4*)(g1 + col0 + bj * HALF + n * 16);
        EPI_ROWS_BEGIN
            GAS float* xr = X + (size_t)row * DM + col0;
#pragma unroll
            for (int bj = 0; bj < 2; ++bj)
#pragma unroll
                for (int n = 0; n < 2; ++n) { GAS f32x4* p = (GAS f32x4*)(xr + bj * HALF + n * 16); *p = *p + gv[bj][n] * acc[ai][bj][m][n] * sgn; }
        EPI_ROWS_END
    }
};
struct EpiUp {
    static constexpr bool PERM = true, AFTER_DRAIN = false;
    GAS bf16* HID;
    __device__ __forceinline__ void operator()(const f32x4 (&acc)[2][2][4][2], const Unit& u, int wr, int wc, int fr, int fq) const {
        const int col = (u.pn & 3) * 128 + wc * 32 + 8 * fq;
        EPI_ROWS_BEGIN
            f32x4 o[2];
#pragma unroll
            for (int n = 0; n < 2; ++n) { const f32x4 a = acc[ai][0][m][n], b = acc[ai][1][m][n]; o[n] = (f32x4){fsilu(a.x) * b.x, fsilu(a.y) * b.y, fsilu(a.z) * b.z, fsilu(a.w) * b.w}; }
            *(GAS v4u*)(HID + (size_t)row * EHID + col) = pack8(o[0], o[1]);
        EPI_ROWS_END
    }
};
struct EpiDown {
    static constexpr bool PERM = true, AFTER_DRAIN = false;
    GAS bf16* YB; const GAS float* sgate;
    __device__ __forceinline__ void operator()(const f32x4 (&acc)[2][2][4][2], const Unit& u, int wr, int wc, int fr, int fq) const {
        EPI_ROWS_BEGIN
            const float gt = sgate[row];
#pragma unroll
            for (int bj = 0; bj < 2; ++bj) *(GAS v4u*)(YB + (size_t)row * DM + (u.pn & 3) * BM + bj * HALF + wc * 32 + 8 * fq) = pack8(acc[ai][bj][m][0] * gt, acc[ai][bj][m][1] * gt);
        EPI_ROWS_END
    }
};
struct EpiS5i {
    static constexpr bool PERM = true, AFTER_DRAIN = false;
    GAS float* YI; GAS float* ST;
    __device__ __forceinline__ void operator()(const f32x4 (&acc)[2][2][4][2], const Unit& u, int wr, int wc, int fr, int fq) const {
        const int g = u.pm / 5, i5 = u.pm - 5 * g, j = u.pn - 3 * g;
        EPI_ROWS_BEGIN
            const int cr = row - g * S5RP; (void)i5;
#pragma unroll
            for (int bj = 0; bj < 2; ++bj) { const int cl = bj * HALF + wc * 32 + 8 * fq; GAS float* dst;
                if (j < 2) { const int n = j * BM + cl; dst = YI + ((size_t)cr * 32 + (n >> 4)) * 256 + g * 16 + (n & 15); } else dst = ST + ((size_t)g * S5RP + cr) * 256 + cl;
                *(GAS f32x4*)dst = acc[ai][bj][m][0]; *(GAS f32x4*)(dst + 4) = acc[ai][bj][m][1]; }
        EPI_ROWS_END
    }
};
struct EpiS5c {
    static constexpr bool PERM = true, AFTER_DRAIN = false;
    const GAS float* YI; GAS bf16* GY;
    __device__ __forceinline__ void operator()(const f32x4 (&acc)[2][2][4][2], const Unit& u, int wr, int wc, int fr, int fq) const {
        const int g = u.pm / 5, j = u.pn - 2 * g;
        EPI_ROWS_BEGIN
            const int cr = row - g * S5RP;
#pragma unroll
            for (int bj = 0; bj < 2; ++bj) { const int n = j * BM + bj * HALF + wc * 32 + 8 * fq; const size_t o = ((size_t)cr * 32 + (n >> 4)) * 256 + g * 16 + (n & 15);
                const f32x4 y0 = acc[ai][bj][m][0] + *(const GAS f32x4*)(YI + o), y1 = acc[ai][bj][m][1] + *(const GAS f32x4*)(YI + o + 4);
                *(GAS v4u*)(GY + o) = pack8((f32x4){fgelu_tanh(y0.x), fgelu_tanh(y0.y), fgelu_tanh(y0.z), fgelu_tanh(y0.w)}, (f32x4){fgelu_tanh(y1.x), fgelu_tanh(y1.y), fgelu_tanh(y1.z), fgelu_tanh(y1.w)}); }
        EPI_ROWS_END
    }
};
struct EpiGlu {
    static constexpr bool PERM = true, AFTER_DRAIN = true;
    const GAS bf16* GY; GAS bf16* MIX; const GAS float* ng;
    __device__ __forceinline__ void fused(f32x4 (&acc)[2][2][4][2], const Unit& u, int wr, int wc, int fr, int fq, PG8_LAS unsigned char* lds, int wid, int lane) const {
        PG8_LAS float* part = (PG8_LAS float*)lds;
        EPI_ROWS_BEGIN
            float ss = 0.f;
#pragma unroll
            for (int bj = 0; bj < 2; ++bj) { const int col = bj * HALF + wc * 32 + 8 * fq; const v4u gw = *(const GAS v4u*)(GY + (size_t)row * 256 + col);
                const f32x4 g0 = {bflo(gw.x), bfhi(gw.x), bflo(gw.y), bfhi(gw.y)}, g1 = {bflo(gw.z), bfhi(gw.z), bflo(gw.w), bfhi(gw.w)};
                f32x4& a0 = acc[ai][bj][m][0]; f32x4& a1 = acc[ai][bj][m][1];
                a0 = (f32x4){g0.x * fsigmoid(a0.x), g0.y * fsigmoid(a0.y), g0.z * fsigmoid(a0.z), g0.w * fsigmoid(a0.w)};
                a1 = (f32x4){g1.x * fsigmoid(a1.x), g1.y * fsigmoid(a1.y), g1.z * fsigmoid(a1.z), g1.w * fsigmoid(a1.w)};
                ss += a0.x * a0.x + a0.y * a0.y + a0.z * a0.z + a0.w * a0.w + a1.x * a1.x + a1.y * a1.y + a1.z * a1.z + a1.w * a1.w; }
            ss = xor_add<16>(ss); ss = xor_add<32>(ss);
            if (fq == 0) part[(ai * HALF + wr * 64 + m * 16 + fr) * 4 + wc] = ss;
        EPI_ROWS_END
        asm volatile("s_waitcnt lgkmcnt(0)" ::: "memory"); __builtin_amdgcn_s_barrier(); asm volatile("" ::: "memory");
        EPI_ROWS_BEGIN
            const int lr = ai * HALF + wr * 64 + m * 16 + fr; const f32x4 pp = *(PG8_LAS f32x4*)(part + lr * 4); const float rs = rsqrtf((pp.x + pp.y + pp.z + pp.w) * (1.f / 256.f) + EPSF);
#pragma unroll
            for (int bj = 0; bj < 2; ++bj) { const int col = bj * HALF + wc * 32 + 8 * fq; const f32x4 n0 = *(const GAS f32x4*)(ng + col), n1 = *(const GAS f32x4*)(ng + col + 4);
                *(GAS v4u*)(MIX + (size_t)row * DM + 256 + col) = pack8(acc[ai][bj][m][0] * rs * n0, acc[ai][bj][m][1] * rs * n1); }
        EPI_ROWS_END
        asm volatile("s_waitcnt lgkmcnt(0)" ::: "memory"); __builtin_amdgcn_s_barrier(); asm volatile("" ::: "memory");
    }
};

namespace att {
constexpr int KVBLK = 64, QBLK = 32;
constexpr int SHM_V = KVBLK * 128 * 2, SHM_K = KVBLK * 128 * 2;
constexpr float SCALE = 0.125f, THR = 8.f;
#define KSWZ(row, colB) ((row) * 256 + ((colB) ^ (((row) & 7) << 4)))
#define SBAR() __builtin_amdgcn_sched_barrier(0)
__device__ __forceinline__ int crow(int r, int hi) { return (r & 3) + 8 * (r >> 2) + 4 * hi; }
__device__ __forceinline__ unsigned cvtpk(float lo, float hi) { unsigned r; asm volatile("v_cvt_pk_bf16_f32 %0, %1, %2" : "=v"(r) : "v"(lo), "v"(hi)); return r; }
__device__ __forceinline__ void partialSM(f32x16& p0, f32x16& p1, float& m_reg, float& mn, float& alpha) {
  constexpr float C = SCALE * 1.4426950408889634f;
  float pmax = p0[0];
#pragma unroll
  for (int r = 1; r < 16; ++r) pmax = fmaxf(pmax, p0[r]);
#pragma unroll
  for (int r = 0; r < 16; ++r) pmax = fmaxf(pmax, p1[r]);
  { auto rr = __builtin_amdgcn_permlane32_swap(__float_as_uint(pmax), __float_as_uint(pmax), false, false);
    pmax = fmaxf(__uint_as_float(rr[0]), __uint_as_float(rr[1])); }
  if (__builtin_expect(__all(pmax - m_reg <= THR / SCALE), 1)) { mn = m_reg; alpha = 1.f; }
  else { mn = fmaxf(m_reg, pmax); alpha = __builtin_amdgcn_exp2f((m_reg - mn) * C); m_reg = mn; }
  float mnC = -mn * C;
#pragma unroll
  for (int r = 0; r < 16; ++r) p0[r] = fmaf(p0[r], C, mnC);
#pragma unroll
  for (int r = 0; r < 16; ++r) p1[r] = fmaf(p1[r], C, mnC);
#pragma unroll
  for (int r = 0; r < 16; ++r) p0[r] = __builtin_amdgcn_exp2f(p0[r]);
}
__device__ __forceinline__ void finishSM(f32x16& p0, f32x16& p1, float alpha, float& l_reg, bf16x8& pa0, bf16x8& pa1, bf16x8& pa2, bf16x8& pa3) {
#pragma unroll
  for (int r = 0; r < 16; ++r) p1[r] = __builtin_amdgcn_exp2f(p1[r]);
  float ps = 0;
#pragma unroll
  for (int r = 0; r < 16; ++r) ps += p0[r];
#pragma unroll
  for (int r = 0; r < 16; ++r) ps += p1[r];
  { auto rr = __builtin_amdgcn_permlane32_swap(__float_as_uint(ps), __float_as_uint(ps), false, false);
    ps = __uint_as_float(rr[0]) + __uint_as_float(rr[1]); }
  l_reg = l_reg * alpha + ps;
#define PK4(P, BASE, OUT) do { unsigned a0 = cvtpk(P[BASE + 0], P[BASE + 1]), a1 = cvtpk(P[BASE + 2], P[BASE + 3]);   \
    unsigned b0 = cvtpk(P[BASE + 4], P[BASE + 5]), b1 = cvtpk(P[BASE + 6], P[BASE + 7]);                              \
    auto r0 = __builtin_amdgcn_permlane32_swap(a0, b0, false, false); auto r1 = __builtin_amdgcn_permlane32_swap(a1, b1, false, false); \
    v4u w = {r0[0], r1[0], r0[1], r1[1]}; OUT = __builtin_bit_cast(bf16x8, w); } while (0)
  PK4(p0, 0, pa0); PK4(p0, 8, pa1); PK4(p1, 0, pa2); PK4(p1, 8, pa3);
#undef PK4
}
__device__ __forceinline__ void qkt(f32x16& p0, f32x16& p1, const LAS char* Ks, const bf16x8* qr, int r32, int hi, int sub) {
  p0 = f32x16{}; p1 = f32x16{};
#pragma unroll
  for (int d0 = 0; d0 < 4; ++d0) { const int cb = sub * 128 + (d0 * 16 + hi * 8) * 2;
    const bf16x8 b0 = *(const LAS bf16x8*)(Ks + KSWZ(r32, cb));
    const bf16x8 b1 = *(const LAS bf16x8*)(Ks + KSWZ(32 + r32, cb));
    p0 = __builtin_amdgcn_mfma_f32_32x32x16_bf16(b0, qr[d0], p0, 0, 0, 0);
    p1 = __builtin_amdgcn_mfma_f32_32x32x16_bf16(b1, qr[d0], p1, 0, 0, 0); }
}
__device__ __forceinline__ int v_st(int k, int c) { const int kk = (k & ~0xC) | ((k & 4) << 1) | ((k & 8) >> 1); return ((kk >> 3) * 4 + (c >> 5)) * 512 + ((kk & 7) * 32 + (c & 31)) * 2; }
__device__ __forceinline__ int v_rd_base(int lane) { return ((lane & 3) << 3) | (((lane >> 2) & 3) << 6) | (((lane >> 4) & 1) << 5) | (((lane >> 5) & 1) << 8); }
constexpr int v_rd_off(int d0, int ks, int half) { return d0 * 512 + ks * 4096 + half * 2048; }
template <int OFF> __device__ __forceinline__ s16x4 tr_read(int vb) { s16x4 r; asm volatile("ds_read_b64_tr_b16 %0, %1 offset:%2" : "=&v"(r) : "v"(vb), "i"(OFF) : "memory"); return r; }
template <int D0> __device__ __forceinline__ void pv_one(f32x16& od, int vb, bf16x8 pa0, bf16x8 pa1, bf16x8 pa2, bf16x8 pa3) {
  const s16x4 l0 = tr_read<v_rd_off(D0, 0, 0)>(vb), h0 = tr_read<v_rd_off(D0, 0, 1)>(vb), l1 = tr_read<v_rd_off(D0, 1, 0)>(vb), h1 = tr_read<v_rd_off(D0, 1, 1)>(vb);
  const s16x4 l2 = tr_read<v_rd_off(D0, 2, 0)>(vb), h2 = tr_read<v_rd_off(D0, 2, 1)>(vb), l3 = tr_read<v_rd_off(D0, 3, 0)>(vb), h3 = tr_read<v_rd_off(D0, 3, 1)>(vb);
  asm volatile("s_waitcnt lgkmcnt(0)" ::: "memory"); SBAR();
#define PK(L, H) (bf16x8){L[0], L[1], L[2], L[3], H[0], H[1], H[2], H[3]}
  od = __builtin_amdgcn_mfma_f32_32x32x16_bf16(pa0, PK(l0, h0), od, 0, 0, 0);
  od = __builtin_amdgcn_mfma_f32_32x32x16_bf16(pa1, PK(l1, h1), od, 0, 0, 0);
  od = __builtin_amdgcn_mfma_f32_32x32x16_bf16(pa2, PK(l2, h2), od, 0, 0, 0);
  od = __builtin_amdgcn_mfma_f32_32x32x16_bf16(pa3, PK(l3, h3), od, 0, 0, 0);
#undef PK
}
__device__ __forceinline__ void pv_d0(f32x16* o, int vb, bf16x8 pa0, bf16x8 pa1, bf16x8 pa2, bf16x8 pa3) {
  pv_one<0>(o[0], vb, pa0, pa1, pa2, pa3); pv_one<1>(o[1], vb, pa0, pa1, pa2, pa3); pv_one<2>(o[2], vb, pa0, pa1, pa2, pa3); pv_one<3>(o[3], vb, pa0, pa1, pa2, pa3);
}
__device__ __forceinline__ void attn_unit(LAS char* lds, const GAS bf16* P, const GAS bf16* QR, GAS bf16* MIX, const GAS float* subln, float lam, float oml, int unit, int tid_) {
  asm volatile("" : "+v"(tid_));
  const int tid = tid_, wid = tid >> 6, lane = tid & 63, r32 = lane & 31, hi = lane >> 5, sub = wid >> 2, wq = wid & 3;
  const bool isl = unit < 1024; int b, h, q0;
  if (isl) { const int bh = unit >> 5; b = bh >> 2; h = bh & 3; q0 = b * SEQ + (unit & 31) * 128; } else { const int u2 = unit - 1024, bh = u2 >> 1; b = bh >> 2; h = bh & 3; q0 = ML + b * CTXL + (u2 & 1) * 128; }
  const int NT = isl ? 68 : 4; const int crow0 = ML + b * CTXL, lrow0 = b * SEQ;
  LAS char* V_lds = lds; LAS char* K_lds = lds + 2 * SHM_V;
  LAS float* ws = (LAS float*)(lds + 2 * SHM_V + 2 * SHM_K) + wid * 64; LAS float* li_l = ws; LAS float* al_l = ws + 32;
  float m_reg = -1e30f, l_reg = 0; f32x16 o[4] = {}; bf16x8 qr[4];
  const int qrow = q0 + wq * QBLK + r32;
  { const GAS bf16* Qw = P + (size_t)qrow * INC + C_Q + h * 128 + sub * 64 + hi * 8;
#pragma unroll
    for (int d0 = 0; d0 < 4; ++d0) qr[d0] = *(const GAS bf16x8*)(Qw + d0 * 16); }
  const int sr = tid >> 4, sc = (tid & 15) * 8, vst0 = v_st(sr, sc), vst1 = v_st(32 + sr, sc);
  const int vb0 = (int)(unsigned long)V_lds + v_rd_base(lane);
  const GAS bf16* Kc = P + C_K + h * 128 + sc; const GAS bf16* Vc = P + C_V + h * 128 + sc;
  struct { bf16x8 vs0, vs1, ks0, ks1; } sr_[2];
#define TROW(j) (((j) < 4 ? crow0 + (j) * 64 : lrow0 + ((j) - 4) * 64) + sr)
#define SLOAD(i, j) do { const size_t _r = (size_t)TROW(j) * INC; sr_[i].vs0 = *(const GAS bf16x8*)(Vc + _r); sr_[i].vs1 = *(const GAS bf16x8*)(Vc + _r + (size_t)32 * INC); \
    sr_[i].ks0 = *(const GAS bf16x8*)(Kc + _r); sr_[i].ks1 = *(const GAS bf16x8*)(Kc + _r + (size_t)32 * INC); } while (0)
#define SWRITE(bb, i) do { *(LAS bf16x8*)(V_lds + (bb) * SHM_V + vst0) = sr_[i].vs0; *(LAS bf16x8*)(V_lds + (bb) * SHM_V + vst1) = sr_[i].vs1; const int kc = sc * 2; \
    *(LAS bf16x8*)(K_lds + (bb) * SHM_K + KSWZ(sr, kc)) = sr_[i].ks0; *(LAS bf16x8*)(K_lds + (bb) * SHM_K + KSWZ(32 + sr, kc)) = sr_[i].ks1; } while (0)
#define SWAIT() asm volatile("s_waitcnt vmcnt(4)" ::: "memory")
#define RESC(a) do { if (__any((a) < 1.f)) { if (hi == 0) al_l[r32] = (a); asm volatile("s_waitcnt lgkmcnt(0)" ::: "memory"); \
    _Pragma("unroll") for (int d = 0; d < 4; ++d) _Pragma("unroll") for (int r = 0; r < 16; ++r) o[d][r] *= al_l[crow(r, hi)]; } } while (0)
  f32x16 pA0, pA1, pB0, pB1; float mnA, mnB, alA, alB; bf16x8 pa0, pa1, pa2, pa3;
  SLOAD(0, 0); asm volatile("s_waitcnt vmcnt(0)" ::: "memory"); SWRITE(0, 0); __syncthreads();
  qkt(pA0, pA1, K_lds, qr, r32, hi, sub); partialSM(pA0, pA1, m_reg, mnA, alA);
  SLOAD(1, 1); if (2 < NT) SLOAD(0, 2);
  SWAIT(); SWRITE(1, 1); __syncthreads();
  for (int j = 1; j + 1 < NT; j += 2) {
    SBAR(); qkt(pB0, pB1, K_lds + SHM_K, qr, r32, hi, sub);
    finishSM(pA0, pA1, alA, l_reg, pa0, pa1, pa2, pa3); SBAR();
    SLOAD(1, j + 2); SBAR();
    pv_d0(o, vb0, pa0, pa1, pa2, pa3); partialSM(pB0, pB1, m_reg, mnB, alB);
    __syncthreads(); SWAIT(); SWRITE(0, 0);
    RESC(alB); __syncthreads();
    if (isl && j == 3) { const GAS bf16* Qw = QR + (size_t)qrow * 512 + h * 128 + sub * 64 + hi * 8;
#pragma unroll
      for (int d0 = 0; d0 < 4; ++d0) qr[d0] = *(const GAS bf16x8*)(Qw + d0 * 16); }
    SBAR(); qkt(pA0, pA1, K_lds, qr, r32, hi, sub);
    finishSM(pB0, pB1, alB, l_reg, pa0, pa1, pa2, pa3); SBAR();
    if (j + 3 < NT) SLOAD(0, j + 3); SBAR();
    pv_d0(o, vb0 + SHM_V, pa0, pa1, pa2, pa3); partialSM(pA0, pA1, m_reg, mnA, alA);
    __syncthreads(); SWAIT(); SWRITE(1, 1);
    RESC(alA); __syncthreads();
  }
  SBAR(); qkt(pB0, pB1, K_lds + SHM_K, qr, r32, hi, sub);
  finishSM(pA0, pA1, alA, l_reg, pa0, pa1, pa2, pa3); SBAR();
  pv_d0(o, vb0, pa0, pa1, pa2, pa3); partialSM(pB0, pB1, m_reg, mnB, alB);
  __syncthreads(); RESC(alB);
  finishSM(pB0, pB1, alB, l_reg, pa0, pa1, pa2, pa3); SBAR();
  pv_d0(o, vb0 + SHM_V, pa0, pa1, pa2, pa3);
  if (hi == 0) li_l[r32] = l_reg; asm volatile("s_waitcnt lgkmcnt(0)" ::: "memory");
  float rli[16];
#pragma unroll
  for (int r = 0; r < 16; ++r) rli[r] = __builtin_amdgcn_rcpf(li_l[crow(r, hi)]);
  __syncthreads();
  LAS float* ex = (LAS float*)lds + wq * 4096 + lane;
  if (sub == 1) {
#pragma unroll
    for (int d = 0; d < 4; ++d)
#pragma unroll
      for (int r = 0; r < 16; ++r) ex[(d * 16 + r) * 64] = o[d][r] * rli[r] * lam;
  }
  __syncthreads();
  if (sub == 0) {
    float ss[16];
#pragma unroll
    for (int r = 0; r < 16; ++r) { float s = 0.f;
#pragma unroll
      for (int d = 0; d < 4; ++d) { const float v = o[d][r] * rli[r] - ex[(d * 16 + r) * 64]; o[d][r] = v; s += v * v; }
      ss[r] = s; }
#pragma unroll
    for (int r = 0; r < 16; ++r) { float s = ss[r]; s = xor_add<1>(s); s = xor_add<2>(s); s = xor_add<4>(s); s = xor_add<8>(s); s = xor_add<16>(s); ss[r] = rsqrtf(s * (1.f / 128.f) + EPSF) * oml; }
    GAS bf16* Ow = MIX + (size_t)(q0 + wq * QBLK) * DM + 512 + h * 128 + r32;
#pragma unroll
    for (int d = 0; d < 4; ++d) { const float gsc = subln[d * 32 + r32];
#pragma unroll
      for (int r = 0; r < 16; ++r) Ow[(size_t)crow(r, hi) * DM + d * 32] = (bf16)f2bf(o[d][r] * ss[r] * gsc); }
  }
  __syncthreads();
#undef TROW
#undef SLOAD
#undef SWRITE
#undef SWAIT
#undef RESC
}
#undef KSWZ
}

#endif
__global__ void __launch_bounds__(NTHR, 2) mega_fwd(Args args) {
#if defined(__HIP_DEVICE_COMPILE__)
    extern __shared__ __attribute__((aligned(16))) unsigned char lds_raw[];
    Frame F;
    F.lds = (LAS unsigned char*)lds_raw; F.out = (GAS float*)args.out; F.ws = (GAS unsigned char*)args.ws; F.ctl = (gu32*)((GAS unsigned char*)args.ws + WS_CTL);
    const int wave0 = __builtin_amdgcn_readfirstlane((int)threadIdx.x >> 6);
    F.tid = threadIdx.x; F.lane = F.tid & 63; F.wave = wave0;
    F.G = gridDim.x; F.bx = blockIdx.x; F.vcu = F.bx;
    volatile LAS unsigned* MISC = (volatile LAS unsigned*)(F.lds + MISC_OFF);
    for (int u = F.tid; u < 256; u += NTHR) MISC[u] = 0u;
    __syncthreads();
    const int lo = args.ph_lo, hi = args.ph_hi;
    const bool multi = (hi - lo) > 1;
    XcdBarrier bar; bar.bar = (GAS unsigned*)(F.ctl + CW_BAR); bar.x = 0; bar.st = nullptr;
    if (multi) bar = xcd_barrier_post((GAS unsigned*)(F.ctl + CW_BAR), MISC + 8, F.tid);
#ifndef PH_MASK
#define PH_MASK 0xFFFFFFFFu
#endif
#define IN(k) (lo <= (k) && (k) < hi)
#define PHM(bit) ((PH_MASK >> (bit)) & 1u)
#define REP(bit) _Pragma("unroll 1") for (int rep_ = 0; rep_ < (((DUP_MASK >> (bit)) & 1u) ? 2 : 1); ++rep_)
#define FRESH() do { const int t_ = (wave0 << 6) | lane_id_asm(); F.tid = t_; F.lane = t_ & 63; F.wave = wave0; \
    GAS unsigned char* w_ = (GAS unsigned char*)args.ws; asm volatile("" : "+s"(w_)); F.ws = w_; F.ctl = (gu32*)(w_ + WS_CTL); \
    int bx_ = blockIdx.x, g_ = gridDim.x; asm volatile("" : "+s"(bx_), "+s"(g_)); F.bx = bx_; F.G = g_; F.vcu = (g_ % 8 == 0) ? (bx_ % 8) * (g_ / 8) + bx_ / 8 : bx_; } while (0)
#define SEAM(k) do { if (IN(k) && IN((k) + 1)) { XcdBarrier b_ = bar; unsigned char* p_ = args.ws; asm volatile("" : "+s"(p_)); b_.bar = (unsigned*)(p_ + WS_CTL) + CW_BAR; xcd_barrier(b_, (wave0 << 6) | lane_id_asm()); } } while (0)
    PG8_LAS unsigned char* glds = (PG8_LAS unsigned char*)lds_raw;

    if (PHM(0) && IN(0)) { FRESH(); REP(0) { p0_modv(F); p0_weights(F); __syncthreads(); p0_h2(F); p0_s5(F); p0_misc(F); } }
    SEAM(0);
    if (PHM(1) && IN(1)) { FRESH(); REP(0) { p0_filters(F); } }
    SEAM(1);

#pragma unroll 1
    for (int l = 0; l < DEPTH; ++l) {
        const int pb = PH_LAYER0 + l * NPL;
        if (PHM(2) && IN(pb + 0)) { FRESH(); _Pragma("unroll 1") for (int rep_ = 0; rep_ < ((((DUP_MASK >> 12) & 1u) && l == 0) ? 2 : 1); ++rep_) n1_phase(F, l); __syncthreads(); FRESH(); REP(1) { moe_weights(F, l); } }
        SEAM(pb + 0);
        if (PHM(3) && IN(pb + 1)) { FRESH();
            pg8::Gemm g{WSP(bf16, WS_H), WSP(bf16, WS_WINT) + (size_t)l * INC * DM, MT, INC, DM}; pg8::StaticOrder S; S.init(MT, INC, F.G, F.bx);
            EpiG1 E{WSP(bf16, WS_P), WSP(bf16, WS_QR), WSP(bf16, WS_U5), WSP(f32x2, WS_ROPE)};
            REP(2) { pg8::gemm_phase<EpiG1, pg8::StaticOrder, true, true, false>(glds, g, S, E, F.tid); }
        }
        SEAM(pb + 1);
#define ATTN_RANGE(lo_, hi_) do { const float lam = WSP(float, WS_MISC)[l], oml = WSP(float, WS_MISC)[4 + l]; const GAS float* sub_ = inptr(I_SUBLN) + l * 128; \
        for (int u = (lo_) + F.vcu; u < (hi_); u += F.G) att::attn_unit((LAS char*)lds_raw, WSP(bf16, WS_P), WSP(bf16, WS_QR), WSP(bf16, WS_MIX), sub_, lam, oml, u, F.tid); __syncthreads(); } while (0)
        if (PHM(4) && IN(pb + 2)) { FRESH();
            REP(4) { for (int u = F.vcu; u < MT / 64; u += F.G) hypre_unit(F, l, u); }
            __syncthreads(); FRESH();
            { pg8::Gemm g{WSP(bf16, WS_U5), WSP(bf16, WS_S5MB) + (size_t)l * 16 * 768 * 512, 16 * S5RP, 16 * 768, 512}; ListOrder S{240, 15, 3, 5, 3, F.G, F.bx};
              EpiS5i E{WSP(float, WS_YI), WSP(float, WS_ST)};
              REP(5) { pg8::gemm_phase<EpiS5i, ListOrder, true, true, false>(glds, g, S, E, F.tid); } }
            __syncthreads(); FRESH();
            REP(3) { ATTN_RANGE(0, 512); }
        }
        SEAM(pb + 2);
        if (PHM(5) && IN(pb + 3)) { FRESH();
            REP(6) { s5_scan_phase(F, l); } FRESH();
            REP(4) { for (int u = F.vcu; u < 1024; u += F.G) hyena_unit(F, l, u);
                     for (int u = F.vcu; u < 256; u += F.G) hyena_ctx_unit(F, l, u); }
            __syncthreads(); FRESH();
            REP(3) { ATTN_RANGE(512, 768); }
        }
        SEAM(pb + 3);
        if (PHM(6) && IN(pb + 4)) { FRESH();
            { pg8::Gemm g{WSP(bf16, WS_HIN), WSP(bf16, WS_S5CS) + (size_t)l * 16 * 512 * 256, 16 * S5RP, 16 * 512, 256}; ListOrder S{160, 10, 2, 5, 2, F.G, F.bx};
              EpiS5c E{WSP(float, WS_YI), WSP(bf16, WS_GY)};
              REP(6) { pg8::gemm_phase<EpiS5c, ListOrder, true, true, false>(glds, g, S, E, F.tid); } }
            __syncthreads(); FRESH();
            REP(3) { ATTN_RANGE(768, 1088); }
        }
        SEAM(pb + 4);
        if (PHM(7) && IN(pb + 5)) { FRESH();
            { pg8::Gemm g{WSP(bf16, WS_GY), WSP(bf16, WS_GLUT) + (size_t)l * 65536, MT, 256, 256}; ListOrder S{MT / 256, 1, 1, 1, 0, F.G, F.bx};
              EpiGlu E{WSP(bf16, WS_GY), WSP(bf16, WS_MIX), inptr(I_S5NG) + l * 256};
              REP(6) { pg8::gemm_phase<EpiGlu, ListOrder, false, true, false>(glds, g, S, E, F.tid); } }
            __syncthreads(); FRESH();
            REP(6) for (int u = F.vcu; u < MT / 64; u += F.G) hyena_fin_unit(F, l, u);
        }
        SEAM(pb + 5);
        if (PHM(8) && IN(pb + 6)) { FRESH();
            pg8::Gemm g{WSP(bf16, WS_MIX), WSP(bf16, WS_WOUTT) + (size_t)l * DM * DM, MT, DM, DM}; pg8::StaticOrder S; S.init(MT, DM, F.G, F.bx);
            _Pragma("unroll 1") for (int rep_ = 0; rep_ < (((DUP_MASK >> 7) & 1u) ? 3 : 1); ++rep_) {
            EpiG2 E{WSP(float, WS_X), WSP(float, WS_MODV) + (size_t)l * 9 * NMOD, rep_ == 1 ? -1.f : 1.f};
            pg8::gemm_phase<EpiG2, pg8::StaticOrder, true, true, false>(glds, g, S, E, F.tid); }
        }
        SEAM(pb + 6);
        if (PHM(9) && IN(pb + 7)) { FRESH(); REP(8) { n2r_phase(F, l); } }
        SEAM(pb + 7);
        if (PHM(10) && IN(pb + 8)) { FRESH(); REP(9) { assign_phase(F, l); } }
        SEAM(pb + 8);
        if (PHM(11) && IN(pb + 9)) { FRESH();
            const int ntiles = (int)__hip_atomic_load(F.ctl + CW_NTILES + l, RLX_AGENT);
            pg8::Gemm g{WSP(bf16, WS_H), WSP(bf16, WS_MOEW13), NSLOT, NEXP * 1024, DM}; MoeOrder S{(const GAS int*)(F.ws + WS_TOK + TK_TILEE), ntiles, F.G, F.bx};
            EpiUp E{WSP(bf16, WS_HID)};
            REP(10) { pg8::gemm_phase<EpiUp, MoeOrder, true, true, true>(glds, g, S, E, F.tid, (const GAS int*)(F.ws + WS_TOK + TK_STOK)); }
        }
        SEAM(pb + 9);
        if (PHM(12) && IN(pb + 10)) { FRESH();
            const int ntiles = (int)__hip_atomic_load(F.ctl + CW_NTILES + l, RLX_AGENT);
            pg8::Gemm g{WSP(bf16, WS_HID), WSP(bf16, WS_MOEW2), NSLOT, NEXP * 1024, EHID}; MoeOrder S{(const GAS int*)(F.ws + WS_TOK + TK_TILEE), ntiles, F.G, F.bx};
            EpiDown E{WSP(bf16, WS_YB), (const GAS float*)(F.ws + WS_TOK + TK_SGATE)};
            REP(11) { pg8::gemm_phase<EpiDown, MoeOrder, true, true, false>(glds, g, S, E, F.tid); }
        }
        SEAM(pb + 10);
    }
    if (PHM(13) && IN(PH_FINAL)) { FRESH(); REP(12) { n1_phase(F, DEPTH); } }
#undef IN
#undef SEAM
#endif
}

#ifndef MK_SPLIT
#define MK_SPLIT 0
#endif
extern "C" void kernel_launch(void* const* d_in, const int* in_sizes, int n_in, void* d_out, int out_size, void* d_ws, size_t ws_size, hipStream_t stream) {
    static int grid = 0;
    if (grid == 0) {
        if (n_in != 43 || out_size != ML * DM || ws_size < WS_END) { fprintf(stderr, "kernel_launch: unexpected problem: n_in %d out %d ws %zu (need %zu)\n", n_in, out_size, ws_size, (size_t)WS_END); grid = -1; return; }
        int dev = 0, cus = 0, per_cu = 0;
        if (hipGetDevice(&dev) != hipSuccess || hipDeviceGetAttribute(&cus, hipDeviceAttributeMultiprocessorCount, dev) != hipSuccess) { grid = -1; return; }
        if (hipFuncSetAttribute((const void*)mega_fwd, hipFuncAttributeMaxDynamicSharedMemorySize, LDS_BYTES) != hipSuccess) { fprintf(stderr, "kernel_launch: hipFuncSetAttribute failed\n"); grid = -1; return; }
        if (hipOccupancyMaxActiveBlocksPerMultiprocessor(&per_cu, (const void*)mega_fwd, NTHR, LDS_BYTES) != hipSuccess || per_cu < 1) fprintf(stderr, "kernel_launch: occupancy query says %d\n", per_cu);
        (void)hipGetLastError();
        grid = cus;
    }
    if (grid < 0) return;
    if (hipMemsetAsync((char*)d_ws + WS_CTL, 0, CTL_ZERO_BYTES, stream) != hipSuccess) return;
    Args a{};
    for (int i = 0; i < 43; ++i) a.in[i] = (const float*)d_in[i];
    a.out = (float*)d_out; a.ws = (unsigned char*)d_ws;
#if MK_SPLIT
    for (int p = 0; p < PH_TOTAL; ++p) { a.ph_lo = p; a.ph_hi = p + 1; hipLaunchKernelGGL(mega_fwd, dim3(grid), dim3(NTHR), LDS_BYTES, stream, a); }
#else
    a.ph_lo = 0; a.ph_hi = PH_TOTAL; hipLaunchKernelGGL(mega_fwd, dim3(grid), dim3(NTHR), LDS_BYTES, stream, a);
#endif
    const hipError_t le = hipPeekAtLastError();
    if (le != hipSuccess) fprintf(stderr, "kernel_launch: launch failed: %s\n", hipGetErrorName(le));
}
```
